# Optimizing an MI355X kernel written in HIP

```python
import math
import jax
import jax.numpy as jnp
from jax import lax
import numpy as np

D_MODEL = 2048
BATCH = 4
SEQ = 4096
DEPTH = 4

GRID_W = 64
CTX_LEN = 256
EPS = 1e-6
NEG = -1e30
HEAD_DIM = 64
GROUP_W = D_MODEL // 4
MIX_W = 4 * GROUP_W

A_HEADS = GROUP_W // HEAD_DIM
A_KV_HEADS = max(1, A_HEADS // 4)
WINDOW = 128
BLOCK = 128
ROPE_BASE = 10000.0
HY_CH = GROUP_W
HY_ORDER = 2
HY_EMB = 33
HY_FFN = 64
HY_SHORT = 3
HY_DECAY_TARGET = 1e-2
HY_FAST_PCT = 0.3
HY_SLOW_PCT = 1.5
NA_HEADS = GROUP_W // HEAD_DIM
NA_KR = 8
NA_KC = 16
SSM_INNER = GROUP_W
SSM_HEAD_DIM = 64
SSM_HEADS = SSM_INNER // SSM_HEAD_DIM
SSM_STATE = 128
SSM_GROUPS = 2
SSM_CONV = 3
SSM_CHUNK = 128
SSM_XBC = SSM_INNER + 2 * SSM_GROUPS * SSM_STATE
D_FF = 4 * D_MODEL

A_COLS = (A_HEADS + 2 * A_KV_HEADS) * HEAD_DIM
HY_COLS = (HY_ORDER + 1) * HY_CH
NA_COLS = 3 * NA_HEADS * HEAD_DIM
SSM_COLS = SSM_INNER + SSM_XBC + 2 * SSM_HEADS
OFF_HY = A_COLS
OFF_NA = OFF_HY + HY_COLS
OFF_SSM = OFF_NA + NA_COLS
N_IN = OFF_SSM + SSM_COLS

kernel_name = "hybrid_parallel_heads_diffusion_trunk"

F32 = jnp.float32


def rms_norm(x, g):
    xf = x.astype(F32)
    y = xf * lax.rsqrt(jnp.mean(xf * xf, axis=-1, keepdims=True) + EPS)
    return (y * g.astype(F32)).astype(x.dtype)


def centred_conv(u, w, b):
    K = w.shape[0]
    L = u.shape[1]
    pad = K // 2
    up = jnp.pad(u, ((0, 0), (pad, pad), (0, 0)))
    out = up[:, 0:L] * w[0]
    for k in range(1, K):
        out = out + up[:, k:k + L] * w[k]
    return out + b


def axial_rope(x, row, col):
    half = x.shape[-1] // 2
    quarter = half // 2
    inv = ROPE_BASE ** (-jnp.arange(quarter, dtype=F32) / quarter)

    def rot(xp, pos):
        ang = pos.astype(F32)[:, None] * inv[None]
        cos = jnp.cos(ang)[None, :, None, :].astype(x.dtype)
        sin = jnp.sin(ang)[None, :, None, :].astype(x.dtype)
        x1, x2 = xp[..., :quarter], xp[..., quarter:]
        return jnp.concatenate([x1 * cos - x2 * sin, x2 * cos + x1 * sin], axis=-1)

    return jnp.concatenate([rot(x[..., :half], row), rot(x[..., half:], col)], axis=-1)


def split_heads(p, n_q, n_kv):
    Bn, L, _ = p.shape
    q = p[..., :n_q * HEAD_DIM].reshape(Bn, L, n_q, HEAD_DIM)
    k = p[..., n_q * HEAD_DIM:(n_q + n_kv) * HEAD_DIM].reshape(Bn, L, n_kv, HEAD_DIM)
    v = p[..., (n_q + n_kv) * HEAD_DIM:(n_q + 2 * n_kv) * HEAD_DIM].reshape(Bn, L, n_kv, HEAD_DIM)
    return q, k, v


def context_attention(qc, kc, vc, sink=None):
    Bn, Lc, Hq, Dh = qc.shape
    Hkv = kc.shape[2]
    G = Hq // Hkv
    qg = qc.reshape(Bn, Lc, Hkv, G, Dh)
    s = jnp.einsum('bqhgd,bkhd->bhgqk', qg, kc).astype(F32) * (Dh ** -0.5)
    if sink is not None:
        sk = jnp.broadcast_to(sink.astype(F32).reshape(1, Hkv, G, 1, 1), s.shape[:-1] + (1,))
        s = jnp.concatenate([s, sk], axis=-1)
    p = jax.nn.softmax(s, axis=-1)[..., :Lc].astype(vc.dtype)
    return jnp.einsum('bhgqk,bkhd->bqhgd', p, vc).reshape(Bn, Lc, Hq * Dh)


def window_attention(q, k, v, kc, vc, sink):
    Bn, S, Hq, Dh = q.shape
    Hkv = k.shape[2]
    G = Hq // Hkv
    nb = S // BLOCK
    Lc = kc.shape[1]
    scale = Dh ** -0.5
    qb = q.reshape(Bn, nb, BLOCK, Hkv, G, Dh)

    def band(t):
        tp = jnp.pad(t, ((0, 0), (BLOCK, BLOCK), (0, 0), (0, 0))).reshape(Bn, nb + 2, BLOCK, Hkv, Dh)
        return jnp.concatenate([tp[:, :-2], tp[:, 1:-1], tp[:, 2:]], axis=2)

    kb, vb = band(k), band(v)
    s_loc = jnp.einsum('bnqhgd,bnkhd->bnhgqk', qb, kb).astype(F32) * scale
    s_ctx = jnp.einsum('bnqhgd,bchd->bnhgqc', qb, kc).astype(F32) * scale
    qi = jnp.arange(BLOCK)[:, None]
    kj = jnp.arange(3 * BLOCK)[None, :]
    rel = kj - BLOCK - qi
    kpos = jnp.arange(nb)[:, None, None] * BLOCK + (kj - BLOCK)[None]
    valid = (jnp.abs(rel) <= WINDOW)[None] & (kpos >= 0) & (kpos < S)
    s_loc = jnp.where(valid[None, :, None, None], s_loc, NEG)
    sk = jnp.broadcast_to(sink.astype(F32).reshape(1, 1, Hkv, G, 1, 1), s_loc.shape[:-1] + (1,))
    p = jax.nn.softmax(jnp.concatenate([s_loc, s_ctx, sk], axis=-1), axis=-1)
    p_loc = p[..., :3 * BLOCK].astype(v.dtype)
    p_ctx = p[..., 3 * BLOCK:3 * BLOCK + Lc].astype(v.dtype)
    out = (jnp.einsum('bnhgqk,bnkhd->bnqhgd', p_loc, vb)
           + jnp.einsum('bnhgqc,bchd->bnqhgd', p_ctx, vc))
    return out.reshape(Bn, S, Hq * Dh)


def neighbourhood_attention(q, k, v, kc, vc, rpb):
    Bn, S, H, Dh = q.shape
    rows = S // GRID_W
    kr = min(NA_KR, rows)
    Lc = kc.shape[1]
    scale = Dh ** -0.5
    qg = q.reshape(Bn, rows, GRID_W, H, Dh)
    r = jnp.arange(rows)
    rstart = jnp.clip(r - kr // 2, 0, rows - kr)
    ridx = rstart[:, None] + jnp.arange(kr)[None]
    kg = jnp.take(k.reshape(Bn, rows, GRID_W, H, Dh), ridx, axis=1)
    vg = jnp.take(v.reshape(Bn, rows, GRID_W, H, Dh), ridx, axis=1)
    s_loc = jnp.einsum('brqhd,brawhd->brhqaw', qg, kg).astype(F32) * scale
    cq = jnp.arange(GRID_W)
    ck = jnp.arange(GRID_W)
    cstart = jnp.clip(cq - NA_KC // 2, 0, GRID_W - NA_KC)
    col_valid = (ck[None] >= cstart[:, None]) & (ck[None] < cstart[:, None] + NA_KC)
    roff = ridx - r[:, None] + NA_KR - 1
    coff = jnp.clip(ck[None] - cq[:, None], -(NA_KC - 1), NA_KC - 1) + NA_KC - 1
    bias = rpb[:, roff][:, :, :, coff]
    bias = bias.transpose(1, 0, 3, 2, 4).astype(F32)
    s_loc = jnp.where(col_valid[:, None, :], s_loc + bias[None], NEG)
    s_loc = s_loc.reshape(Bn, rows, H, GRID_W, kr * GRID_W)
    s_ctx = jnp.einsum('brqhd,bchd->brhqc', qg, kc).astype(F32) * scale
    p = jax.nn.softmax(jnp.concatenate([s_loc, s_ctx], axis=-1), axis=-1)
    p_loc = p[..., :kr * GRID_W].reshape(Bn, rows, H, GRID_W, kr, GRID_W).astype(v.dtype)
    p_ctx = p[..., kr * GRID_W:].astype(v.dtype)
    out = (jnp.einsum('brhqaw,brawhd->brqhd', p_loc, vg)
           + jnp.einsum('brhqc,bchd->brqhd', p_ctx, vc))
    return out.reshape(Bn, S, H * Dh)


def hyena_filters(L, w1, b1, w2, b2, w3, b3, w4, freq):
    t = jnp.linspace(0.0, 1.0, L, dtype=F32)[:, None]
    bands = (HY_EMB - 1) // 2
    f = jnp.linspace(1e-4, bands - 1, bands, dtype=F32)[None]
    wpos = 2.0 * math.pi * jnp.arange(L, dtype=F32)[:, None] / L
    z = jnp.concatenate([t, jnp.cos(f * wpos), -jnp.sin(f * wpos)], axis=-1)
    fr = freq.astype(F32)
    h = jnp.sin(fr * (z @ w1.astype(F32) + b1.astype(F32)))
    h = jnp.sin(fr * (h @ w2.astype(F32) + b2.astype(F32)))
    h = jnp.sin(fr * (h @ w3.astype(F32) + b3.astype(F32)))
    h = (h @ w4.astype(F32)).reshape(L, HY_ORDER, 2, HY_CH)
    max_decay = math.log(HY_DECAY_TARGET) / HY_FAST_PCT
    min_decay = math.log(HY_DECAY_TARGET) / HY_SLOW_PCT
    deltas = jnp.linspace(min_decay, max_decay, HY_CH, dtype=F32)
    decay = jnp.exp(-t * jnp.abs(deltas)[None])
    return h * decay[:, None, None, :]


def bidir_long_conv(u, h_fwd, h_bwd, skip):
    Bn, L, C = u.shape
    kern = jnp.concatenate([h_fwd, jnp.zeros((1, C), F32), h_bwd[1:][::-1]], axis=0)
    U = jnp.fft.rfft(u, n=2 * L, axis=1)
    Kf = jnp.fft.rfft(kern, n=2 * L, axis=0)
    y = jnp.fft.irfft(U * Kf[None], n=2 * L, axis=1)[:, :L]
    return y + u * skip.astype(F32)


def hyena_mixer(p, short_w, short_b, filt, skip):
    u = centred_conv(p, short_w, short_b).astype(F32)
    x1, x2, v = u[..., :HY_CH], u[..., HY_CH:2 * HY_CH], u[..., 2 * HY_CH:]
    z = x1 * bidir_long_conv(v, filt[:, 0, 0], filt[:, 0, 1], skip[0])
    z = x2 * bidir_long_conv(z, filt[:, 1, 0], filt[:, 1, 1], skip[1])
    return z.astype(p.dtype)


def segsum(a):
    T = a.shape[-1]
    cs = jnp.cumsum(a, axis=-1)
    diff = cs[..., :, None] - cs[..., None, :]
    mask = jnp.tril(jnp.ones((T, T), dtype=bool))
    return jnp.where(mask, diff, -jnp.inf)


def ssd_chunked(xs, dt, A, Bm, Cm, h0, return_y):
    b, l, nh, p = xs.shape
    g, n = Bm.shape[2], Bm.shape[3]
    nc = l // SSM_CHUNK
    Bh = jnp.repeat(Bm, nh // g, axis=2).reshape(b, nc, SSM_CHUNK, nh, n)
    Ch = jnp.repeat(Cm, nh // g, axis=2).reshape(b, nc, SSM_CHUNK, nh, n)
    X = (xs * dt[..., None]).reshape(b, nc, SSM_CHUNK, nh, p)
    Adt = (dt * A).reshape(b, nc, SSM_CHUNK, nh).transpose(0, 3, 1, 2)
    A_cs = jnp.cumsum(Adt, axis=-1)
    decay_states = jnp.exp(A_cs[..., -1:] - A_cs).transpose(0, 2, 3, 1)
    states = jnp.einsum('bclhn,bclhp->bchpn', Bh, X * decay_states[..., None])
    states = jnp.concatenate([h0[:, None], states], axis=1)
    chunk_decay = jnp.exp(segsum(jnp.pad(A_cs[..., -1], ((0, 0), (0, 0), (1, 0)))))
    new_states = jnp.einsum('bhzc,bchpn->bzhpn', chunk_decay, states)
    final = new_states[:, -1]
    if not return_y:
        return None, final
    prev = new_states[:, :-1]
    Lmat = jnp.exp(segsum(Adt))
    cb = jnp.einsum('bclhn,bcshn->bhcls', Ch, Bh) * Lmat
    y_diag = jnp.einsum('bhcls,bcshp->bclhp', cb, X)
    out_decay = jnp.exp(A_cs).transpose(0, 2, 3, 1)
    y_off = jnp.einsum('bclhn,bchpn->bclhp', Ch, prev) * out_decay[..., None]
    return (y_diag + y_off).reshape(b, l, nh, p), final


def ssm_inputs(p, conv_w, conv_b):
    Bn, L, _ = p.shape
    z = p[..., :SSM_INNER]
    xbc = jax.nn.silu(centred_conv(p[..., SSM_INNER:SSM_INNER + SSM_XBC], conv_w, conv_b)).astype(F32)
    dt_raw = p[..., SSM_INNER + SSM_XBC:].astype(F32).reshape(Bn, L, 2, SSM_HEADS)
    gn = SSM_GROUPS * SSM_STATE
    xs = xbc[..., :SSM_INNER].reshape(Bn, L, SSM_HEADS, SSM_HEAD_DIM)
    Bm = xbc[..., SSM_INNER:SSM_INNER + gn].reshape(Bn, L, SSM_GROUPS, SSM_STATE)
    Cm = xbc[..., SSM_INNER + gn:].reshape(Bn, L, SSM_GROUPS, SSM_STATE)
    return z, xs, Bm, Cm, dt_raw


def ssm_direction(xs, Bm, Cm, dt_raw_d, dt_bias_d, a_log_d, h0, reverse, return_y):
    dt = jax.nn.softplus(dt_raw_d + dt_bias_d.astype(F32))
    A = -jnp.exp(a_log_d.astype(F32))
    if reverse:
        xs, Bm, Cm, dt = (jnp.flip(t, axis=1) for t in (xs, Bm, Cm, dt))
    y, hT = ssd_chunked(xs, dt, A, Bm, Cm, h0, return_y)
    if reverse and return_y:
        y = jnp.flip(y, axis=1)
    return y, hT


def ssm_output(y, xs, z, d_skip, norm_w):
    Bn, L = z.shape[0], z.shape[1]
    y = y + xs * d_skip.astype(F32)[:, None]
    y = y.reshape(Bn, L, SSM_INNER) * jax.nn.silu(z.astype(F32))
    yg = y.reshape(Bn, L, SSM_GROUPS, SSM_INNER // SSM_GROUPS)
    yg = yg * lax.rsqrt(jnp.mean(yg * yg, axis=-1, keepdims=True) + EPS)
    return (yg.reshape(Bn, L, SSM_INNER) * norm_w.astype(F32)).astype(z.dtype)


def sq_relu_mlp(h, w1, w2):
    return jnp.square(jax.nn.relu(h @ w1)) @ w2


def setup_inputs(seed: int = 0) -> dict:
    key = jax.random.key(seed)
    ks = iter(jax.random.split(key, 40))

    def nrm(shape, scale):
        return jax.random.normal(next(ks), shape, F32) * scale

    x = nrm((BATCH, SEQ, D_MODEL), 1.0)
    c = nrm((BATCH, D_MODEL), 1.0)
    ctx = nrm((BATCH, CTX_LEN, D_MODEL), 1.0)
    c_ctx = nrm((D_MODEL,), 1.0)
    ada_w = nrm((DEPTH, D_MODEL, 6 * D_MODEL), D_MODEL ** -0.5)
    ada_b = nrm((DEPTH, 6 * D_MODEL), 0.02)
    norm_mix = 1.0 + nrm((DEPTH, D_MODEL), 0.02)
    norm_mlp = 1.0 + nrm((DEPTH, D_MODEL), 0.02)
    w_in = nrm((DEPTH, D_MODEL, N_IN), D_MODEL ** -0.5)
    w_out = nrm((DEPTH, MIX_W, D_MODEL), MIX_W ** -0.5)
    attn_sink = nrm((DEPTH, A_HEADS), 0.5)
    hy_short_w = nrm((DEPTH, HY_SHORT, HY_COLS), HY_SHORT ** -0.5)
    hy_short_b = nrm((DEPTH, HY_COLS), 0.02)
    hy_w1 = nrm((DEPTH, HY_EMB, HY_FFN), HY_EMB ** -0.5)
    hy_b1 = nrm((DEPTH, HY_FFN), 0.02)
    hy_w2 = nrm((DEPTH, HY_FFN, HY_FFN), HY_FFN ** -0.5)
    hy_b2 = nrm((DEPTH, HY_FFN), 0.02)
    hy_w3 = nrm((DEPTH, HY_FFN, HY_FFN), HY_FFN ** -0.5)
    hy_b3 = nrm((DEPTH, HY_FFN), 0.02)
    hy_w4 = nrm((DEPTH, HY_FFN, HY_ORDER * 2 * HY_CH), 0.02 * HY_FFN ** -0.5)
    hy_freq = 1.0 + nrm((DEPTH, HY_FFN), 0.02)
    hy_skip = 1.0 + nrm((DEPTH, HY_ORDER, HY_CH), 0.1)
    na_rpb = nrm((DEPTH, NA_HEADS, 2 * NA_KR - 1, 2 * NA_KC - 1), 0.02)
    ssm_conv_w = nrm((DEPTH, SSM_CONV, SSM_XBC), SSM_CONV ** -0.5)
    ssm_conv_b = nrm((DEPTH, SSM_XBC), 0.02)
    u = jax.random.uniform(next(ks), (DEPTH, 2, SSM_HEADS), F32)
    dt0 = jnp.exp(u * (math.log(0.1) - math.log(0.001)) + math.log(0.001))
    ssm_dt_bias = dt0 + jnp.log(-jnp.expm1(-dt0))
    ssm_a_log = jnp.log(jax.random.uniform(next(ks), (DEPTH, 2, SSM_HEADS), F32, 1.0, 16.0))
    ssm_d = 1.0 + nrm((DEPTH, SSM_HEADS), 0.02)
    ssm_norm = 1.0 + nrm((DEPTH, SSM_INNER), 0.02)
    mlp_w1 = nrm((DEPTH, D_MODEL, D_FF), D_MODEL ** -0.5)
    mlp_w2 = nrm((DEPTH, D_FF, D_MODEL), D_FF ** -0.5)
    final_norm = 1.0 + nrm((D_MODEL,), 0.02)
    return {"x": x, "c": c, "ctx": ctx, "c_ctx": c_ctx, "ada_w": ada_w, "ada_b": ada_b,
            "norm_mix": norm_mix, "norm_mlp": norm_mlp, "w_in": w_in, "w_out": w_out,
            "attn_sink": attn_sink, "hy_short_w": hy_short_w, "hy_short_b": hy_short_b,
            "hy_w1": hy_w1, "hy_b1": hy_b1, "hy_w2": hy_w2, "hy_b2": hy_b2, "hy_w3": hy_w3,
            "hy_b3": hy_b3, "hy_w4": hy_w4, "hy_freq": hy_freq, "hy_skip": hy_skip,
            "na_rpb": na_rpb, "ssm_conv_w": ssm_conv_w, "ssm_conv_b": ssm_conv_b,
            "ssm_dt_bias": ssm_dt_bias, "ssm_a_log": ssm_a_log, "ssm_d": ssm_d, "ssm_norm": ssm_norm,
            "mlp_w1": mlp_w1, "mlp_w2": mlp_w2, "final_norm": final_norm}


def reference(x, c, ctx, c_ctx, ada_w, ada_b, norm_mix, norm_mlp, w_in, w_out, attn_sink,
              hy_short_w, hy_short_b, hy_w1, hy_b1, hy_w2, hy_b2, hy_w3, hy_b3, hy_w4, hy_freq, hy_skip,
              na_rpb, ssm_conv_w, ssm_conv_b, ssm_dt_bias, ssm_a_log, ssm_d, ssm_norm,
              mlp_w1, mlp_w2, final_norm):
    Bn, S, _ = x.shape
    Lc = ctx.shape[1]
    t = jnp.arange(S)
    row, col = t // GRID_W, t % GRID_W
    xc = ctx
    for i in range(DEPTH):
        last = i == DEPTH - 1
        need_ctx = not last
        mod = (jax.nn.silu(c) @ ada_w[i] + ada_b[i])[:, None, :]
        sh_a, sc_a, g_a, sh_m, sc_m, g_m = jnp.split(mod, 6, axis=-1)
        modc = (jax.nn.silu(c_ctx) @ ada_w[i] + ada_b[i])[None, None, :]
        shc_a, scc_a, gc_a, shc_m, scc_m, gc_m = jnp.split(modc, 6, axis=-1)

        h = rms_norm(x, norm_mix[i]) * (1 + sc_a) + sh_a
        hc = rms_norm(xc, norm_mix[i]) * (1 + scc_a) + shc_a
        p = h @ w_in[i]
        pc = hc @ w_in[i]

        qa, ka, va = split_heads(p[..., :OFF_HY], A_HEADS, A_KV_HEADS)
        qac, kac, vac = split_heads(pc[..., :OFF_HY], A_HEADS, A_KV_HEADS)
        qa = axial_rope(qa, row, col)
        ka = axial_rope(ka, row, col)
        ya = window_attention(qa, ka, va, kac, vac, attn_sink[i])

        filt = hyena_filters(S, hy_w1[i], hy_b1[i], hy_w2[i], hy_b2[i], hy_w3[i], hy_b3[i], hy_w4[i], hy_freq[i])
        yb = hyena_mixer(p[..., OFF_HY:OFF_NA], hy_short_w[i], hy_short_b[i], filt, hy_skip[i])

        qn, kn, vn = split_heads(p[..., OFF_NA:OFF_SSM], NA_HEADS, NA_HEADS)
        qnc, knc, vnc = split_heads(pc[..., OFF_NA:OFF_SSM], NA_HEADS, NA_HEADS)
        yn = neighbourhood_attention(qn, kn, vn, knc, vnc, na_rpb[i])

        zc, xsc, Bc, Cc, dtc = ssm_inputs(pc[..., OFF_SSM:], ssm_conv_w[i], ssm_conv_b[i])
        h0 = jnp.zeros((Bn, SSM_HEADS, SSM_HEAD_DIM, SSM_STATE), F32)
        yc_f, hf = ssm_direction(xsc, Bc, Cc, dtc[:, :, 0], ssm_dt_bias[i, 0], ssm_a_log[i, 0], h0, False, need_ctx)
        yc_b, hb = ssm_direction(xsc, Bc, Cc, dtc[:, :, 1], ssm_dt_bias[i, 1], ssm_a_log[i, 1], h0, True, need_ctx)
        zl, xsl, Bl, Cl, dtl = ssm_inputs(p[..., OFF_SSM:], ssm_conv_w[i], ssm_conv_b[i])
        yl_f, _ = ssm_direction(xsl, Bl, Cl, dtl[:, :, 0], ssm_dt_bias[i, 0], ssm_a_log[i, 0], hf, False, True)
        yl_b, _ = ssm_direction(xsl, Bl, Cl, dtl[:, :, 1], ssm_dt_bias[i, 1], ssm_a_log[i, 1], hb, True, True)
        yd = ssm_output(yl_f + yl_b, xsl, zl, ssm_d[i], ssm_norm[i])

        y = jnp.concatenate([ya, yb, yn, yd], axis=-1)
        x = x + g_a * (y @ w_out[i])

        if need_ctx:
            filt_c = hyena_filters(Lc, hy_w1[i], hy_b1[i], hy_w2[i], hy_b2[i], hy_w3[i], hy_b3[i], hy_w4[i], hy_freq[i])
            yc = jnp.concatenate([
                context_attention(qac, kac, vac, attn_sink[i]),
                hyena_mixer(pc[..., OFF_HY:OFF_NA], hy_short_w[i], hy_short_b[i], filt_c, hy_skip[i]),
                context_attention(qnc, knc, vnc),
                ssm_output(yc_f + yc_b, xsc, zc, ssm_d[i], ssm_norm[i]),
            ], axis=-1)
            xc = xc + gc_a * (yc @ w_out[i])

        hm = rms_norm(x, norm_mlp[i]) * (1 + sc_m) + sh_m
        x = x + g_m * sq_relu_mlp(hm, mlp_w1[i], mlp_w2[i])
        if need_ctx:
            hmc = rms_norm(xc, norm_mlp[i]) * (1 + scc_m) + shc_m
            xc = xc + gc_m * sq_relu_mlp(hmc, mlp_w1[i], mlp_w2[i])
    return rms_norm(x, final_norm)
```

```cpp
#include <hip/hip_runtime.h>
#include <cstdio>
#include <cstdint>
namespace pg8 {
#define PG8_LAS __attribute__((address_space(3)))
typedef unsigned short bf16_t;
typedef short bf16x8 __attribute__((ext_vector_type(8)));
typedef float f32x4 __attribute__((ext_vector_type(4)));
typedef unsigned u32x4 __attribute__((ext_vector_type(4)));
constexpr int BM = 256, BK = 64, HALF = 128, HTB = HALF * BK * 2  , STAGE_BYTES = 8 * HTB, NXCD = 8, WGM = 8;

__host__ __device__ __forceinline__ int lds_byte(int r, int c) { const int st = (r >> 4) * 2 + (c >> 5), rr = r & 15, cc = c & 31, ob = rr * 64 + cc * 2; return st * 1024 + (ob ^ (((ob >> 9) & 1) << 5)); }
__host__ __device__ __forceinline__ void stage_rc(int b, int& R, int& C) { const int st = b / 1024, sb = b % 1024, swz = sb ^ (((sb >> 9) & 1) << 5); R = (st >> 1) * 16 + swz / 64; C = (st & 1) * 32 + (swz % 64) / 2; }
__host__ __device__ __forceinline__ int perm32(int rho) { const int n = rho >> 4, i = rho & 15; return 8 * (i >> 2) + 4 * n + (i & 3); }

struct Unit { int pm, pn; };
struct Gemm { const bf16_t* A; const bf16_t* Bt; int M, N, K; };

struct StaticOrder {
    int nM, nN, nwg, G, c;
    __host__ __device__ void init(int M, int N, int G_, int c_) { nM = M / BM; nN = N / BM; nwg = nM * nN; G = G_; c = c_; }
    __host__ __device__ bool next(int i, Unit& u) const {
        const long L = (long)i * G + c; if (L >= nwg) return false;
        int wgid = (int)L; { const int q = nwg / NXCD, r = nwg % NXCD, xcd = wgid % NXCD, off = wgid / NXCD; wgid = (xcd < r ? xcd * (q + 1) : r * (q + 1) + (xcd - r) * q) + off; }
        const int nig = WGM * nN, gid = wgid / nig, fm = gid * WGM, gsz = (nM - fm) < WGM ? (nM - fm) : WGM;
        u.pm = fm + ((wgid % nig) % gsz); u.pn = (wgid % nig) / gsz; return true;
    }
    __device__ __forceinline__ void a_ready(const Unit&) const {}
    __device__ __forceinline__ void done(const Unit&) const {}
};

__device__ __forceinline__ unsigned cvt_pk_bf16(float lo, float hi) { unsigned r; asm volatile("v_cvt_pk_bf16_f32 %0, %1, %2" : "=v"(r) : "v"(lo), "v"(hi)); return r; }
typedef float f32x2 __attribute__((ext_vector_type(2)));
template <int ACT  > struct EpiStoreBf16 {
    static constexpr bool PERM = true, AFTER_DRAIN = false;
    bf16_t* O; int ldc;
    __device__ __forceinline__ void operator()(const f32x4 (&acc)[2][2][4][2], const Unit& u, int wr, int wc, int fr, int fq) const {
        const int row0 = u.pm * BM + wr * 64 + fr; const int col0 = u.pn * BM + wc * 32 + 8 * fq;
#pragma unroll
        for (int ai = 0; ai < 2; ++ai)
#pragma unroll
            for (int m = 0; m < 4; ++m) { bf16_t* rowp = O + (size_t)(row0 + ai * HALF + m * 16) * ldc + col0;
#pragma unroll
                for (int bj = 0; bj < 2; ++bj) { f32x4 v0 = acc[ai][bj][m][0], v1 = acc[ai][bj][m][1];
                    if (ACT == 1) {
#pragma unroll
                        for (int j = 0; j < 4; ++j) { const float a = fmaxf(v0[j], 0.f), b = fmaxf(v1[j], 0.f); v0[j] = a * a; v1[j] = b * b; } }
                    u32x4 w; w.x = cvt_pk_bf16(v0[0], v0[1]); w.y = cvt_pk_bf16(v0[2], v0[3]); w.z = cvt_pk_bf16(v1[0], v1[1]); w.w = cvt_pk_bf16(v1[2], v1[3]);
                    *(u32x4*)(rowp + bj * HALF) = w; } }
    }
};
struct EpiResid {
    static constexpr bool PERM = false, AFTER_DRAIN = false;
    float* X; const float* gate;
    __device__ __forceinline__ void operator()(const f32x4 (&acc)[2][2][4][2], const Unit& u, int wr, int wc, int fr, int fq) const {
        const int row0 = u.pm * BM + wr * 64 + fr, col0 = u.pn * BM + wc * 32 + 4 * fq;
        const int b = (u.pm < 64) ? (u.pm >> 4) : 4;
        const float* gp = gate + (size_t)b * 12288 + col0;
        f32x4 gv[2][2];
#pragma unroll
        for (int bj = 0; bj < 2; ++bj)
#pragma unroll
            for (int n = 0; n < 2; ++n) gv[bj][n] = *(const f32x4*)(gp + bj * HALF + n * 16);
#pragma unroll
        for (int ai = 0; ai < 2; ++ai)
#pragma unroll
            for (int m = 0; m < 4; ++m) { float* rowp = X + (size_t)(row0 + ai * HALF + m * 16) * 2048 + col0;
#pragma unroll
                for (int bj = 0; bj < 2; ++bj)
#pragma unroll
                    for (int n = 0; n < 2; ++n) { f32x4 x = *(const f32x4*)(rowp + bj * HALF + n * 16); x = x + gv[bj][n] * acc[ai][bj][m][n]; *(f32x4*)(rowp + bj * HALF + n * 16) = x; }
                if (m & 1) asm volatile("" ::: "memory"); }
    }
};

template <class Epi, class Sched, bool ALIGN_EPI = false, bool SP2 = false>
__device__ __forceinline__ void gemm_phase(PG8_LAS unsigned char* lds, const Gemm g, const Sched& S, const Epi& E) {
    int tid_ = threadIdx.x; asm volatile("" : "+v"(tid_));
    const int tid = tid_, wid = __builtin_amdgcn_readfirstlane(tid >> 6), lane = tid & 63, wr = wid >> 2, wc = wid & 3, fr = lane & 15, fq = lane >> 4;
    const int K = g.K, nt = K / BK;
    unsigned voffA[2], voffB[2];
#pragma unroll
    for (int i = 0; i < 2; ++i) { int R, C; stage_rc(tid * 16 + i * 8192, R, C); const int Rb = Epi::PERM ? ((R & ~31) + perm32(R & 31)) : R;
        voffA[i] = (unsigned)(R * K + C) * 2u; voffB[i] = (unsigned)(Rb * K + C) * 2u; }
    const size_t kstep = (size_t)(BK * 2);
    const size_t hstep = (size_t)HALF * K * 2;
    const size_t tstep = 2 * hstep;
    const unsigned ldsw = (unsigned)wid * 1024u;
    const int aoff = lds_byte(wr * 64 + fr, fq * 8), boff = lds_byte(wc * 32 + fr, fq * 8);
#define PG8_SA(b, h) (((b) * 2 + (h)) * HTB)
#define PG8_SB(b, h) ((4 + (b) * 2 + (h)) * HTB)
#define PG8_STAGE(bufoff, gbase, voff) do { _Pragma("unroll") for (int _i = 0; _i < 2; ++_i) \
        __builtin_amdgcn_global_load_lds((const unsigned*)((const char*)(gbase) + (voff)[_i]), (PG8_LAS unsigned*)(lds + (bufoff) + ldsw + _i * 8192), 16, 0, 0); } while (0)
#define PG8_LDA(dst, b, h) do { _Pragma("unroll") for (int m = 0; m < 4; ++m) _Pragma("unroll") for (int k = 0; k < 2; ++k) dst[m][k] = *(const PG8_LAS bf16x8*)(lds + PG8_SA(b, h) + aoff + m * 2048 + k * 1024); } while (0)
#define PG8_LDB(dst, b, h) do { _Pragma("unroll") for (int n = 0; n < 2; ++n) _Pragma("unroll") for (int k = 0; k < 2; ++k) dst[n][k] = *(const PG8_LAS bf16x8*)(lds + PG8_SB(b, h) + boff + n * 2048 + k * 1024); } while (0)
#define PG8_MMA(ai, bj, At, Bt) do { __builtin_amdgcn_s_setprio(1); _Pragma("unroll") for (int m = 0; m < 4; ++m) _Pragma("unroll") for (int n = 0; n < 2; ++n) _Pragma("unroll") for (int k = 0; k < 2; ++k) \
        acc[ai][bj][m][n] = __builtin_amdgcn_mfma_f32_16x16x32_bf16(Bt[n][k], At[m][k], acc[ai][bj][m][n], 0, 0, 0); __builtin_amdgcn_s_setprio(0); } while (0)
#define PG8_WAIT_V(n) asm volatile("s_waitcnt vmcnt(" #n ")" ::: "memory")
#define PG8_WAIT_L(n) asm volatile("s_waitcnt lgkmcnt(" #n ")" ::: "memory")
#define PG8_BAR __builtin_amdgcn_s_barrier()
#define PG8_SCHED __builtin_amdgcn_sched_barrier(0)
    Unit cur, nxt; int ui = 0;
    if (!S.next(0, cur)) return;
    f32x4 acc[2][2][4][2];
#pragma unroll
    for (int a = 0; a < 2; ++a)
#pragma unroll
        for (int b = 0; b < 2; ++b)
#pragma unroll
            for (int m = 0; m < 4; ++m)
#pragma unroll
                for (int n = 0; n < 2; ++n) acc[a][b][m][n] = (f32x4){0.f, 0.f, 0.f, 0.f};
    bf16x8 At[4][2], B0[2][2], B1[2][2];
    const char* cA = (const char*)g.A + (size_t)cur.pm * tstep; const char* cB = (const char*)g.Bt + (size_t)cur.pn * tstep;
    S.a_ready(cur);
    if constexpr (SP2) {
        PG8_STAGE(PG8_SB(0, 0), cB, voffB); PG8_STAGE(PG8_SB(0, 1), cB + hstep, voffB); PG8_STAGE(PG8_SA(0, 0), cA, voffA); PG8_STAGE(PG8_SA(0, 1), cA + hstep, voffA);
        if (wr == 1) PG8_BAR;
        PG8_WAIT_V(2); PG8_BAR;
        PG8_STAGE(PG8_SB(1, 0), cB + kstep, voffB); PG8_STAGE(PG8_SA(1, 0), cA + kstep, voffA); PG8_STAGE(PG8_SB(1, 1), cB + hstep + kstep, voffB);
        PG8_WAIT_V(6); PG8_BAR;
    } else {
        PG8_STAGE(PG8_SB(0, 0), cB, voffB); PG8_STAGE(PG8_SA(0, 0), cA, voffA); PG8_STAGE(PG8_SB(0, 1), cB + hstep, voffB); PG8_STAGE(PG8_SA(0, 1), cA + hstep, voffA);
        if (wr == 1) PG8_BAR;
        PG8_WAIT_V(4); PG8_BAR;
        PG8_STAGE(PG8_SB(1, 0), cB + kstep, voffB); PG8_STAGE(PG8_SA(1, 0), cA + kstep, voffA); PG8_STAGE(PG8_SB(1, 1), cB + hstep + kstep, voffB);
        PG8_WAIT_V(6); PG8_BAR;
    }
    for (;;) {
        const bool has_next = S.next(ui + 1, nxt);
        const char* nA = has_next ? (const char*)g.A + (size_t)nxt.pm * tstep : cA; const char* nB = has_next ? (const char*)g.Bt + (size_t)nxt.pn * tstep : cB;
        for (int t = 0; t < nt; t += 2) {
            const bool last = (t == nt - 2);
            const char* a1 = cA + (size_t)(t + 1) * kstep;
            const char* a2 = last ? nA : cA + (size_t)(t + 2) * kstep; const char* b2 = last ? nB : cB + (size_t)(t + 2) * kstep;
            const char* a3 = a2 + kstep; const char* b3 = b2 + kstep;
            if (last && has_next) S.a_ready(nxt);
            if constexpr (SP2) {
            PG8_LDB(B0, 0, 0); PG8_LDB(B1, 0, 1); PG8_SCHED; PG8_LDA(At, 0, 0); PG8_STAGE(PG8_SA(1, 1), a1 + hstep, voffA);
            PG8_WAIT_V(8); PG8_WAIT_L(0); PG8_BAR; PG8_MMA(0, 0, At, B0); PG8_MMA(0, 1, At, B1); PG8_BAR; PG8_SCHED;
            PG8_LDA(At, 0, 1); PG8_STAGE(PG8_SB(0, 0), b2, voffB); PG8_STAGE(PG8_SB(0, 1), b2 + hstep, voffB); PG8_STAGE(PG8_SA(0, 0), a2, voffA);
            PG8_WAIT_V(8); PG8_WAIT_L(0); PG8_BAR; PG8_MMA(1, 0, At, B0); PG8_MMA(1, 1, At, B1); PG8_BAR; PG8_SCHED;
            PG8_LDB(B0, 1, 0); PG8_LDB(B1, 1, 1); PG8_SCHED; PG8_LDA(At, 1, 0); PG8_STAGE(PG8_SA(0, 1), a2 + hstep, voffA);
            PG8_WAIT_V(8); PG8_WAIT_L(0); PG8_BAR; PG8_MMA(0, 0, At, B0); PG8_MMA(0, 1, At, B1); PG8_BAR; PG8_SCHED;
            PG8_LDA(At, 1, 1); PG8_STAGE(PG8_SB(1, 0), b3, voffB); PG8_STAGE(PG8_SB(1, 1), b3 + hstep, voffB); PG8_STAGE(PG8_SA(1, 0), a3, voffA);
            PG8_WAIT_V(8); PG8_WAIT_L(0); PG8_BAR; PG8_MMA(1, 0, At, B0); PG8_MMA(1, 1, At, B1); PG8_BAR; PG8_SCHED;
            } else {
            PG8_LDB(B0, 0, 0); PG8_SCHED; PG8_LDA(At, 0, 0); PG8_STAGE(PG8_SA(1, 1), a1 + hstep, voffA);
            PG8_WAIT_L(8); PG8_BAR; PG8_WAIT_L(0); PG8_MMA(0, 0, At, B0); PG8_BAR; PG8_SCHED;
            PG8_LDB(B1, 0, 1); PG8_STAGE(PG8_SB(0, 0), b2, voffB);
            PG8_BAR; PG8_WAIT_L(0); PG8_MMA(0, 1, At, B1); PG8_BAR;
            PG8_LDA(At, 0, 1); PG8_STAGE(PG8_SA(0, 0), a2, voffA);
            PG8_BAR; PG8_WAIT_L(0); PG8_MMA(1, 0, At, B0); PG8_BAR; PG8_SCHED;
            PG8_STAGE(PG8_SB(0, 1), b2 + hstep, voffB);
            PG8_WAIT_V(6); PG8_BAR; PG8_MMA(1, 1, At, B1); PG8_BAR;
            PG8_LDB(B0, 1, 0); PG8_SCHED; PG8_LDA(At, 1, 0); PG8_STAGE(PG8_SA(0, 1), a2 + hstep, voffA);
            PG8_WAIT_L(8); PG8_BAR; PG8_WAIT_L(0); PG8_MMA(0, 0, At, B0); PG8_BAR; PG8_SCHED;
            PG8_LDB(B1, 1, 1); PG8_STAGE(PG8_SB(1, 0), b3, voffB);
            PG8_BAR; PG8_WAIT_L(0); PG8_MMA(0, 1, At, B1); PG8_BAR;
            PG8_LDA(At, 1, 1); PG8_STAGE(PG8_SA(1, 0), a3, voffA);
            PG8_BAR; PG8_WAIT_L(0); PG8_MMA(1, 0, At, B0); PG8_BAR; PG8_SCHED;
            PG8_STAGE(PG8_SB(1, 1), b3 + hstep, voffB);
            PG8_WAIT_V(6); PG8_BAR; PG8_MMA(1, 1, At, B1); PG8_BAR;
            }
        }
        if constexpr (ALIGN_EPI) { if (wr == 0) PG8_BAR; }
        if constexpr (!Epi::AFTER_DRAIN) { E(acc, cur, wr, wc, fr, fq); S.done(cur); }
        if (!has_next) break;
#pragma unroll
        for (int a = 0; a < 2; ++a)
#pragma unroll
            for (int b = 0; b < 2; ++b)
#pragma unroll
                for (int m = 0; m < 4; ++m)
#pragma unroll
                    for (int n = 0; n < 2; ++n) acc[a][b][m][n] = (f32x4){0.f, 0.f, 0.f, 0.f};
        cur = nxt; cA = nA; cB = nB; ++ui;
        if constexpr (ALIGN_EPI) { if (wr == 1) PG8_BAR; }
    }
    PG8_WAIT_V(0);
    if constexpr (!ALIGN_EPI) { if (wr == 0) PG8_BAR; }
    PG8_BAR;
    if constexpr (Epi::AFTER_DRAIN) { E.fused(acc, cur, wr, wc, fr, fq, lds, wid, lane); S.done(cur); }
#undef PG8_SA
#undef PG8_SB
#undef PG8_STAGE
#undef PG8_LDA
#undef PG8_LDB
#undef PG8_MMA
#undef PG8_WAIT_V
#undef PG8_WAIT_L
#undef PG8_BAR
#undef PG8_SCHED
}
}
#define GAS __attribute__((address_space(1)))
#define LAS __attribute__((address_space(3)))
typedef unsigned short bf16;
typedef unsigned v4u __attribute__((ext_vector_type(4)));
typedef float f32x4 __attribute__((ext_vector_type(4)));
typedef short bf16x8 __attribute__((ext_vector_type(8)));
typedef GAS unsigned gu32;
typedef GAS unsigned long long gu64;
#define RLX_AGENT __ATOMIC_RELAXED, __HIP_MEMORY_SCOPE_AGENT
#define LDS_WAIT() asm volatile("s_waitcnt lgkmcnt(0)" ::: "memory")
#define VM_WAIT() asm volatile("s_waitcnt vmcnt(0)" ::: "memory")
__device__ __forceinline__ unsigned long long rt() { return __builtin_amdgcn_s_memrealtime(); }
__device__ __forceinline__ unsigned f2bf(float f) { unsigned u = __builtin_bit_cast(unsigned, f); return (u + 0x7fffu + ((u >> 16) & 1u)) >> 16; }
__device__ __forceinline__ unsigned pk2(float lo, float hi) { return f2bf(lo) | (f2bf(hi) << 16); }
#define XB_TMO      128
#define XB_XCNT(j)  (256  + 64 * (j))
#define XB_XSUB(j)  (1280 + 64 * (j))
#define XB_XGEN(j)  (2304 + 64 * (j))
#define XB_TOP      3328
#define XB_TOPGEN   3392
#define XCD_BAR_WORDS 3456
#define XB_SPIN_CAP (1u << 18)

__device__ __forceinline__ unsigned xb_ld(unsigned* p)              { return __hip_atomic_load(p, __ATOMIC_RELAXED, __HIP_MEMORY_SCOPE_AGENT); }
__device__ __forceinline__ unsigned xb_add(unsigned* p, unsigned v) { return __hip_atomic_fetch_add(p, v, __ATOMIC_RELAXED, __HIP_MEMORY_SCOPE_AGENT); }
__device__ __forceinline__ unsigned xb_xcc_id() { return (unsigned)__builtin_amdgcn_s_getreg((3 << 11) | 20) & 0xFu; }
#define XB_SPIN(cond, bar) do { unsigned _sp = 0; while (cond) { __builtin_amdgcn_s_sleep(1); \
    if ((++_sp & 255u) == 0u) { if (xb_ld(&(bar)[XB_TMO])) break; if (_sp > XB_SPIN_CAP) { atomicAdd(&(bar)[XB_TMO], 1u); break; } } } } while (0)

struct XcdBarrier {
    unsigned* bar; unsigned x;
    volatile LAS unsigned* st;
};

__device__ __forceinline__ XcdBarrier xcd_barrier_post(unsigned* bar, volatile LAS unsigned* st) {
    XcdBarrier b; b.bar = bar; b.x = xb_xcc_id(); b.st = st;
    if (threadIdx.x == 0) (void)xb_add(&bar[XB_XCNT(b.x)], 1u);
    return b;
}
__device__ __forceinline__ void xcd_barrier_complete(unsigned* bar, unsigned x, unsigned& nloc, unsigned& nx) {
    const unsigned G = gridDim.x * gridDim.y * gridDim.z;
    unsigned sum, cnt, mine, sp = 0u;
    for (;;) {
        sum = 0u; cnt = 0u; mine = 0u;
#pragma unroll
        for (unsigned j = 0; j < 16; ++j) { const unsigned c = xb_ld(&bar[XB_XCNT(j)]); sum += c; cnt += (c > 0u) ? 1u : 0u; mine = (j == x) ? c : mine; }
        if (sum == G) break;
        __builtin_amdgcn_s_sleep(1);
        if ((++sp & 255u) == 0u) { if (xb_ld(&bar[XB_TMO])) break; if (sp > XB_SPIN_CAP) { atomicAdd(&bar[XB_TMO], 1u); break; } }
    }
    nloc = mine > 0u ? mine : 1u; nx = cnt > 0u ? cnt : 1u;
}

__device__ __forceinline__ void xcd_barrier(const XcdBarrier& b) {
    asm volatile("s_waitcnt vmcnt(0)" ::: "memory");
    __syncthreads();
    if (threadIdx.x == 0) {
        unsigned* bar = b.bar;
        __builtin_amdgcn_s_waitcnt(0);
        unsigned nloc = b.st[0], nx = b.st[1];
        if (nloc == 0u) { xcd_barrier_complete(bar, b.x, nloc, nx); b.st[0] = nloc; b.st[1] = nx; }
        const unsigned old = xb_add(&bar[XB_XSUB(b.x)], 1u);
        const unsigned gen = old / nloc;
        if (old + 1u == (gen + 1u) * nloc) {
            __builtin_amdgcn_fence(__ATOMIC_RELEASE, "agent");
            asm volatile("s_waitcnt vmcnt(0)" ::: "memory");
            const unsigned og = xb_add(&bar[XB_TOP], 1u);
            const unsigned tg = og / nx;
            if (og + 1u == (tg + 1u) * nx) xb_add(&bar[XB_TOPGEN], 1u);
            else XB_SPIN(xb_ld(&bar[XB_TOPGEN]) == tg, bar);
            __builtin_amdgcn_fence(__ATOMIC_ACQUIRE, "agent");
            xb_add(&bar[XB_XGEN(b.x)], 1u);
            asm volatile("s_waitcnt vmcnt(0)" ::: "memory");
        } else {
            XB_SPIN(xb_ld(&bar[XB_XGEN(b.x)]) == gen, bar);
            __builtin_amdgcn_fence(__ATOMIC_ACQUIRE, "agent");
            asm volatile("s_waitcnt vmcnt(0)" ::: "memory");
        }
    }
    __syncthreads();
}

constexpr int DM = 2048, NB = 4, SEQ = 4096, LC = 256, DEPTH = 4, DFF = 8192;
constexpr int M_LAT = NB * SEQ, M_CTX = NB * LC, M_ALL = M_LAT + M_CTX;
constexpr int N_IN = 5392, N_INP = 5632;
constexpr int OFF_HY = 768, OFF_NA = 2304, OFF_SSM = 3840;
constexpr int NWAVES = 8, NTHR = 512;
constexpr float EPS = 1e-6f;

constexpr size_t MiB = 1u << 20;
constexpr size_t WS_CTL = 0, CTL_ZERO_BYTES = 1 * MiB;
constexpr size_t WS_MOD = 1 * MiB;
constexpr size_t WS_MODP = 2 * MiB;
constexpr size_t WS_ROPE = 10 * MiB;
constexpr size_t WS_GLAT = 11 * MiB;
constexpr size_t WS_GCTX = 43 * MiB;
constexpr size_t WS_W = 48 * MiB;
constexpr size_t W_LAYER = 94 * MiB, W_OUT_OFF = 22 * MiB, W_1_OFF = 30 * MiB, W_2_OFF = 62 * MiB;
constexpr size_t WS_X = 424 * MiB;
constexpr size_t WS_XN = 560 * MiB;
constexpr size_t WS_P = 628 * MiB;
constexpr size_t WS_Y = 815 * MiB;
constexpr size_t WS_H = 883 * MiB;
constexpr size_t WS_XBC = 1155 * MiB;
constexpr size_t WS_DT = 1223 * MiB;
constexpr size_t WS_YF = 1226 * MiB;
constexpr size_t WS_YB = 1260 * MiB;
constexpr size_t WS_HU = 1294 * MiB;
constexpr size_t WS_Z = 1396 * MiB;
constexpr size_t WS_END = 1430 * MiB;
constexpr int CW_BAR = 4096;

constexpr int RING_BYTES = 131072, MISC_OFF = RING_BYTES, LDS_BYTES = RING_BYTES + 1024;

constexpr int PH_PRO1 = 0, PH_PRO2 = 1, PH_L0 = 2, PH_PER_LAYER = 9, PH_FINAL = PH_L0 + DEPTH * PH_PER_LAYER, N_PHASES = PH_FINAL + 1;
#ifndef MK_SPLIT
#define MK_SPLIT 0
#endif

__device__ __forceinline__ float bf2f(bf16 h) { return __uint_as_float(((unsigned)h) << 16); }
__device__ __forceinline__ float wave_sum(float v) {
#pragma unroll
    for (int o = 1; o < 64; o <<= 1) v += __shfl_xor(v, o);
    return v;
}
__device__ __forceinline__ float wave_max(float v) {
#pragma unroll
    for (int o = 1; o < 64; o <<= 1) v = fmaxf(v, __shfl_xor(v, o));
    return v;
}
__device__ __forceinline__ float silu_f(float v) { return v / (1.f + __expf(-v)); }

struct Ctx {
    LAS unsigned char* lds;
    int tid, lane, wave, G, gw, NGW;
};
__device__ __forceinline__ void launder(Ctx& C) { int t = threadIdx.x; asm volatile("" : "+v"(t)); C.tid = t; C.lane = t & 63; C.wave = __builtin_amdgcn_readfirstlane(t >> 6); C.gw = blockIdx.x * NWAVES + C.wave; }
struct Args { const float* in[32]; float* out; unsigned char* ws; int ph_lo, ph_hi; };

__device__ __forceinline__ void transpose_item(const float* W, int K, int N, bf16* WT, LAS float* scr, int kb, int nb, int lane) {
    const int k0 = 64 * kb, n0 = 32 * nb;
    const int nn = n0 + (lane & 31); const bool okn = nn < N;
#pragma unroll 8
    for (int i = 0; i < 32; ++i) { const int kk = 2 * i + (lane >> 5); scr[kk * 33 + (lane & 31)] = okn ? W[(size_t)(k0 + kk) * N + nn] : 0.f; }
    LDS_WAIT(); asm volatile("" ::: "memory");
    const int c = lane & 7;
#pragma unroll
    for (int j = 0; j < 4; ++j) { const int n = (lane >> 3) + 8 * j; const LAS float* s = scr + (8 * c) * 33 + n;
        v4u o; o.x = pk2(s[0 * 33], s[1 * 33]); o.y = pk2(s[2 * 33], s[3 * 33]); o.z = pk2(s[4 * 33], s[5 * 33]); o.w = pk2(s[6 * 33], s[7 * 33]);
        *(v4u*)(WT + (size_t)(n0 + n) * K + k0 + 8 * c) = o; }
    LDS_WAIT(); asm volatile("" ::: "memory");
}

__device__ __forceinline__ void phase_pro1(const Ctx& C, const Args& A) {
    LAS float* sl = (LAS float*)C.lds;
    const float* cvec = A.in[1]; const float* cctx = A.in[3]; const float* ada_w = A.in[4];
    float* modp = (float*)(A.ws + WS_MODP);
    for (int u = blockIdx.x; u < 768; u += C.G) {
        const int layer = u / 192, r = u % 192, kc = r / 24, nb = r % 24;
        __syncthreads();
        for (int i = C.tid; i < 5 * 256; i += NTHR) { const int b = i >> 8, kk = i & 255, k = kc * 256 + kk; const float v = (b < 4) ? cvec[b * DM + k] : cctx[k]; sl[i] = v / (1.f + expf(-v)); }
        __syncthreads();
        const int n = nb * 512 + C.tid; const float* w = ada_w + ((size_t)layer * DM + kc * 256) * 12288 + n;
        float a0 = 0.f, a1 = 0.f, a2 = 0.f, a3 = 0.f, a4 = 0.f;
#pragma unroll 8
        for (int kk = 0; kk < 256; ++kk) { const float wv = w[(size_t)kk * 12288]; a0 += sl[kk] * wv; a1 += sl[256 + kk] * wv; a2 += sl[512 + kk] * wv; a3 += sl[768 + kk] * wv; a4 += sl[1024 + kk] * wv; }
        float* o = modp + ((size_t)(kc * 4 + layer) * 5) * 12288 + n;
        o[0] = a0; o[12288] = a1; o[2 * 12288] = a2; o[3 * 12288] = a3; o[4 * 12288] = a4;
    }
    __syncthreads();
    if (blockIdx.x == 0) { float* rc = (float*)(A.ws + WS_ROPE); float* rs = rc + 1024;
        for (int i = C.tid; i < 1024; i += NTHR) { const int pos = i >> 4, j = i & 15; const float inv = powf(10000.f, -(float)j / 16.f); const float ang = (float)pos * inv; rc[i] = cosf(ang); rs[i] = sinf(ang); } }
    { const f32x4* xs = (const f32x4*)A.in[0]; const f32x4* cs = (const f32x4*)A.in[2]; f32x4* X = (f32x4*)(A.ws + WS_X);
      const size_t nl = (size_t)M_LAT * DM / 4, nc = (size_t)M_CTX * DM / 4;
      for (size_t i = (size_t)blockIdx.x * NTHR + C.tid; i < nl + nc; i += (size_t)C.G * NTHR) X[i] = (i < nl) ? xs[i] : cs[i - nl]; }
    LAS float* scr = (LAS float*)(C.lds + C.wave * 16384);
    constexpr int I_IN = 32 * 176, I_OUT = 32 * 64, I_1 = 32 * 256, I_2 = 128 * 64, I_LAYER = I_IN + I_OUT + I_1 + I_2;
    for (int it = C.gw; it < DEPTH * I_LAYER; it += C.NGW) {
        const int layer = it / I_LAYER; int r = it % I_LAYER;
        bf16* wl = (bf16*)(A.ws + WS_W + (size_t)layer * W_LAYER);
        if (r < I_IN) { transpose_item(A.in[8] + (size_t)layer * DM * N_IN, DM, N_IN, wl, scr, r / 176, r % 176, C.lane); continue; } r -= I_IN;
        if (r < I_OUT) { transpose_item(A.in[9] + (size_t)layer * DM * DM, DM, DM, (bf16*)((unsigned char*)wl + W_OUT_OFF), scr, r / 64, r % 64, C.lane); continue; } r -= I_OUT;
        if (r < I_1) { transpose_item(A.in[29] + (size_t)layer * DM * DFF, DM, DFF, (bf16*)((unsigned char*)wl + W_1_OFF), scr, r / 256, r % 256, C.lane); continue; } r -= I_1;
        transpose_item(A.in[30] + (size_t)layer * DFF * DM, DFF, DM, (bf16*)((unsigned char*)wl + W_2_OFF), scr, r / 64, r % 64, C.lane);
    }
}
__device__ __forceinline__ void phase_pro2(const Ctx& C, const Args& A) {
    const float* modp = (const float*)(A.ws + WS_MODP); const float* ada_b = A.in[5]; float* mod = (float*)(A.ws + WS_MOD);
    for (int i = blockIdx.x * NTHR + C.tid; i < DEPTH * 5 * 12288; i += C.G * NTHR) {
        const int layer = i / (5 * 12288), r = i % (5 * 12288), n = r % 12288;
        float s = ada_b[layer * 12288 + n];
#pragma unroll
        for (int kc = 0; kc < 8; ++kc) s += modp[(size_t)(kc * 4 + layer) * 5 * 12288 + r];
        mod[i] = s;
    }
}

__device__ __forceinline__ void norm_row(const float* xrow, const float* nw, const float* sh, const float* sc, bf16* orow, int lane) {
    const f32x4* xr = (const f32x4*)xrow; f32x4 v[8]; float s = 0.f;
#pragma unroll
    for (int j = 0; j < 8; ++j) { v[j] = xr[lane + 64 * j]; s += (v[j].x * v[j].x + v[j].y * v[j].y) + (v[j].z * v[j].z + v[j].w * v[j].w); }
    const float rstd = 1.0f / sqrtf(wave_sum(s) * (1.f / DM) + EPS);
#pragma unroll
    for (int j = 0; j < 8; ++j) { const int c4 = lane + 64 * j; const f32x4 w = ((const f32x4*)nw)[c4], a = ((const f32x4*)sc)[c4], b = ((const f32x4*)sh)[c4];
        const f32x4 y = v[j] * rstd * w * (a + 1.0f) + b;
        *(unsigned long long*)(orow + 4 * c4) = (unsigned long long)pk2(y.x, y.y) | ((unsigned long long)pk2(y.z, y.w) << 32); }
}
__device__ __forceinline__ void phase_norm(const Ctx& C, const Args& A, int layer, int which  , int nrows) {
    const float* X = (const float*)(A.ws + WS_X); bf16* XN = (bf16*)(A.ws + WS_XN);
    const float* nw = A.in[which ? 7 : 6] + layer * DM;
    const float* mod = (const float*)(A.ws + WS_MOD) + (size_t)layer * 5 * 12288 + (which ? 3 * DM : 0);
    for (int m = C.gw; m < nrows; m += C.NGW) { const int b = (m < M_LAT) ? (m >> 12) : 4; const float* mb = mod + (size_t)b * 12288;
        norm_row(X + (size_t)m * DM, nw, mb, mb + DM, XN + (size_t)m * DM, C.lane); }
}
__device__ __forceinline__ void phase_final(const Ctx& C, const Args& A) {
    const float* X = (const float*)(A.ws + WS_X); const float* nw = A.in[31];
    for (int m = C.gw; m < M_LAT; m += C.NGW) {
        const f32x4* xr = (const f32x4*)(X + (size_t)m * DM); f32x4 v[8]; float s = 0.f;
#pragma unroll
        for (int j = 0; j < 8; ++j) { v[j] = xr[C.lane + 64 * j]; s += (v[j].x * v[j].x + v[j].y * v[j].y) + (v[j].z * v[j].z + v[j].w * v[j].w); }
        const float rstd = 1.0f / sqrtf(wave_sum(s) * (1.f / DM) + EPS);
        f32x4* o = (f32x4*)(A.out + (size_t)m * DM);
#pragma unroll
        for (int j = 0; j < 8; ++j) { const int c4 = C.lane + 64 * j; o[c4] = v[j] * rstd * ((const f32x4*)nw)[c4]; }
    }
}

__device__ __forceinline__ void hy_filter_item(const Ctx& C, const Args& A, int layer, int L, int t, float* G) {
    const int lane = C.lane;
    const float* w1 = A.in[13] + layer * 33 * 64; const float* b1 = A.in[14] + layer * 64; const float* w2 = A.in[15] + layer * 4096; const float* b2 = A.in[16] + layer * 64;
    const float* w3 = A.in[17] + layer * 4096; const float* b3 = A.in[18] + layer * 64; const float* w4 = A.in[19] + (size_t)layer * 64 * 2048; const float* fr = A.in[20] + layer * 64;
    const float* skip = A.in[21] + layer * 1024;
    const float tl = (float)t / (float)(L - 1);
    const float wpos = (6.283185307179586f * (float)t) / (float)L;
    float z = 0.f;
    if (lane == 0) z = tl;
    else if (lane <= 32) { const int k = (lane - 1) & 15; const float f = 1e-4f + (float)k * ((15.0f - 1e-4f) / 15.0f); const float a = f * wpos; z = (lane <= 16) ? cosf(a) : -sinf(a); }
    const float frl = fr[lane];
    float pre = b1[lane];
    for (int e = 0; e < 33; ++e) pre += __shfl(z, e) * w1[e * 64 + lane];
    float h = sinf(frl * pre);
    pre = b2[lane];
    for (int i = 0; i < 64; ++i) pre += __shfl(h, i) * w2[i * 64 + lane];
    h = sinf(frl * pre);
    pre = b3[lane];
    for (int i = 0; i < 64; ++i) pre += __shfl(h, i) * w3[i * 64 + lane];
    h = sinf(frl * pre);
    float acc[32];
#pragma unroll
    for (int cc = 0; cc < 32; ++cc) acc[cc] = 0.f;
    for (int i = 0; i < 64; ++i) { const float hi = __shfl(h, i); const float* wr = w4 + (size_t)i * 2048 + lane;
#pragma unroll
        for (int cc = 0; cc < 32; ++cc) acc[cc] += hi * wr[cc * 64]; }
    const float dmin = 3.0701134573253945f, dmax = 15.350567286626973f;
    const int W = 2 * L - 1;
#pragma unroll
    for (int cc = 0; cc < 32; ++cc) { const int col = cc * 64 + lane, o = col >> 10, r = (col >> 9) & 1, c = col & 511;
        const float delta = dmin + (float)c * ((dmax - dmin) / 511.0f);
        float val = acc[cc] * expf(-tl * delta);
        if (r == 0) { if (t == 0) val += skip[o * 512 + c]; G[((size_t)o * W + (L - 1 + t)) * 512 + c] = val; }
        else if (t > 0) G[((size_t)o * W + (L - 1 - t)) * 512 + c] = val; }
}

__device__ __forceinline__ void prep_row(const Ctx& C, const Args& A, int layer, int row) {
    const int lane = C.lane;
    bf16* P = (bf16*)(A.ws + WS_P); bf16* prow = P + (size_t)row * N_INP;
    int t, L; if (row < M_LAT) { t = row & 4095; L = SEQ; } else { t = (row - M_LAT) & 255; L = LC; }
    const bool hp = t > 0, hn = t < L - 1;
    const bf16* pm = prow - N_INP; const bf16* pp = prow + N_INP;
    if (row < M_LAT) {
        const float* rc = (const float*)(A.ws + WS_ROPE); const float* rs = rc + 1024; const int r = t >> 6, c = t & 63;
#pragma unroll
        for (int i = 0; i < 5; ++i) { const int q = lane + 64 * i, head = q >> 5, w = q & 31, half = w >> 4, j = w & 15, d1 = head * 64 + half * 32 + j, pos = half ? c : r;
            const float cs = rc[pos * 16 + j], sn = rs[pos * 16 + j], x1 = bf2f(prow[d1]), x2 = bf2f(prow[d1 + 16]);
            prow[d1] = (bf16)f2bf(x1 * cs - x2 * sn); prow[d1 + 16] = (bf16)f2bf(x2 * cs + x1 * sn); }
    }
    { const float* cw = A.in[23] + layer * 3 * 1024; const float* cb = A.in[24] + layer * 1024; float* XBC = (float*)(A.ws + WS_XBC) + (size_t)row * 1024;
#pragma unroll 4
      for (int i = 0; i < 16; ++i) { const int ch = lane + 64 * i, col = OFF_SSM + 512 + ch;
          float a = cb[ch] + cw[1024 + ch] * bf2f(prow[col]); if (hp) a += cw[ch] * bf2f(pm[col]); if (hn) a += cw[2048 + ch] * bf2f(pp[col]);
          XBC[ch] = silu_f(a); }
      if (lane < 16) { const float raw = bf2f(prow[OFF_SSM + 1536 + lane]) + A.in[25][layer * 16 + lane]; const float dt = raw > 20.f ? raw : log1pf(expf(raw));
          const float Aneg = -expf(A.in[26][layer * 16 + lane]); float* DT = (float*)(A.ws + WS_DT);
          DT[(size_t)row * 16 + lane] = dt; DT[(size_t)M_ALL * 16 + (size_t)row * 16 + lane] = expf(Aneg * dt); } }
    { const float* sw = A.in[11] + layer * 3 * 1536; const float* sb = A.in[12] + layer * 1536; float* HU = (float*)(A.ws + WS_HU) + (size_t)row * 1536;
#pragma unroll 4
      for (int i = 0; i < 24; ++i) { const int ch = lane + 64 * i, col = OFF_HY + ch;
          float a = sb[ch] + sw[1536 + ch] * bf2f(prow[col]); if (hp) a += sw[ch] * bf2f(pm[col]); if (hn) a += sw[3072 + ch] * bf2f(pp[col]);
          HU[ch] = a; } }
}

struct KD_A_lat { int b, t;
    __device__ __forceinline__ bool operator()(int idx, int& row, float& bias) const { bias = 0.f;
        if (idx < 257) { const int kp = t - 128 + idx; row = b * SEQ + kp; return kp >= 0 && kp < SEQ; }
        if (idx < 513) { row = M_LAT + b * LC + (idx - 257); return true; }
        row = 0; return false; } };
struct KD_ctx { int b;
    __device__ __forceinline__ bool operator()(int idx, int& row, float& bias) const { bias = 0.f; row = M_LAT + b * LC + idx; return idx < 256; } };
struct KD_NA_lat { int b, r, c, rstart, cstart; const float* rpb;
    __device__ __forceinline__ bool operator()(int idx, int& row, float& bias) const {
        if (idx < 128) { const int kr = rstart + (idx >> 4), kc = cstart + (idx & 15); row = b * SEQ + kr * 64 + kc; bias = rpb[(kr - r + 7) * 31 + (kc - c + 15)]; return true; }
        bias = 0.f; row = M_LAT + b * LC + (idx - 128); return idx < 384; } };

template <int NT, class KD>
__device__ __forceinline__ void attn_wave(const bf16* P, const bf16* qptr, int kcol, int vcol, const KD& kd, bool has_sink, float sink, bf16* optr, LAS float* pl, int lane) {
    LAS float* ql = pl + 640;
    ql[lane] = bf2f(qptr[lane]) * 0.125f;
    LDS_WAIT(); asm volatile("" ::: "memory");
    float sc[NT]; float mx = has_sink ? sink : -1e30f;
#pragma unroll
    for (int i = 0; i < NT; ++i) { const int idx = lane + 64 * i; int row; float bias; const bool ok = kd(idx, row, bias);
        float s = -1e30f;
        if (ok) { const v4u* kp = (const v4u*)(P + (size_t)row * N_INP + kcol); float a = 0.f;
#pragma unroll
            for (int c8 = 0; c8 < 8; ++c8) { const v4u w = kp[c8]; const f32x4 q0 = *(const LAS f32x4*)(ql + c8 * 8), q1 = *(const LAS f32x4*)(ql + c8 * 8 + 4);
                a += __uint_as_float(w.x << 16) * q0.x + __uint_as_float(w.x & 0xffff0000u) * q0.y + __uint_as_float(w.y << 16) * q0.z + __uint_as_float(w.y & 0xffff0000u) * q0.w
                   + __uint_as_float(w.z << 16) * q1.x + __uint_as_float(w.z & 0xffff0000u) * q1.y + __uint_as_float(w.w << 16) * q1.z + __uint_as_float(w.w & 0xffff0000u) * q1.w; }
            s = a + bias; }
        sc[i] = s; mx = fmaxf(mx, s); }
    mx = wave_max(mx);
    float l = 0.f;
#pragma unroll
    for (int i = 0; i < NT; ++i) { const float p = (sc[i] > -1e29f) ? __expf(sc[i] - mx) : 0.f; pl[lane + 64 * i] = p; l += p; }
    l = wave_sum(l); if (has_sink) l += __expf(sink - mx);
    LDS_WAIT(); asm volatile("" ::: "memory");
    float o = 0.f;
#pragma unroll 8
    for (int idx = 0; idx < NT * 64; ++idx) { int row; float bias; const bool ok = kd(idx, row, bias);
        if (ok) o += pl[idx] * bf2f(P[(size_t)row * N_INP + vcol + lane]); }
    optr[lane] = (bf16)f2bf(o / l);
    LDS_WAIT(); asm volatile("" ::: "memory");
}

__device__ __forceinline__ void phase_attn(const Ctx& C, const Args& A, int layer, bool need_ctx) {
    const bf16* P = (const bf16*)(A.ws + WS_P); bf16* Y = (bf16*)(A.ws + WS_Y);
    LAS float* pl = (LAS float*)(C.lds + 65536 + C.wave * 4096);
    const float* sinkp = A.in[10] + layer * 8; const float* rpb = A.in[22] + (size_t)layer * 8 * 15 * 31;
    const int nA = M_LAT * 8, nAc = need_ctx ? M_CTX * 8 : 0, nN = M_LAT * 8, nNc = need_ctx ? M_CTX * 8 : 0;
    for (int it = C.gw; it < nA + nAc + nN + nNc; it += C.NGW) {
        int r = it;
        if (r < nA) { const int row = r >> 3, h = r & 7, b = row >> 12, t = row & 4095; KD_A_lat kd{b, t};
            attn_wave<9>(P, P + (size_t)row * N_INP + h * 64, 512 + (h >> 2) * 64, 640 + (h >> 2) * 64, kd, true, sinkp[h], Y + (size_t)row * DM + h * 64, pl, C.lane); continue; } r -= nA;
        if (r < nAc) { const int rc = r >> 3, h = r & 7, b = rc >> 8, row = M_LAT + rc; KD_ctx kd{b};
            attn_wave<4>(P, P + (size_t)row * N_INP + h * 64, 512 + (h >> 2) * 64, 640 + (h >> 2) * 64, kd, true, sinkp[h], Y + (size_t)row * DM + h * 64, pl, C.lane); continue; } r -= nAc;
        if (r < nN) { const int row = r >> 3, h = r & 7, b = row >> 12, t = row & 4095, rr = t >> 6, cc = t & 63;
            int rstart = rr - 4; rstart = rstart < 0 ? 0 : (rstart > 56 ? 56 : rstart); int cstart = cc - 8; cstart = cstart < 0 ? 0 : (cstart > 48 ? 48 : cstart);
            KD_NA_lat kd{b, rr, cc, rstart, cstart, rpb + h * 15 * 31};
            attn_wave<6>(P, P + (size_t)row * N_INP + OFF_NA + h * 64, OFF_NA + 512 + h * 64, OFF_NA + 1024 + h * 64, kd, false, 0.f, Y + (size_t)row * DM + 1024 + h * 64, pl, C.lane); continue; } r -= nN;
        { const int rc = r >> 3, h = r & 7, b = rc >> 8, row = M_LAT + rc; KD_ctx kd{b};
            attn_wave<4>(P, P + (size_t)row * N_INP + OFF_NA + h * 64, OFF_NA + 512 + h * 64, OFF_NA + 1024 + h * 64, kd, false, 0.f, Y + (size_t)row * DM + 1024 + h * 64, pl, C.lane); }
    }
}

template <bool OUT_BF16>
__device__ __forceinline__ void hy_conv_unit(const float* U, int ustride, const float* G, int L, int rowbase, int t0, const float* gate, int gstride, void* outp, int ostride, int c) {
    float acc[16], old[16], nw[16], u[16];
#pragma unroll
    for (int i = 0; i < 16; ++i) { acc[i] = 0.f; old[i] = 0.f; }
#pragma unroll
    for (int m = 0; m < 15; ++m) old[m] = G[(size_t)(t0 + 1 + m + L - 1) * 512 + c];
    for (int sb = 0; sb < L; sb += 16) {
#pragma unroll
        for (int k = 0; k < 16; ++k) u[k] = U[(size_t)(rowbase + sb + k) * ustride + c];
#pragma unroll
        for (int m = 0; m < 16; ++m) nw[m] = G[(size_t)(t0 - sb - 15 + m + L - 1) * 512 + c];
#pragma unroll
        for (int i = 0; i < 16; ++i)
#pragma unroll
            for (int k = 0; k < 16; ++k) { const int j = i - k; acc[i] += u[k] * ((j <= 0) ? nw[j + 15] : old[j - 1]); }
#pragma unroll
        for (int m = 0; m < 16; ++m) old[m] = nw[m];
    }
#pragma unroll
    for (int i = 0; i < 16; ++i) { const size_t row = (size_t)(rowbase + t0 + i); const float v = gate[row * gstride + c] * acc[i];
        if (OUT_BF16) ((bf16*)outp)[row * ostride + c] = (bf16)f2bf(v); else ((float*)outp)[row * ostride + c] = v; }
}
__device__ __forceinline__ void phase_hyconv(const Ctx& C, const Args& A, int order, bool need_ctx) {
    const float* HU = (const float*)(A.ws + WS_HU); float* Z = (float*)(A.ws + WS_Z); bf16* Y = (bf16*)(A.ws + WS_Y);
    const float* GL = (const float*)(A.ws + WS_GLAT) + (size_t)order * (2 * SEQ - 1) * 512; const float* GC = (const float*)(A.ws + WS_GCTX) + (size_t)order * (2 * LC - 1) * 512;
    const int nl = NB * (SEQ / 16), nc = need_ctx ? NB * (LC / 16) : 0;
    for (int u = blockIdx.x; u < nl + nc; u += C.G) {
        int L, rowbase, t0; const float* G;
        if (u < nl) { const int b = u / (SEQ / 16); t0 = (u % (SEQ / 16)) * 16; L = SEQ; rowbase = b * SEQ; G = GL; }
        else { const int v = u - nl, b = v / (LC / 16); t0 = (v % (LC / 16)) * 16; L = LC; rowbase = M_LAT + b * LC; G = GC; }
        if (order == 0) hy_conv_unit<false>(HU + 1024, 1536, G, L, rowbase, t0, HU, 1536, Z, 512, C.tid);
        else hy_conv_unit<true>(Z, 512, G, L, rowbase, t0, HU + 512, 1536, Y + 512, DM, C.tid);
    }
}

__device__ __forceinline__ void ssd_scan_unit(const Ctx& C, const Args& A, int b, int head, int dir, bool need_ctx) {
    const float* XBC = (const float*)(A.ws + WS_XBC); const float* DT = (const float*)(A.ws + WS_DT); const float* DA = DT + (size_t)M_ALL * 16;
    float* YO = (float*)(A.ws + (dir ? WS_YB : WS_YF));
    const int p = C.tid >> 3, ns = C.tid & 7, g = head >> 2;
    float h[16];
#pragma unroll
    for (int j = 0; j < 16; ++j) h[j] = 0.f;
    for (int seg = 0; seg < 2; ++seg) {
        const int L = seg ? SEQ : LC, base = seg ? b * SEQ : M_LAT + b * LC; const bool wr = seg ? true : need_ctx;
        for (int i = 0; i < L; ++i) { const int t = dir ? (L - 1 - i) : i; const size_t row = (size_t)(base + t);
            const float a = DA[row * 16 + dir * 8 + head], dtv = DT[row * 16 + dir * 8 + head];
            const float* xr = XBC + row * 1024; const float xv = xr[head * 64 + p] * dtv;
            const f32x4* Bp = (const f32x4*)(xr + 512 + g * 128 + ns * 16); const f32x4* Cp = (const f32x4*)(xr + 768 + g * 128 + ns * 16);
            float y = 0.f;
#pragma unroll
            for (int j4 = 0; j4 < 4; ++j4) { const f32x4 bv = Bp[j4], cv = Cp[j4];
                h[j4 * 4 + 0] = a * h[j4 * 4 + 0] + xv * bv.x; h[j4 * 4 + 1] = a * h[j4 * 4 + 1] + xv * bv.y; h[j4 * 4 + 2] = a * h[j4 * 4 + 2] + xv * bv.z; h[j4 * 4 + 3] = a * h[j4 * 4 + 3] + xv * bv.w;
                y += cv.x * h[j4 * 4 + 0] + cv.y * h[j4 * 4 + 1] + cv.z * h[j4 * 4 + 2] + cv.w * h[j4 * 4 + 3]; }
            y += __shfl_xor(y, 1); y += __shfl_xor(y, 2); y += __shfl_xor(y, 4);
            if (wr && ns == 0) YO[row * 512 + head * 64 + p] = y;
        }
    }
}
__device__ __forceinline__ void ssd_final_row(const Ctx& C, const Args& A, int layer, int row) {
    const int lane = C.lane;
    const float* XBC = (const float*)(A.ws + WS_XBC) + (size_t)row * 1024; const float* YF = (const float*)(A.ws + WS_YF) + (size_t)row * 512; const float* YB = (const float*)(A.ws + WS_YB) + (size_t)row * 512;
    const bf16* prow = (const bf16*)(A.ws + WS_P) + (size_t)row * N_INP + OFF_SSM; const float* dsk = A.in[27] + layer * 8; const float* nw = A.in[28] + layer * 512;
    float v[8]; float s0 = 0.f, s1 = 0.f;
#pragma unroll
    for (int i = 0; i < 8; ++i) { const int ch = lane + 64 * i; const float y = YF[ch] + YB[ch] + XBC[ch] * dsk[i]; const float z = bf2f(prow[ch]); v[i] = y * silu_f(z); if (i < 4) s0 += v[i] * v[i]; else s1 += v[i] * v[i]; }
    s0 = wave_sum(s0); s1 = wave_sum(s1);
    const float r0 = 1.0f / sqrtf(s0 * (1.f / 256.f) + EPS), r1 = 1.0f / sqrtf(s1 * (1.f / 256.f) + EPS);
    bf16* yo = (bf16*)(A.ws + WS_Y) + (size_t)row * DM + 1536;
#pragma unroll
    for (int i = 0; i < 8; ++i) { const int ch = lane + 64 * i; yo[ch] = (bf16)f2bf(v[i] * (i < 4 ? r0 : r1) * nw[ch]); }
}

__global__ void __launch_bounds__(NTHR, 2) mk_fwd(const Args A) {
    extern __shared__ __attribute__((aligned(16))) unsigned char lds_raw[];
    Ctx C;
    C.lds = (LAS unsigned char*)lds_raw;
    C.tid = threadIdx.x; C.lane = C.tid & 63; C.wave = __builtin_amdgcn_readfirstlane(C.tid >> 6);
    C.G = gridDim.x; C.gw = blockIdx.x * NWAVES + C.wave; C.NGW = C.G * NWAVES;
    volatile LAS unsigned* MISC = (volatile LAS unsigned*)(C.lds + MISC_OFF);
    for (int u = C.tid; u < (LDS_BYTES - MISC_OFF) / 4; u += NTHR) MISC[u] = 0u;
    __syncthreads();
    XcdBarrier bar; bar.bar = (unsigned*)(A.ws + WS_CTL) + CW_BAR; bar.x = 0; bar.st = nullptr;
    if (!MK_SPLIT) bar = xcd_barrier_post((unsigned*)(A.ws + WS_CTL) + CW_BAR, MISC + 8);
    const int lo = A.ph_lo, hi = A.ph_hi;
#define IN(k) (lo <= (k) && (k) < hi && (launder(C), true))
#define SEAM(k) do { if (!MK_SPLIT && IN(k) && IN((k) + 1)) xcd_barrier(bar); } while (0)

    if (IN(PH_PRO1)) { phase_pro1(C, A); } SEAM(PH_PRO1);
    if (IN(PH_PRO2)) { phase_pro2(C, A); } SEAM(PH_PRO2);

    for (int layer = 0; layer < DEPTH; ++layer) {
        const int pb = PH_L0 + layer * PH_PER_LAYER; const bool last = (layer == DEPTH - 1), need_ctx = !last;
        const unsigned char* wl = A.ws + WS_W + (size_t)layer * W_LAYER;
        const float* mod = (const float*)(A.ws + WS_MOD) + (size_t)layer * 5 * 12288;
        if (IN(pb + 0)) {
            phase_norm(C, A, layer, 0, M_ALL);
            const int nf = SEQ + (need_ctx ? LC : 0);
            for (int it = C.gw; it < nf; it += C.NGW) { if (it < SEQ) hy_filter_item(C, A, layer, SEQ, it, (float*)(A.ws + WS_GLAT)); else hy_filter_item(C, A, layer, LC, it - SEQ, (float*)(A.ws + WS_GCTX)); }
        } SEAM(pb + 0);
        if (IN(pb + 1)) {
            pg8::Gemm g{(const bf16*)(A.ws + WS_XN), (const bf16*)wl, M_ALL, N_INP, DM}; pg8::StaticOrder S; S.init(M_ALL, N_INP, C.G, (int)blockIdx.x);
            pg8::EpiStoreBf16<0> E{(bf16*)(A.ws + WS_P), N_INP};
            pg8::gemm_phase<pg8::EpiStoreBf16<0>, pg8::StaticOrder, true, true>(C.lds, g, S, E);
        } SEAM(pb + 1);
        if (IN(pb + 2)) { for (int row = C.gw; row < M_ALL; row += C.NGW) prep_row(C, A, layer, row); } SEAM(pb + 2);
        if (IN(pb + 3)) {
            if (blockIdx.x < 64) { const int u = blockIdx.x; ssd_scan_unit(C, A, u >> 4, (u >> 1) & 7, u & 1, need_ctx); }
            phase_hyconv(C, A, 0, need_ctx);
            phase_attn(C, A, layer, need_ctx);
        } SEAM(pb + 3);
        if (IN(pb + 4)) {
            phase_hyconv(C, A, 1, need_ctx);
            const int nr = need_ctx ? M_ALL : M_LAT;
            for (int row = C.gw; row < nr; row += C.NGW) ssd_final_row(C, A, layer, row);
        } SEAM(pb + 4);
        if (IN(pb + 5)) {
            const int Mo = need_ctx ? M_ALL : M_LAT;
            pg8::Gemm g{(const bf16*)(A.ws + WS_Y), (const bf16*)(wl + W_OUT_OFF), Mo, DM, DM}; pg8::StaticOrder S; S.init(Mo, DM, C.G, (int)blockIdx.x);
            pg8::EpiResid E{(float*)(A.ws + WS_X), mod + 2 * DM};
            pg8::gemm_phase<pg8::EpiResid, pg8::StaticOrder, true, true>(C.lds, g, S, E);
        } SEAM(pb + 5);
        if (IN(pb + 6)) { phase_norm(C, A, layer, 1, need_ctx ? M_ALL : M_LAT); } SEAM(pb + 6);
        if (IN(pb + 7)) {
            const int Mo = need_ctx ? M_ALL : M_LAT;
            pg8::Gemm g{(const bf16*)(A.ws + WS_XN), (const bf16*)(wl + W_1_OFF), Mo, DFF, DM}; pg8::StaticOrder S; S.init(Mo, DFF, C.G, (int)blockIdx.x);
            pg8::EpiStoreBf16<1> E{(bf16*)(A.ws + WS_H), DFF};
            pg8::gemm_phase<pg8::EpiStoreBf16<1>, pg8::StaticOrder, true, true>(C.lds, g, S, E);
        } SEAM(pb + 7);
        if (IN(pb + 8)) {
            const int Mo = need_ctx ? M_ALL : M_LAT;
            pg8::Gemm g{(const bf16*)(A.ws + WS_H), (const bf16*)(wl + W_2_OFF), Mo, DM, DFF}; pg8::StaticOrder S; S.init(Mo, DM, C.G, (int)blockIdx.x);
            pg8::EpiResid E{(float*)(A.ws + WS_X), mod + 5 * DM};
            pg8::gemm_phase<pg8::EpiResid, pg8::StaticOrder, true, true>(C.lds, g, S, E);
        } SEAM(pb + 8);
    }
    if (IN(PH_FINAL)) phase_final(C, A);
#undef IN
#undef SEAM
}

extern "C" void kernel_launch(void* const* d_in, const int* in_sizes, int n_in, void* d_out, int out_size, void* d_ws, size_t ws_size, hipStream_t stream) {
    static int grid = 0;
    if (grid == 0) {
        if (n_in != 32 || out_size != M_LAT * DM || ws_size < WS_END) { fprintf(stderr, "kernel_launch: unexpected shapes (n_in %d, out %d, ws %zu); nothing launched\n", n_in, out_size, ws_size); grid = -1; return; }
        int dev = 0, cus = 0, per_cu = 0;
        if (hipGetDevice(&dev) != hipSuccess || hipDeviceGetAttribute(&cus, hipDeviceAttributeMultiprocessorCount, dev) != hipSuccess) { grid = -1; return; }
        if (hipFuncSetAttribute((const void*)mk_fwd, hipFuncAttributeMaxDynamicSharedMemorySize, LDS_BYTES) != hipSuccess) { fprintf(stderr, "kernel_launch: hipFuncSetAttribute failed\n"); grid = -1; return; }
        if (hipOccupancyMaxActiveBlocksPerMultiprocessor(&per_cu, (const void*)mk_fwd, NTHR, LDS_BYTES) != hipSuccess || per_cu < 1) { fprintf(stderr, "kernel_launch: occupancy query says %d blocks per CU\n", per_cu); }
        (void)hipGetLastError();
        grid = cus;
    }
    if (grid < 0) return;
    if (hipMemsetAsync((char*)d_ws + WS_CTL, 0, CTL_ZERO_BYTES, stream) != hipSuccess) { fprintf(stderr, "kernel_launch: memset failed\n"); return; }
    Args a{};
    for (int i = 0; i < 32; ++i) a.in[i] = (const float*)d_in[i];
    a.out = (float*)d_out; a.ws = (unsigned char*)d_ws;
#if MK_SPLIT
    for (int ph = 0; ph < N_PHASES; ++ph) { a.ph_lo = ph; a.ph_hi = ph + 1; hipLaunchKernelGGL(mk_fwd, dim3(grid), dim3(NTHR), LDS_BYTES, stream, a); }
#else
    a.ph_lo = 0; a.ph_hi = N_PHASES; hipLaunchKernelGGL(mk_fwd, dim3(grid), dim3(NTHR), LDS_BYTES, stream, a);
#endif
    const hipError_t le = hipPeekAtLastError();
    if (le != hipSuccess) fprintf(stderr, "kernel_launch: launch failed: %s\n", hipGetErrorName(le));
}
```

```cpp
#include <hip/hip_runtime.h>
#include <cstdio>
#include <cstdint>
namespace pg8 {
#define PG8_LAS __attribute__((address_space(3)))
typedef unsigned short bf16_t;
typedef short bf16x8 __attribute__((ext_vector_type(8)));
typedef float f32x4 __attribute__((ext_vector_type(4)));
typedef unsigned u32x4 __attribute__((ext_vector_type(4)));
constexpr int BM = 256, BK = 64, HALF = 128, HTB = HALF * BK * 2  , STAGE_BYTES = 8 * HTB, NXCD = 8, WGM = 8;

__host__ __device__ __forceinline__ int lds_byte(int r, int c) { const int st = (r >> 4) * 2 + (c >> 5), rr = r & 15, cc = c & 31, ob = rr * 64 + cc * 2; return st * 1024 + (ob ^ (((ob >> 9) & 1) << 5)); }
__host__ __device__ __forceinline__ void stage_rc(int b, int& R, int& C) { const int st = b / 1024, sb = b % 1024, swz = sb ^ (((sb >> 9) & 1) << 5); R = (st >> 1) * 16 + swz / 64; C = (st & 1) * 32 + (swz % 64) / 2; }
__host__ __device__ __forceinline__ int perm32(int rho) { const int n = rho >> 4, i = rho & 15; return 8 * (i >> 2) + 4 * n + (i & 3); }

struct Unit { int pm, pn; };
struct Gemm { const bf16_t* A; const bf16_t* Bt; int M, N, K; };

struct StaticOrder {
    int nM, nN, nwg, G, c;
    __host__ __device__ void init(int M, int N, int G_, int c_) { nM = M / BM; nN = N / BM; nwg = nM * nN; G = G_; c = c_; }
    __host__ __device__ bool next(int i, Unit& u) const {
        const long L = (long)i * G + c; if (L >= nwg) return false;
        int wgid = (int)L; { const int q = nwg / NXCD, r = nwg % NXCD, xcd = wgid % NXCD, off = wgid / NXCD; wgid = (xcd < r ? xcd * (q + 1) : r * (q + 1) + (xcd - r) * q) + off; }
        const int nig = WGM * nN, gid = wgid / nig, fm = gid * WGM, gsz = (nM - fm) < WGM ? (nM - fm) : WGM;
        u.pm = fm + ((wgid % nig) % gsz); u.pn = (wgid % nig) / gsz; return true;
    }
    __device__ __forceinline__ void a_ready(const Unit&) const {}
    __device__ __forceinline__ void done(const Unit&) const {}
};

__device__ __forceinline__ unsigned cvt_pk_bf16(float lo, float hi) { unsigned r; asm volatile("v_cvt_pk_bf16_f32 %0, %1, %2" : "=v"(r) : "v"(lo), "v"(hi)); return r; }
typedef float f32x2 __attribute__((ext_vector_type(2)));
template <int ACT  > struct EpiStoreBf16 {
    static constexpr bool PERM = true, AFTER_DRAIN = false;
    bf16_t* O; int ldc; const float* rope;
    __device__ __forceinline__ void operator()(const f32x4 (&acc)[2][2][4][2], const Unit& u, int wr, int wc, int fr, int fq) const {
        const int row0 = u.pm * BM + wr * 64 + fr; const int col0 = u.pn * BM + wc * 32 + 8 * fq;
        const bool roped = (ACT == 0) && rope != nullptr && u.pm < 64 && u.pn < 3;
#pragma unroll
        for (int ai = 0; ai < 2; ++ai)
#pragma unroll
            for (int m = 0; m < 4; ++m) { const int row = row0 + ai * HALF + m * 16; bf16_t* rowp = O + (size_t)row * ldc + col0;
                f32x4 c0 = {1.f, 1.f, 1.f, 1.f}, c1 = c0, s0 = {0.f, 0.f, 0.f, 0.f}, s1 = s0;
                if (roped) { const int t = row & 4095, pos = (wc & 1) ? (t & 63) : (t >> 6); const float* tp = rope + pos * 16 + 8 * (fq & 1);
                    c0 = *(const f32x4*)tp; c1 = *(const f32x4*)(tp + 4); s0 = *(const f32x4*)(tp + 1024); s1 = *(const f32x4*)(tp + 1028); if (fq < 2) { s0 = -s0; s1 = -s1; } }
#pragma unroll
                for (int bj = 0; bj < 2; ++bj) { f32x4 v0 = acc[ai][bj][m][0], v1 = acc[ai][bj][m][1];
                    if (ACT == 1) {
#pragma unroll
                        for (int j = 0; j < 4; ++j) { const float a = fmaxf(v0[j], 0.f), b = fmaxf(v1[j], 0.f); v0[j] = a * a; v1[j] = b * b; } }
                    if (roped && (u.pn < 2 || bj == 0)) { f32x4 p0, p1;
#pragma unroll
                        for (int j = 0; j < 4; ++j) { p0[j] = __shfl_xor(v0[j], 32); p1[j] = __shfl_xor(v1[j], 32); }
                        v0 = v0 * c0 + p0 * s0; v1 = v1 * c1 + p1 * s1; }
                    u32x4 w; w.x = cvt_pk_bf16(v0[0], v0[1]); w.y = cvt_pk_bf16(v0[2], v0[3]); w.z = cvt_pk_bf16(v1[0], v1[1]); w.w = cvt_pk_bf16(v1[2], v1[3]);
                    *(u32x4*)(rowp + bj * HALF) = w; } }
    }
};
struct EpiResid {
    static constexpr bool PERM = false, AFTER_DRAIN = false;
    float* X; const float* gate; float gs; const float* base_lat; const float* base_ctx;
    __device__ __forceinline__ void operator()(const f32x4 (&acc)[2][2][4][2], const Unit& u, int wr, int wc, int fr, int fq) const {
        const int row0 = u.pm * BM + wr * 64 + fr, col0 = u.pn * BM + wc * 32 + 4 * fq;
        const int b = (u.pm < 64) ? (u.pm >> 4) : 4;
        const float* bl_ = base_lat; const float* bc_ = base_ctx; const float* sbase = (u.pm < 64) ? bl_ : bc_;
        const float* gp = gate + (size_t)b * 12288 + col0;
        f32x4 gv[2][2];
#pragma unroll
        for (int bj = 0; bj < 2; ++bj)
#pragma unroll
            for (int n = 0; n < 2; ++n) gv[bj][n] = *(const f32x4*)(gp + bj * HALF + n * 16) * gs;
#pragma unroll
        for (int ai = 0; ai < 2; ++ai)
#pragma unroll
            for (int m = 0; m < 4; ++m) { const int rr = row0 + ai * HALF + m * 16; float* rowp = X + (size_t)rr * 2048 + col0; const float* srcp = sbase + (size_t)rr * 2048 + col0;
#pragma unroll
                for (int bj = 0; bj < 2; ++bj)
#pragma unroll
                    for (int n = 0; n < 2; ++n) { f32x4 x = *(const f32x4*)(srcp + bj * HALF + n * 16); x = x + gv[bj][n] * acc[ai][bj][m][n]; *(f32x4*)(rowp + bj * HALF + n * 16) = x; }
                if (m & 1) asm volatile("" ::: "memory"); }
    }
};

template <class Epi, class Sched, bool ALIGN_EPI = false, bool SP2 = false>
__device__ __forceinline__ void gemm_phase(PG8_LAS unsigned char* lds, const Gemm g, const Sched& S, const Epi& E) {
    int tid_ = threadIdx.x; asm volatile("" : "+v"(tid_));
    const int tid = tid_, wid = __builtin_amdgcn_readfirstlane(tid >> 6), lane = tid & 63, wr = wid >> 2, wc = wid & 3, fr = lane & 15, fq = lane >> 4;
    const int K = g.K, nt = K / BK;
    unsigned voffA[2], voffB[2];
#pragma unroll
    for (int i = 0; i < 2; ++i) { int R, C; stage_rc(tid * 16 + i * 8192, R, C); const int Rb = Epi::PERM ? ((R & ~31) + perm32(R & 31)) : R;
        voffA[i] = (unsigned)(R * K + C) * 2u; voffB[i] = (unsigned)(Rb * K + C) * 2u; }
    const size_t kstep = (size_t)(BK * 2);
    const size_t hstep = (size_t)HALF * K * 2;
    const size_t tstep = 2 * hstep;
    const unsigned ldsw = (unsigned)wid * 1024u;
    const int aoff = lds_byte(wr * 64 + fr, fq * 8), boff = lds_byte(wc * 32 + fr, fq * 8);
#define PG8_SA(b, h) (((b) * 2 + (h)) * HTB)
#define PG8_SB(b, h) ((4 + (b) * 2 + (h)) * HTB)
#define PG8_STAGE(bufoff, gbase, voff) do { _Pragma("unroll") for (int _i = 0; _i < 2; ++_i) \
        __builtin_amdgcn_global_load_lds((const unsigned*)((const char*)(gbase) + (voff)[_i]), (PG8_LAS unsigned*)(lds + (bufoff) + ldsw + _i * 8192), 16, 0, 0); } while (0)
#define PG8_LDA(dst, b, h) do { _Pragma("unroll") for (int m = 0; m < 4; ++m) _Pragma("unroll") for (int k = 0; k < 2; ++k) dst[m][k] = *(const PG8_LAS bf16x8*)(lds + PG8_SA(b, h) + aoff + m * 2048 + k * 1024); } while (0)
#define PG8_LDB(dst, b, h) do { _Pragma("unroll") for (int n = 0; n < 2; ++n) _Pragma("unroll") for (int k = 0; k < 2; ++k) dst[n][k] = *(const PG8_LAS bf16x8*)(lds + PG8_SB(b, h) + boff + n * 2048 + k * 1024); } while (0)
#define PG8_MMA(ai, bj, At, Bt) do { __builtin_amdgcn_s_setprio(1); _Pragma("unroll") for (int m = 0; m < 4; ++m) _Pragma("unroll") for (int n = 0; n < 2; ++n) _Pragma("unroll") for (int k = 0; k < 2; ++k) \
        acc[ai][bj][m][n] = __builtin_amdgcn_mfma_f32_16x16x32_bf16(Bt[n][k], At[m][k], acc[ai][bj][m][n], 0, 0, 0); __builtin_amdgcn_s_setprio(0); } while (0)
#define PG8_WAIT_V(n) asm volatile("s_waitcnt vmcnt(" #n ")" ::: "memory")
#define PG8_WAIT_L(n) asm volatile("s_waitcnt lgkmcnt(" #n ")" ::: "memory")
#define PG8_BAR __builtin_amdgcn_s_barrier()
#define PG8_SCHED __builtin_amdgcn_sched_barrier(0)
    Unit cur, nxt; int ui = 0;
    if (!S.next(0, cur)) return;
    f32x4 acc[2][2][4][2];
#pragma unroll
    for (int a = 0; a < 2; ++a)
#pragma unroll
        for (int b = 0; b < 2; ++b)
#pragma unroll
            for (int m = 0; m < 4; ++m)
#pragma unroll
                for (int n = 0; n < 2; ++n) acc[a][b][m][n] = (f32x4){0.f, 0.f, 0.f, 0.f};
    bf16x8 At[4][2], B0[2][2], B1[2][2];
    const char* cA = (const char*)g.A + (size_t)cur.pm * tstep; const char* cB = (const char*)g.Bt + (size_t)cur.pn * tstep;
    S.a_ready(cur);
    if constexpr (SP2) {
        PG8_STAGE(PG8_SB(0, 0), cB, voffB); PG8_STAGE(PG8_SB(0, 1), cB + hstep, voffB); PG8_STAGE(PG8_SA(0, 0), cA, voffA); PG8_STAGE(PG8_SA(0, 1), cA + hstep, voffA);
        if (wr == 1) PG8_BAR;
        PG8_WAIT_V(2); PG8_BAR;
        PG8_STAGE(PG8_SB(1, 0), cB + kstep, voffB); PG8_STAGE(PG8_SA(1, 0), cA + kstep, voffA); PG8_STAGE(PG8_SB(1, 1), cB + hstep + kstep, voffB);
        PG8_WAIT_V(6); PG8_BAR;
    } else {
        PG8_STAGE(PG8_SB(0, 0), cB, voffB); PG8_STAGE(PG8_SA(0, 0), cA, voffA); PG8_STAGE(PG8_SB(0, 1), cB + hstep, voffB); PG8_STAGE(PG8_SA(0, 1), cA + hstep, voffA);
        if (wr == 1) PG8_BAR;
        PG8_WAIT_V(4); PG8_BAR;
        PG8_STAGE(PG8_SB(1, 0), cB + kstep, voffB); PG8_STAGE(PG8_SA(1, 0), cA + kstep, voffA); PG8_STAGE(PG8_SB(1, 1), cB + hstep + kstep, voffB);
        PG8_WAIT_V(6); PG8_BAR;
    }
    for (;;) {
        const bool has_next = S.next(ui + 1, nxt);
        const char* nA = has_next ? (const char*)g.A + (size_t)nxt.pm * tstep : cA; const char* nB = has_next ? (const char*)g.Bt + (size_t)nxt.pn * tstep : cB;
        for (int t = 0; t < nt; t += 2) {
            const bool last = (t == nt - 2);
            const char* a1 = cA + (size_t)(t + 1) * kstep;
            const char* a2 = last ? nA : cA + (size_t)(t + 2) * kstep; const char* b2 = last ? nB : cB + (size_t)(t + 2) * kstep;
            const char* a3 = a2 + kstep; const char* b3 = b2 + kstep;
            if (last && has_next) S.a_ready(nxt);
            if constexpr (SP2) {
            PG8_LDB(B0, 0, 0); PG8_LDB(B1, 0, 1); PG8_SCHED; PG8_LDA(At, 0, 0); PG8_STAGE(PG8_SA(1, 1), a1 + hstep, voffA);
            PG8_WAIT_V(8); PG8_WAIT_L(0); PG8_BAR; PG8_MMA(0, 0, At, B0); PG8_MMA(0, 1, At, B1); PG8_BAR; PG8_SCHED;
            PG8_LDA(At, 0, 1); PG8_STAGE(PG8_SB(0, 0), b2, voffB); PG8_STAGE(PG8_SB(0, 1), b2 + hstep, voffB); PG8_STAGE(PG8_SA(0, 0), a2, voffA);
            PG8_WAIT_V(8); PG8_WAIT_L(0); PG8_BAR; PG8_MMA(1, 0, At, B0); PG8_MMA(1, 1, At, B1); PG8_BAR; PG8_SCHED;
            PG8_LDB(B0, 1, 0); PG8_LDB(B1, 1, 1); PG8_SCHED; PG8_LDA(At, 1, 0); PG8_STAGE(PG8_SA(0, 1), a2 + hstep, voffA);
            PG8_WAIT_V(8); PG8_WAIT_L(0); PG8_BAR; PG8_MMA(0, 0, At, B0); PG8_MMA(0, 1, At, B1); PG8_BAR; PG8_SCHED;
            PG8_LDA(At, 1, 1); PG8_STAGE(PG8_SB(1, 0), b3, voffB); PG8_STAGE(PG8_SB(1, 1), b3 + hstep, voffB); PG8_STAGE(PG8_SA(1, 0), a3, voffA);
            PG8_WAIT_V(8); PG8_WAIT_L(0); PG8_BAR; PG8_MMA(1, 0, At, B0); PG8_MMA(1, 1, At, B1); PG8_BAR; PG8_SCHED;
            } else {
            PG8_LDB(B0, 0, 0); PG8_SCHED; PG8_LDA(At, 0, 0); PG8_STAGE(PG8_SA(1, 1), a1 + hstep, voffA);
            PG8_WAIT_L(8); PG8_BAR; PG8_WAIT_L(0); PG8_MMA(0, 0, At, B0); PG8_BAR; PG8_SCHED;
            PG8_LDB(B1, 0, 1); PG8_STAGE(PG8_SB(0, 0), b2, voffB);
            PG8_BAR; PG8_WAIT_L(0); PG8_MMA(0, 1, At, B1); PG8_BAR;
            PG8_LDA(At, 0, 1); PG8_STAGE(PG8_SA(0, 0), a2, voffA);
            PG8_BAR; PG8_WAIT_L(0); PG8_MMA(1, 0, At, B0); PG8_BAR; PG8_SCHED;
            PG8_STAGE(PG8_SB(0, 1), b2 + hstep, voffB);
            PG8_WAIT_V(6); PG8_BAR; PG8_MMA(1, 1, At, B1); PG8_BAR;
            PG8_LDB(B0, 1, 0); PG8_SCHED; PG8_LDA(At, 1, 0); PG8_STAGE(PG8_SA(0, 1), a2 + hstep, voffA);
            PG8_WAIT_L(8); PG8_BAR; PG8_WAIT_L(0); PG8_MMA(0, 0, At, B0); PG8_BAR; PG8_SCHED;
            PG8_LDB(B1, 1, 1); PG8_STAGE(PG8_SB(1, 0), b3, voffB);
            PG8_BAR; PG8_WAIT_L(0); PG8_MMA(0, 1, At, B1); PG8_BAR;
            PG8_LDA(At, 1, 1); PG8_STAGE(PG8_SA(1, 0), a3, voffA);
            PG8_BAR; PG8_WAIT_L(0); PG8_MMA(1, 0, At, B0); PG8_BAR; PG8_SCHED;
            PG8_STAGE(PG8_SB(1, 1), b3 + hstep, voffB);
            PG8_WAIT_V(6); PG8_BAR; PG8_MMA(1, 1, At, B1); PG8_BAR;
            }
        }
        if constexpr (ALIGN_EPI) { if (wr == 0) PG8_BAR; }
        if constexpr (!Epi::AFTER_DRAIN) { E(acc, cur, wr, wc, fr, fq); S.done(cur); }
        if (!has_next) break;
#pragma unroll
        for (int a = 0; a < 2; ++a)
#pragma unroll
            for (int b = 0; b < 2; ++b)
#pragma unroll
                for (int m = 0; m < 4; ++m)
#pragma unroll
                    for (int n = 0; n < 2; ++n) acc[a][b][m][n] = (f32x4){0.f, 0.f, 0.f, 0.f};
        cur = nxt; cA = nA; cB = nB; ++ui;
        if constexpr (ALIGN_EPI) { if (wr == 1) PG8_BAR; }
    }
    PG8_WAIT_V(0);
    if constexpr (!ALIGN_EPI) { if (wr == 0) PG8_BAR; }
    PG8_BAR;
    if constexpr (Epi::AFTER_DRAIN) { E.fused(acc, cur, wr, wc, fr, fq, lds, wid, lane); S.done(cur); }
#undef PG8_SA
#undef PG8_SB
#undef PG8_STAGE
#undef PG8_LDA
#undef PG8_LDB
#undef PG8_MMA
#undef PG8_WAIT_V
#undef PG8_WAIT_L
#undef PG8_BAR
#undef PG8_SCHED
}
}
#define GAS __attribute__((address_space(1)))
#define LAS __attribute__((address_space(3)))
typedef unsigned short bf16;
typedef unsigned v4u __attribute__((ext_vector_type(4)));
typedef float f32x4 __attribute__((ext_vector_type(4)));
typedef short bf16x8 __attribute__((ext_vector_type(8)));
typedef GAS unsigned gu32;
typedef GAS unsigned long long gu64;
#define RLX_AGENT __ATOMIC_RELAXED, __HIP_MEMORY_SCOPE_AGENT
#define LDS_WAIT() asm volatile("s_waitcnt lgkmcnt(0)" ::: "memory")
#define VM_WAIT() asm volatile("s_waitcnt vmcnt(0)" ::: "memory")
__device__ __forceinline__ unsigned long long rt() { return __builtin_amdgcn_s_memrealtime(); }
__device__ __forceinline__ unsigned f2bf(float f) { unsigned u = __builtin_bit_cast(unsigned, f); return (u + 0x7fffu + ((u >> 16) & 1u)) >> 16; }
__device__ __forceinline__ unsigned pk2(float lo, float hi) { unsigned r; asm("v_cvt_pk_bf16_f32 %0, %1, %2" : "=v"(r) : "v"(lo), "v"(hi)); return r; }
#define XB_TMO      128
#define XB_XCNT(j)  (256  + 64 * (j))
#define XB_XSUB(j)  (1280 + 64 * (j))
#define XB_XGEN(j)  (2304 + 64 * (j))
#define XB_TOP      3328
#define XB_TOPGEN   3392
#define XCD_BAR_WORDS 3456
#define XB_SPIN_CAP (1u << 18)

__device__ __forceinline__ unsigned xb_ld(unsigned* p)              { return __hip_atomic_load(p, __ATOMIC_RELAXED, __HIP_MEMORY_SCOPE_AGENT); }
__device__ __forceinline__ unsigned xb_add(unsigned* p, unsigned v) { return __hip_atomic_fetch_add(p, v, __ATOMIC_RELAXED, __HIP_MEMORY_SCOPE_AGENT); }
__device__ __forceinline__ unsigned xb_xcc_id() { return (unsigned)__builtin_amdgcn_s_getreg((3 << 11) | 20) & 0xFu; }
#define XB_SPIN(cond, bar) do { unsigned _sp = 0; while (cond) { __builtin_amdgcn_s_sleep(1); \
    if ((++_sp & 255u) == 0u) { if (xb_ld(&(bar)[XB_TMO])) break; if (_sp > XB_SPIN_CAP) { atomicAdd(&(bar)[XB_TMO], 1u); break; } } } } while (0)

struct XcdBarrier {
    unsigned* bar; unsigned x;
    volatile LAS unsigned* st;
};

__device__ __forceinline__ XcdBarrier xcd_barrier_post(unsigned* bar, volatile LAS unsigned* st) {
    XcdBarrier b; b.bar = bar; b.x = xb_xcc_id(); b.st = st;
    if (threadIdx.x == 0) (void)xb_add(&bar[XB_XCNT(b.x)], 1u);
    return b;
}
__device__ __forceinline__ void xcd_barrier_complete(unsigned* bar, unsigned x, unsigned& nloc, unsigned& nx) {
    const unsigned G = gridDim.x * gridDim.y * gridDim.z;
    unsigned sum, cnt, mine, sp = 0u;
    for (;;) {
        sum = 0u; cnt = 0u; mine = 0u;
#pragma unroll
        for (unsigned j = 0; j < 16; ++j) { const unsigned c = xb_ld(&bar[XB_XCNT(j)]); sum += c; cnt += (c > 0u) ? 1u : 0u; mine = (j == x) ? c : mine; }
        if (sum == G) break;
        __builtin_amdgcn_s_sleep(1);
        if ((++sp & 255u) == 0u) { if (xb_ld(&bar[XB_TMO])) break; if (sp > XB_SPIN_CAP) { atomicAdd(&bar[XB_TMO], 1u); break; } }
    }
    nloc = mine > 0u ? mine : 1u; nx = cnt > 0u ? cnt : 1u;
}

__device__ __forceinline__ void xcd_barrier(const XcdBarrier& b) {
    asm volatile("s_waitcnt vmcnt(0)" ::: "memory");
    __syncthreads();
    if (threadIdx.x == 0) {
        unsigned* bar = b.bar; unsigned bx = b.x; asm volatile("" : "+s"(bar), "+s"(bx));
        __builtin_amdgcn_s_waitcnt(0);
        unsigned nloc = b.st[0], nx = b.st[1];
        if (nloc == 0u) { xcd_barrier_complete(bar, bx, nloc, nx); b.st[0] = nloc; b.st[1] = nx; }
        const unsigned old = xb_add(&bar[XB_XSUB(bx)], 1u);
        const unsigned gen = old / nloc;
        if (old + 1u == (gen + 1u) * nloc) {
            __builtin_amdgcn_fence(__ATOMIC_RELEASE, "agent");
            asm volatile("s_waitcnt vmcnt(0)" ::: "memory");
            const unsigned og = xb_add(&bar[XB_TOP], 1u);
            const unsigned tg = og / nx;
            if (og + 1u == (tg + 1u) * nx) xb_add(&bar[XB_TOPGEN], 1u);
            else XB_SPIN(xb_ld(&bar[XB_TOPGEN]) == tg, bar);
            __builtin_amdgcn_fence(__ATOMIC_ACQUIRE, "agent");
            xb_add(&bar[XB_XGEN(bx)], 1u);
            asm volatile("s_waitcnt vmcnt(0)" ::: "memory");
        } else {
            XB_SPIN(xb_ld(&bar[XB_XGEN(bx)]) == gen, bar);
            __builtin_amdgcn_fence(__ATOMIC_ACQUIRE, "agent");
            asm volatile("s_waitcnt vmcnt(0)" ::: "memory");
        }
    }
    __syncthreads();
}

constexpr int DM = 2048, NB = 4, SEQ = 4096, LC = 256, DEPTH = 4, DFF = 8192;
constexpr int M_LAT = NB * SEQ, M_CTX = NB * LC, M_ALL = M_LAT + M_CTX;
constexpr int N_IN = 5392, N_INP = 5632;
constexpr int OFF_HY = 768, OFF_NA = 2304, OFF_SSM = 3840;
constexpr int NWAVES = 8, NTHR = 512;
constexpr float EPS = 1e-6f;

constexpr size_t MiB = 1u << 20;
constexpr size_t WS_CTL = 0, CTL_ZERO_BYTES = 1 * MiB;
constexpr size_t WS_MOD = 1 * MiB;
constexpr size_t WS_MODP = 2 * MiB;
constexpr size_t WS_ROPE = 10 * MiB;
constexpr size_t WS_GLAT = 11 * MiB;
constexpr size_t WS_GCTX = 43 * MiB;
constexpr size_t WS_GCTX1 = 28 * MiB;
constexpr size_t WS_W4T = 46 * MiB;
constexpr size_t WS_W = 48 * MiB;
constexpr size_t W_LAYER = 94 * MiB, W_OUT_OFF = 22 * MiB, W_1_OFF = 30 * MiB, W_2_OFF = 62 * MiB;
constexpr size_t WS_X = 424 * MiB;
constexpr size_t WS_XN = 560 * MiB;
constexpr size_t WS_P = 628 * MiB;
constexpr size_t WS_Y = 815 * MiB;
constexpr size_t WS_H = 883 * MiB;
constexpr size_t WS_XBC = 1155 * MiB;
constexpr size_t WS_XBCT = WS_XBC + 34 * MiB;
constexpr size_t WS_DT = 1223 * MiB;
constexpr size_t WS_YF = 1226 * MiB;
constexpr size_t WS_HIN = WS_YF;
constexpr size_t WS_YB = 1260 * MiB;
constexpr size_t WS_CD = WS_YB;
constexpr size_t WS_HU = 1294 * MiB;
constexpr size_t WS_SST = WS_HU;
constexpr size_t WS_Z = 1396 * MiB;
constexpr size_t WS_HUT = 1430 * MiB;
constexpr size_t WS_YT = 1478 * MiB;
constexpr size_t WS_GT = WS_GLAT;
constexpr size_t WS_VT = 1494 * MiB;
constexpr size_t WS_END = 1516 * MiB;
constexpr int CW_BAR = 4096;

constexpr int RING_BYTES = 131072, MISC_OFF = 147456, LDS_BYTES = MISC_OFF + 1024;

constexpr int PH_PRO1 = 0, PH_PRO2 = 1, PH_L0 = 2, PH_PER_LAYER = 10, PH_FINAL = PH_L0 + DEPTH * PH_PER_LAYER, N_PHASES = PH_FINAL + 1;
#ifndef PROBE_REP
#define PROBE_REP -1
#endif
#ifndef MK_SPLIT
#define MK_SPLIT 0
#endif

__device__ __forceinline__ float bf2f(bf16 h) { return __uint_as_float(((unsigned)h) << 16); }
__device__ __forceinline__ float wave_sum(float v) {
#pragma unroll
    for (int o = 1; o < 64; o <<= 1) v += __shfl_xor(v, o);
    return v;
}
__device__ __forceinline__ float wave_max(float v) {
#pragma unroll
    for (int o = 1; o < 64; o <<= 1) v = fmaxf(v, __shfl_xor(v, o));
    return v;
}
__device__ __forceinline__ float silu_f(float v) { return v / (1.f + __expf(-v)); }

struct Ctx {
    LAS unsigned char* lds;
    int tid, lane, wave, G, gw, NGW, bid;
};
__device__ __forceinline__ void launder(Ctx& C) { int t = threadIdx.x, bx = blockIdx.x, gx = gridDim.x; asm volatile("" : "+v"(t), "+s"(bx), "+s"(gx));
    C.tid = t; C.lane = t & 63; C.wave = __builtin_amdgcn_readfirstlane(t >> 6); C.bid = bx; C.G = gx; C.gw = bx * NWAVES + C.wave; C.NGW = gx * NWAVES; }
struct Args { const float* in[32]; float* out; unsigned char* ws; int ph_lo, ph_hi; };
typedef const Args __attribute__((address_space(4))) KArgs;

__device__ __forceinline__ void transpose_item(const float* W, int K, int N, bf16* WT, LAS float* scr, int kb, int nb, int lane) {
    const int k0 = 64 * kb, n0 = 64 * nb;
    const int nn = n0 + lane; const bool okn = nn < N;
    float tv[64];
#pragma unroll
    for (int i = 0; i < 64; ++i) tv[i] = okn ? W[(size_t)(k0 + i) * N + nn] : 0.f;
#pragma unroll
    for (int i = 0; i < 64; ++i) scr[i * 65 + lane] = tv[i];
    LDS_WAIT(); asm volatile("" ::: "memory");
    const int c = lane & 7;
#pragma unroll
    for (int j = 0; j < 8; ++j) { const int n = (lane >> 3) + 8 * j; const LAS float* s = scr + (8 * c) * 65 + n;
        v4u o; o.x = pk2(s[0 * 65], s[1 * 65]); o.y = pk2(s[2 * 65], s[3 * 65]); o.z = pk2(s[4 * 65], s[5 * 65]); o.w = pk2(s[6 * 65], s[7 * 65]);
        *(v4u*)(WT + (size_t)(n0 + n) * K + k0 + 8 * c) = o; }
    LDS_WAIT(); asm volatile("" ::: "memory");
}

__device__ __forceinline__ void phase_pro1(const Ctx& C, KArgs& A) {
    LAS float* sl = (LAS float*)C.lds;
    const float* cvec = A.in[1]; const float* cctx = A.in[3]; const float* ada_w = A.in[4];
    float* modp = (float*)(A.ws + WS_MODP);
    for (int sr = 0; sr < ((PROBE_REP == 43) ? 2 : 1); ++sr)
    for (int u = C.bid; u < 768; u += C.G) {
        const int layer = u / 192, r = u % 192, kc = r / 24, nb = r % 24;
        __syncthreads();
        for (int i = C.tid; i < 5 * 256; i += NTHR) { const int b = i >> 8, kk = i & 255, k = kc * 256 + kk; const float v = (b < 4) ? cvec[b * DM + k] : cctx[k]; sl[i] = v / (1.f + expf(-v)); }
        __syncthreads();
        const int n = nb * 512 + C.tid; const float* w = ada_w + ((size_t)layer * DM + kc * 256) * 12288 + n;
        float a0 = 0.f, a1 = 0.f, a2 = 0.f, a3 = 0.f, a4 = 0.f;
#pragma unroll 8
        for (int kk = 0; kk < 256; ++kk) { const float wv = w[(size_t)kk * 12288]; a0 += sl[kk] * wv; a1 += sl[256 + kk] * wv; a2 += sl[512 + kk] * wv; a3 += sl[768 + kk] * wv; a4 += sl[1024 + kk] * wv; }
        float* o = modp + ((size_t)(kc * 4 + layer) * 5) * 12288 + n;
        o[0] = a0; o[12288] = a1; o[2 * 12288] = a2; o[3 * 12288] = a3; o[4 * 12288] = a4;
    }
    __syncthreads();
    if (C.bid == 0) { float* rc = (float*)(A.ws + WS_ROPE); float* rs = rc + 1024;
        for (int i = C.tid; i < 1024; i += NTHR) { const int pos = i >> 4, j = i & 15; const float inv = powf(10000.f, -(float)j / 16.f); const float ang = (float)pos * inv; rc[i] = cosf(ang); rs[i] = sinf(ang); } }
    { const float* w4 = A.in[19]; bf16* w4t = (bf16*)(A.ws + WS_W4T);
      for (int i = C.bid * NTHR + C.tid; i < DEPTH * 2048; i += C.G * NTHR) { const int layer = i >> 11, n = i & 2047; const float* s = w4 + (size_t)layer * 64 * 2048 + n; v4u* d = (v4u*)(w4t + (size_t)i * 64);
#pragma unroll
          for (int q = 0; q < 8; ++q) { v4u o; o.x = pk2(s[(8 * q + 0) * 2048], s[(8 * q + 1) * 2048]); o.y = pk2(s[(8 * q + 2) * 2048], s[(8 * q + 3) * 2048]); o.z = pk2(s[(8 * q + 4) * 2048], s[(8 * q + 5) * 2048]); o.w = pk2(s[(8 * q + 6) * 2048], s[(8 * q + 7) * 2048]); d[q] = o; } } }
    LAS float* scr = (LAS float*)(C.lds + C.wave * 16896);
    constexpr int I_IN = 32 * 88, I_OUT = 32 * 32, I_1 = 32 * 128, I_2 = 128 * 32, I_LAYER = I_IN + I_OUT + I_1 + I_2;
    for (int it = C.gw; it < DEPTH * I_LAYER; it += C.NGW) {
        const int layer = it / I_LAYER; int r = it % I_LAYER;
        bf16* wl = (bf16*)(A.ws + WS_W + (size_t)layer * W_LAYER);
        if (r < I_IN) { transpose_item(A.in[8] + (size_t)layer * DM * N_IN, DM, N_IN, wl, scr, r / 88, r % 88, C.lane); continue; } r -= I_IN;
        if (r < I_OUT) { transpose_item(A.in[9] + (size_t)layer * DM * DM, DM, DM, (bf16*)((unsigned char*)wl + W_OUT_OFF), scr, r / 32, r % 32, C.lane); continue; } r -= I_OUT;
        if (r < I_1) { transpose_item(A.in[29] + (size_t)layer * DM * DFF, DM, DFF, (bf16*)((unsigned char*)wl + W_1_OFF), scr, r / 128, r % 128, C.lane); continue; } r -= I_1;
        transpose_item(A.in[30] + (size_t)layer * DFF * DM, DFF, DM, (bf16*)((unsigned char*)wl + W_2_OFF), scr, r / 32, r % 32, C.lane);
    }
}
__device__ __forceinline__ void phase_pro2(const Ctx& C, KArgs& A) {
    const float* modp = (const float*)(A.ws + WS_MODP); const float* ada_b = A.in[5]; float* mod = (float*)(A.ws + WS_MOD);
    for (int i = C.bid * NTHR + C.tid; i < DEPTH * 5 * 12288; i += C.G * NTHR) {
        const int layer = i / (5 * 12288), r = i % (5 * 12288), n = r % 12288;
        float s = ada_b[layer * 12288 + n];
#pragma unroll
        for (int kc = 0; kc < 8; ++kc) s += modp[(size_t)(kc * 4 + layer) * 5 * 12288 + r];
        mod[i] = s;
    }
}

__device__ __forceinline__ void norm_row_v(const f32x4 (&v)[8], const float* nw, const float* sh, const float* sc, bf16* orow, int lane) {
    float s = 0.f;
#pragma unroll
    for (int j = 0; j < 8; ++j) s += (v[j].x * v[j].x + v[j].y * v[j].y) + (v[j].z * v[j].z + v[j].w * v[j].w);
    const float rstd = 1.0f / sqrtf(wave_sum(s) * (1.f / DM) + EPS);
#pragma unroll
    for (int j = 0; j < 8; ++j) { const int c4 = lane + 64 * j; const f32x4 w = ((const f32x4*)nw)[c4], a = ((const f32x4*)sc)[c4], b = ((const f32x4*)sh)[c4];
        const f32x4 y = v[j] * rstd * w * (a + 1.0f) + b;
        *(unsigned long long*)(orow + 4 * c4) = (unsigned long long)pk2(y.x, y.y) | ((unsigned long long)pk2(y.z, y.w) << 32); }
}
__device__ __forceinline__ const float* norm_src(KArgs& A, int layer, int which, int m) {
    return (layer == 0 && which == 0) ? ((m < M_LAT) ? A.in[0] + (size_t)m * DM : A.in[2] + (size_t)(m - M_LAT) * DM) : (const float*)(A.ws + WS_X) + (size_t)m * DM;
}
__device__ __forceinline__ void phase_norm(const Ctx& C, KArgs& A, int layer, int which  , int row_lo, int row_hi, int gw, int ngw) {
    bf16* XN = (bf16*)(A.ws + WS_XN);
    const float* nw = A.in[which ? 7 : 6] + layer * DM;
    const float* mod = (const float*)(A.ws + WS_MOD) + (size_t)layer * 5 * 12288 + (which ? 3 * DM : 0);
    int m = row_lo + gw; f32x4 cur[8];
    if (m < row_hi) { const f32x4* xr = (const f32x4*)norm_src(A, layer, which, m);
#pragma unroll
        for (int j = 0; j < 8; ++j) cur[j] = xr[C.lane + 64 * j]; }
    while (m < row_hi) { const int mn = m + ngw; f32x4 nxt[8];
        if (mn < row_hi) { const f32x4* xr = (const f32x4*)norm_src(A, layer, which, mn);
#pragma unroll
            for (int j = 0; j < 8; ++j) nxt[j] = xr[C.lane + 64 * j]; }
        const int b = (m < M_LAT) ? (m >> 12) : 4; const float* mb = mod + (size_t)b * 12288;
        norm_row_v(cur, nw, mb, mb + DM, XN + (size_t)m * DM, C.lane);
#pragma unroll
        for (int j = 0; j < 8; ++j) cur[j] = nxt[j];
        m = mn; }
}
__device__ __forceinline__ void phase_final(const Ctx& C, KArgs& A) {
    const float* X = (const float*)(A.ws + WS_X); const float* nw = A.in[31];
    int m = C.gw; f32x4 cur[8];
    if (m < M_LAT) { const f32x4* xr = (const f32x4*)(X + (size_t)m * DM);
#pragma unroll
        for (int j = 0; j < 8; ++j) cur[j] = xr[C.lane + 64 * j]; }
    while (m < M_LAT) { const int mn = m + C.NGW; f32x4 nxt[8];
        if (mn < M_LAT) { const f32x4* xr = (const f32x4*)(X + (size_t)mn * DM);
#pragma unroll
            for (int j = 0; j < 8; ++j) nxt[j] = xr[C.lane + 64 * j]; }
        float s = 0.f;
#pragma unroll
        for (int j = 0; j < 8; ++j) s += (cur[j].x * cur[j].x + cur[j].y * cur[j].y) + (cur[j].z * cur[j].z + cur[j].w * cur[j].w);
        const float rstd = 1.0f / sqrtf(wave_sum(s) * (1.f / DM) + EPS);
        f32x4* o = (f32x4*)(A.out + (size_t)m * DM);
#pragma unroll
        for (int j = 0; j < 8; ++j) { const int c4 = C.lane + 64 * j; o[c4] = cur[j] * rstd * ((const f32x4*)nw)[c4]; }
#pragma unroll
        for (int j = 0; j < 8; ++j) cur[j] = nxt[j];
        m = mn; }
}

__device__ __forceinline__ float hy_filter_hidden(const Ctx& C, KArgs& A, int layer, int L, int t) {
    const int lane = C.lane;
    const float* w1 = A.in[13] + layer * 33 * 64; const float* b1 = A.in[14] + layer * 64; const float* w2 = A.in[15] + layer * 4096; const float* b2 = A.in[16] + layer * 64;
    const float* w3 = A.in[17] + layer * 4096; const float* b3 = A.in[18] + layer * 64; const float* fr = A.in[20] + layer * 64;
    const float tl = (float)t / (float)(L - 1);
    const float wpos = (6.283185307179586f * (float)t) / (float)L;
    float z = 0.f;
    if (lane == 0) z = tl;
    else if (lane <= 32) { const int k = (lane - 1) & 15; const float f = 1e-4f + (float)k * ((15.0f - 1e-4f) / 15.0f); const float a = f * wpos; z = (lane <= 16) ? cosf(a) : -sinf(a); }
    const float frl = fr[lane];
    float pre = b1[lane];
    for (int e = 0; e < 33; ++e) pre += __shfl(z, e) * w1[e * 64 + lane];
    float h = sinf(frl * pre);
    pre = b2[lane];
    for (int i = 0; i < 64; ++i) pre += __shfl(h, i) * w2[i * 64 + lane];
    h = sinf(frl * pre);
    pre = b3[lane];
    for (int i = 0; i < 64; ++i) pre += __shfl(h, i) * w3[i * 64 + lane];
    return sinf(frl * pre);
}
__device__ __forceinline__ void hy_filter_core(const Ctx& C, KArgs& A, int layer, int L, int t, float (&acc)[32]) {
    const int lane = C.lane; const float* w4 = A.in[19] + (size_t)layer * 64 * 2048;
    const float tl = (float)t / (float)(L - 1);
    const float h = hy_filter_hidden(C, A, layer, L, t);
#pragma unroll
    for (int cc = 0; cc < 32; ++cc) acc[cc] = 0.f;
    for (int i = 0; i < 64; ++i) { const float hi = __shfl(h, i); const float* wr = w4 + (size_t)i * 2048 + lane;
#pragma unroll
        for (int cc = 0; cc < 32; ++cc) acc[cc] += hi * wr[cc * 64]; }
    const float dmin = 3.0701134573253945f, dmax = 15.350567286626973f;
#pragma unroll
    for (int cc = 0; cc < 32; ++cc) { const int c = (cc * 64 + lane) & 511; const float delta = dmin + (float)c * ((dmax - dmin) / 511.0f); acc[cc] *= expf(-tl * delta); }
}
__device__ __forceinline__ void hy_filter_item(const Ctx& C, KArgs& A, int layer, int L, int t, float* G) {
    float acc[32]; hy_filter_core(C, A, layer, L, t, acc);
    const float* skip = A.in[21] + layer * 1024; const int W = 2 * L - 1, lane = C.lane;
#pragma unroll
    for (int cc = 0; cc < 32; ++cc) { const int col = cc * 64 + lane, o = col >> 10, r = (col >> 9) & 1, c = col & 511;
        float val = acc[cc];
        if (r == 0) { if (t == 0) val += skip[o * 512 + c]; G[((size_t)o * W + (L - 1 + t)) * 512 + c] = val; }
        else if (t > 0) G[((size_t)o * W + (L - 1 - t)) * 512 + c] = val; }
}
template <int L>
__device__ __forceinline__ void hy_filter_unit16(const Ctx& C, KArgs& A, int layer, int t0, void* Gout) {
    LAS bf16* H3 = (LAS bf16*)C.lds;
    __syncthreads();
#pragma unroll 1
    for (int q = 0; q < 2; ++q) { const int pi = 2 * C.wave + q; const float h = hy_filter_hidden(C, A, layer, L, t0 + pi); H3[pi * 64 + C.lane] = (bf16)f2bf(h); }
    __syncthreads();
    int lane = C.lane; asm volatile("" : "+v"(lane));
    const int li = lane & 15, g = lane >> 4, tq = t0 + 4 * g;
    const bf16x8 ha0 = *(const LAS bf16x8*)(H3 + li * 64 + 8 * g), ha1 = *(const LAS bf16x8*)(H3 + li * 64 + 32 + 8 * g);
    const bf16* w4t = (const bf16*)(A.ws + WS_W4T) + (size_t)layer * 2048 * 64; const float* skip = A.in[21] + layer * 1024;
    const float dmin = 3.0701134573253945f, dmax = 15.350567286626973f, inv = 1.0f / (float)(L - 1);
#pragma unroll 2
    for (int i = 0; i < 16; ++i) { const int n = 16 * (C.wave * 16 + i) + li;
        const bf16* wr = w4t + (size_t)n * 64 + 8 * g;
        f32x4 acc = __builtin_amdgcn_mfma_f32_16x16x32_bf16(ha0, *(const bf16x8*)wr, (f32x4){0.f, 0.f, 0.f, 0.f}, 0, 0, 0);
        acc = __builtin_amdgcn_mfma_f32_16x16x32_bf16(ha1, *(const bf16x8*)(wr + 32), acc, 0, 0, 0);
        const int o = n >> 10, dir = (n >> 9) & 1, c = n & 511; const float delta = dmin + (float)c * ((dmax - dmin) / 511.0f);
        float v[4];
#pragma unroll
        for (int r = 0; r < 4; ++r) v[r] = acc[r] * expf(-((float)(tq + r) * inv) * delta);
        if (dir == 0 && tq == 0) v[0] += skip[o * 512 + c];
        if (L == SEQ) { bf16* gp = (bf16*)Gout + ((size_t)(o * 512 + c)) * 8192 + (dir ? 0 : 4096) + tq;
            *(unsigned long long*)gp = (unsigned long long)pk2(v[0], v[1]) | ((unsigned long long)pk2(v[2], v[3]) << 32); }
        else { float* gq = (float*)Gout + (size_t)o * (2 * L - 1) * 512 + c;
#pragma unroll
            for (int r = 0; r < 4; ++r) { const int t = tq + r; if (dir == 0) gq[(size_t)(L - 1 + t) * 512] = v[r]; else if (t > 0) gq[(size_t)(L - 1 - t) * 512] = v[r]; } } }
}

constexpr int HY_CP_STRIDE = 16384 + 64;
constexpr int HY_U_OFF = 4 * HY_CP_STRIDE;
constexpr int HY_U_PITCH = 8992;
struct HyF { v4u w0, w1; };
__device__ __forceinline__ void hy_load_filter(HyF& f, const bf16* grow, int tid) { const v4u* gp = (const v4u*)(grow + 16 * tid); f.w0 = gp[0]; f.w1 = gp[1]; }
__device__ __forceinline__ void hy_store_filter(LAS unsigned char* lds, const HyF& f, int tid) {
    const v4u w0 = f.w0, w1 = f.w1;
    unsigned e[16];
    e[0] = w0.x & 0xffffu; e[1] = w0.x >> 16; e[2] = w0.y & 0xffffu; e[3] = w0.y >> 16; e[4] = w0.z & 0xffffu; e[5] = w0.z >> 16; e[6] = w0.w & 0xffffu; e[7] = w0.w >> 16;
    e[8] = w1.x & 0xffffu; e[9] = w1.x >> 16; e[10] = w1.y & 0xffffu; e[11] = w1.y >> 16; e[12] = w1.z & 0xffffu; e[13] = w1.z >> 16; e[14] = w1.w & 0xffffu; e[15] = w1.w >> 16;
#pragma unroll
    for (int j = 0; j < 16; ++j) { const int i = 16 * tid + j, x = (i >= 4096) ? 8191 - i : (i == 0 ? 8191 : 4095 + i); const bf16 val = (i == 0) ? (bf16)0 : (bf16)e[j];
#pragma unroll
        for (int k = 0; k < 4; ++k) { const int y = x - k; if (y >= 0) *(LAS bf16*)(lds + k * HY_CP_STRIDE + 2 * y) = val; } }
}
__device__ __forceinline__ void hy_load_u(v4u (&u)[4], const bf16* src, int tid) {
#pragma unroll
    for (int q = 0; q < 4; ++q) u[q] = ((const v4u*)src)[tid + 512 * q];
}
__device__ __forceinline__ void hy_store_u(LAS unsigned char* lds, const v4u (&u)[4], int tid) {
#pragma unroll
    for (int q = 0; q < 4; ++q) { const int idx = tid + 512 * q, el = 8 * idx, b = el >> 12, s = el & 4095; *(LAS v4u*)(lds + HY_U_OFF + b * HY_U_PITCH + 384 + 2 * s) = u[q]; }
    if (tid < 192) { const int b = tid / 48, r = tid % 48, side = r / 24, off = (r % 24) * 16; unsigned z0 = 0u; asm volatile("" : "+v"(z0)); v4u zz; zz.x = z0; zz.y = z0; zz.z = z0; zz.w = z0;
        *(LAS v4u*)(lds + HY_U_OFF + b * HY_U_PITCH + (side ? 384 + 8192 : 0) + off) = zz; }
}
__device__ __forceinline__ void hy_conv_mfma(LAS unsigned char* lds, f32x4 (&acc)[2][4], int wave, int lane) {
    typedef unsigned long long u64;
    const int wm = wave & 1, wn = wave >> 1, r = lane & 15, g = lane >> 4;
    const int kcp = (4095 - r) & 3;
    const int abase = kcp * HY_CP_STRIDE + 2 * (4095 - r - kcp + 8 * g) - 64 * wm;
    const int bbase = HY_U_OFF + (lane & 3) * HY_U_PITCH + 384 + 2 * (64 * (16 * wn + ((lane & 15) >> 2)) + 8 * g);
#pragma unroll 1
    for (int rho = 0; rho < 4; ++rho) {
        bf16x8 ring[4][2];
#pragma unroll 1
        for (int jq = 0; jq < 5; ++jq) {
#pragma unroll
            for (int k = 0; k < 4; ++k) {
                const int Dp = -63 + rho + 4 * (4 * jq + k);
                if (Dp <= 15) {
                    const int D = 16 * wn + Dp;
                    if (Dp <= 3) {
#pragma unroll
                        for (int kk = 0; kk < 2; ++kk) ring[k][kk] = *(const LAS bf16x8*)(lds + bbase - 128 * D + 64 * kk); }
                    bf16x8 af[2][2];
#pragma unroll
                    for (int m = 0; m < 2; ++m)
#pragma unroll
                        for (int kk = 0; kk < 2; ++kk) { const LAS u64* ap = (const LAS u64*)(lds + abase - 128 * D - 32 * m + 64 * kk); union { u64 q[2]; bf16x8 v; } cv; cv.q[0] = ap[0]; cv.q[1] = ap[1]; af[m][kk] = cv.v; }
#pragma unroll
                    for (int kk = 0; kk < 2; ++kk)
#pragma unroll
                        for (int nt = 0; nt < 4; ++nt) { const int e = Dp - 4 * nt;
                            if (e >= -63 && e <= 3) {
#pragma unroll
                                for (int m = 0; m < 2; ++m) acc[m][nt] = __builtin_amdgcn_mfma_f32_16x16x32_bf16(af[m][kk], ring[(k - nt) & 3][kk], acc[m][nt], 0, 0, 0); } }
                }
            }
        }
    }
}
__device__ __forceinline__ void hy_fast_units(const Ctx& C, KArgs& A) {
    LAS unsigned char* lds = C.lds;
    const bf16* GT = (const bf16*)(A.ws + WS_GT); const bf16* HUT = (const bf16*)(A.ws + WS_HUT); bf16* YT = (bf16*)(A.ws + WS_YT);
    int tid = C.tid; asm volatile("" : "+v"(tid));
    const int wave = C.wave, lane = tid & 63, wm = wave & 1, wn = wave >> 1, g = lane >> 4, bb = lane & 3, il = (lane & 15) >> 2;
    int c = C.bid; if (c >= 512) return;
    HyF fa; v4u ua[4];
    hy_load_filter(fa, GT + (size_t)c * 8192, tid); hy_load_u(ua, HUT + ((size_t)(2 * 512 + c)) * M_LAT, tid);
    while (c < 512) {
        const int cn = c + C.G;
        __syncthreads();
        hy_store_filter(lds, fa, tid); hy_store_u(lds, ua, tid);
        HyF fb; hy_load_filter(fb, GT + (size_t)(512 + c) * 8192, tid);
        unsigned long long xg[2][4];
        { const bf16* x1 = HUT + (size_t)c * M_LAT + bb * SEQ;
#pragma unroll
          for (int m = 0; m < 2; ++m)
#pragma unroll
              for (int nt = 0; nt < 4; ++nt) xg[m][nt] = *(const unsigned long long*)(x1 + 64 * (16 * wn + 4 * nt + il) + 16 * (2 * wm + m) + 4 * g); }
        __syncthreads();
        f32x4 acc[2][4];
#pragma unroll
        for (int m = 0; m < 2; ++m)
#pragma unroll
            for (int nt = 0; nt < 4; ++nt) acc[m][nt] = (f32x4){0.f, 0.f, 0.f, 0.f};
        hy_conv_mfma(lds, acc, wave, lane);
        __syncthreads();
#pragma unroll
        for (int m = 0; m < 2; ++m)
#pragma unroll
            for (int nt = 0; nt < 4; ++nt) { const int t = 64 * (16 * wn + 4 * nt + il) + 16 * (2 * wm + m) + 4 * g;
                const unsigned lo = (unsigned)xg[m][nt], hi = (unsigned)(xg[m][nt] >> 32);
                const float z0 = __uint_as_float(lo << 16) * acc[m][nt][0], z1 = __uint_as_float(lo & 0xffff0000u) * acc[m][nt][1], z2 = __uint_as_float(hi << 16) * acc[m][nt][2], z3 = __uint_as_float(hi & 0xffff0000u) * acc[m][nt][3];
                *(LAS unsigned long long*)(lds + HY_U_OFF + bb * HY_U_PITCH + 384 + 2 * t) = (unsigned long long)pk2(z0, z1) | ((unsigned long long)pk2(z2, z3) << 32); }
        hy_store_filter(lds, fb, tid);
        { const bf16* x2 = HUT + ((size_t)(512 + c)) * M_LAT + bb * SEQ;
#pragma unroll
          for (int m = 0; m < 2; ++m)
#pragma unroll
              for (int nt = 0; nt < 4; ++nt) xg[m][nt] = *(const unsigned long long*)(x2 + 64 * (16 * wn + 4 * nt + il) + 16 * (2 * wm + m) + 4 * g); }
        if (cn < 512) { hy_load_filter(fa, GT + (size_t)cn * 8192, tid); hy_load_u(ua, HUT + ((size_t)(2 * 512 + cn)) * M_LAT, tid); }
        __syncthreads();
#pragma unroll
        for (int m = 0; m < 2; ++m)
#pragma unroll
            for (int nt = 0; nt < 4; ++nt) acc[m][nt] = (f32x4){0.f, 0.f, 0.f, 0.f};
        hy_conv_mfma(lds, acc, wave, lane);
        { bf16* yo = YT + (size_t)c * M_LAT + bb * SEQ;
#pragma unroll
          for (int m = 0; m < 2; ++m)
#pragma unroll
              for (int nt = 0; nt < 4; ++nt) { const int t = 64 * (16 * wn + 4 * nt + il) + 16 * (2 * wm + m) + 4 * g;
                  const unsigned lo = (unsigned)xg[m][nt], hi = (unsigned)(xg[m][nt] >> 32);
                  const float z0 = __uint_as_float(lo << 16) * acc[m][nt][0], z1 = __uint_as_float(lo & 0xffff0000u) * acc[m][nt][1], z2 = __uint_as_float(hi << 16) * acc[m][nt][2], z3 = __uint_as_float(hi & 0xffff0000u) * acc[m][nt][3];
                  *(unsigned long long*)(yo + t) = (unsigned long long)pk2(z0, z1) | ((unsigned long long)pk2(z2, z3) << 32); } }
        c = cn;
    }
}
__device__ __forceinline__ void hy_prep_tile(const Ctx& C, KArgs& A, int layer, int tile) {
    const int lane = C.lane; LAS unsigned* T = (LAS unsigned*)(C.lds + C.wave * 8448);
    const int ct = tile % 24, tt = tile / 24, cb = ct * 64, row0 = tt * 64, t0 = row0 & 4095;
    const float* sw = A.in[11] + layer * 3 * 1536; const float* sb = A.in[12] + layer * 1536; const int ch = cb + lane;
    const float w0 = sw[ch], w1 = sw[1536 + ch], w2 = sw[3072 + ch], bias = sb[ch];
    const bf16* p = (const bf16*)(A.ws + WS_P) + (size_t)row0 * N_INP + OFF_HY + ch;
    float pm = (t0 > 0) ? bf2f(p[-(ptrdiff_t)N_INP]) : 0.f, pc = bf2f(p[0]), ae = 0.f;
#pragma unroll 8
    for (int i = 0; i < 64; ++i) { const float pn = (t0 + i + 1 < SEQ) ? bf2f(p[(size_t)(i + 1) * N_INP]) : 0.f; const float a = bias + w0 * pm + w1 * pc + w2 * pn; pm = pc; pc = pn;
        if (i & 1) T[lane * 33 + (i >> 1)] = pk2(ae, a); else ae = a; }
    LDS_WAIT(); asm volatile("" ::: "memory");
    unsigned* dst = (unsigned*)((bf16*)(A.ws + WS_HUT) + (size_t)cb * M_LAT + row0);
#pragma unroll 8
    for (int ii = 0; ii < 32; ++ii) { const int rr = 2 * ii + (lane >> 5), j = lane & 31; dst[(size_t)rr * (M_LAT / 2) + j] = T[rr * 33 + j]; }
    LDS_WAIT(); asm volatile("" ::: "memory");
}
__device__ __forceinline__ void hy_post_tile(const Ctx& C, KArgs& A, int tile) {
    const int lane = C.lane; LAS unsigned char* T = C.lds + C.wave * 8448;
    const int ct = tile & 7, tt = tile >> 3, cb = ct * 64, row0 = tt * 64;
    const unsigned* src = (const unsigned*)((const bf16*)(A.ws + WS_YT) + (size_t)cb * M_LAT + row0);
#pragma unroll
    for (int ii = 0; ii < 32; ++ii) { const int rr = 2 * ii + (lane >> 5), j = lane & 31; const unsigned w = src[(size_t)rr * (M_LAT / 2) + j];
        *(LAS bf16*)(T + (2 * j) * 132 + 2 * rr) = (bf16)(w & 0xffffu); *(LAS bf16*)(T + (2 * j + 1) * 132 + 2 * rr) = (bf16)(w >> 16); }
    LDS_WAIT(); asm volatile("" ::: "memory");
    unsigned* dst = (unsigned*)((bf16*)(A.ws + WS_Y) + (size_t)row0 * DM + 512 + cb);
#pragma unroll
    for (int ii = 0; ii < 32; ++ii) { const int rr = 2 * ii + (lane >> 5), j = lane & 31; dst[(size_t)rr * (DM / 2) + j] = *(const LAS unsigned*)(T + rr * 132 + 4 * j); }
    LDS_WAIT(); asm volatile("" ::: "memory");
}

struct PrepDesc { int col0, nch; const float* w; int wstride; const float* bias; bool silu; int cm_count; bf16* dst_cm; size_t cm_stride; int cm_col; bf16* dst_tm; int tm_stride; };
__device__ __forceinline__ void prep_load(KArgs& A, const PrepDesc& D, int r0, int t0, int L, int tid, v4u (&v)[5]) {
    const bf16* P = (const bf16*)(A.ws + WS_P); const int cpr = D.nch >> 3; const bool conv = D.w != nullptr, hp = conv && t0 > 0, hn = conv && (t0 + 32 < L);
#pragma unroll
    for (int i = 0; i < 5; ++i) { const int idx = tid + NTHR * i, rr = idx / cpr, part = idx - rr * cpr; const bool ok = idx < 34 * cpr && ((rr == 0) ? hp : ((rr == 33) ? hn : true));
        v[i].x = 0u; v[i].y = 0u; v[i].z = 0u; v[i].w = 0u; if (ok) v[i] = *(const v4u*)(P + (size_t)(r0 - 1 + rr) * N_INP + D.col0 + 8 * part); }
}
__device__ __forceinline__ void prep_desc(KArgs& A, int layer, int u, PrepDesc& D, int& r0, int& t0, int& L) {
    const int NT_L = M_LAT / 32, NT_A = M_ALL / 32; const int nH = 3 * NT_L, nS = 2 * NT_A; int tt;
    if (u < nH) { const int k = u / NT_L; tt = u - k * NT_L; D.col0 = OFF_HY + 512 * k; D.nch = 512; D.w = A.in[11] + layer * 3 * 1536 + 512 * k; D.wstride = 1536; D.bias = A.in[12] + layer * 1536 + 512 * k; D.silu = false;
        D.cm_count = 512; D.dst_cm = (bf16*)(A.ws + WS_HUT) + (size_t)(512 * k) * M_LAT; D.cm_stride = M_LAT; D.cm_col = 32 * tt; D.dst_tm = nullptr; D.tm_stride = 0; }
    else if (u < nH + nS) { const int v = u - nH, k = v / NT_A; tt = v - k * NT_A; D.col0 = OFF_SSM + 512 + 512 * k; D.nch = 512; D.w = A.in[23] + layer * 3 * 1024 + 512 * k; D.wstride = 1024; D.bias = A.in[24] + layer * 1024 + 512 * k; D.silu = true;
        D.cm_count = k ? 256 : 512; D.dst_cm = (bf16*)(A.ws + WS_XBCT) + (size_t)(512 * k) * M_ALL; D.cm_stride = M_ALL; D.cm_col = 32 * tt; D.dst_tm = (bf16*)(A.ws + WS_XBC) + 512 * k; D.tm_stride = 1024; }
    else { const int v = u - nH - nS, k = v / NT_A; tt = v - k * NT_A; D.col0 = k ? OFF_NA + 1024 : 640; D.nch = k ? 512 : 128; D.w = nullptr; D.wstride = 0; D.bias = nullptr; D.silu = false;
        D.cm_count = D.nch; D.dst_cm = (bf16*)(A.ws + WS_VT) + (size_t)(k ? 128 : 0) * M_ALL; D.cm_stride = M_ALL; D.cm_col = 32 * tt; D.dst_tm = nullptr; D.tm_stride = 0; }
    r0 = 32 * tt; if (r0 < M_LAT) { t0 = r0 & 4095; L = SEQ; } else { t0 = (r0 - M_LAT) & 255; L = LC; }
}
__device__ __forceinline__ void phase_prep_units(const Ctx& C, KArgs& A, int layer) {
    LAS unsigned char* lds = C.lds; constexpr int OFF_T = 36864, OFF_O = 81920;
    const int N = 3 * (M_LAT / 32) + 4 * (M_ALL / 32);
    int tid = C.tid; asm volatile("" : "+v"(tid));
    int u = C.bid; v4u v[5];
    if (u < N) { PrepDesc D0; int a0, b0, c0; prep_desc(A, layer, u, D0, a0, b0, c0); prep_load(A, D0, a0, b0, c0, tid, v); }
    while (u < N) {
        PrepDesc D; int r0, t0, L; prep_desc(A, layer, u, D, r0, t0, L);
        const int cpr = D.nch >> 3;
        __syncthreads();
#pragma unroll
        for (int i = 0; i < 5; ++i) { const int idx = tid + NTHR * i, rr = idx / cpr, part = idx - rr * cpr; if (idx < 34 * cpr) *(LAS v4u*)(lds + (rr * D.nch + 8 * part) * 2) = v[i]; }
        const int un = u + C.G;
        if (un < N) { PrepDesc Dn; int r0n, t0n, Ln; prep_desc(A, layer, un, Dn, r0n, t0n, Ln); prep_load(A, Dn, r0n, t0n, Ln, tid, v); }
        __syncthreads();
        if (tid < D.nch) { const int c = tid; float w0 = 0.f, w1 = 1.f, w2 = 0.f, bs = 0.f;
            if (D.w != nullptr) { w0 = D.w[c]; w1 = D.w[D.wstride + c]; w2 = D.w[2 * D.wstride + c]; bs = D.bias[c]; }
            const LAS bf16* in = (const LAS bf16*)lds + c; float pm = bf2f(in[0]), pc = bf2f(in[D.nch]), ae = 0.f;
            const bool cm = c < D.cm_count, tm = D.dst_tm != nullptr;
#pragma unroll 8
            for (int t = 0; t < 32; ++t) { const float pn = bf2f(in[(t + 2) * D.nch]); float a = bs + w0 * pm + w1 * pc + w2 * pn; if (D.silu) a = silu_f(a); pm = pc; pc = pn;
                if (tm) *(LAS bf16*)(lds + OFF_O + (t * D.nch + c) * 2) = (bf16)f2bf(a);
                if (t & 1) { if (cm) *(LAS unsigned*)(lds + OFF_T + c * 80 + (t >> 1) * 4) = pk2(ae, a); } else ae = a; } }
        __syncthreads();
        for (int idx = tid; idx < D.cm_count * 4; idx += NTHR) { const int c = idx >> 2, part = idx & 3; *(v4u*)(D.dst_cm + (size_t)c * D.cm_stride + D.cm_col + 8 * part) = *(const LAS v4u*)(lds + OFF_T + c * 80 + part * 16); }
        if (D.dst_tm) for (int idx = tid; idx < 32 * cpr; idx += NTHR) { const int t = idx / cpr, part = idx - t * cpr; *(v4u*)(D.dst_tm + (size_t)(r0 + t) * D.tm_stride + 8 * part) = *(const LAS v4u*)(lds + OFF_O + (t * D.nch + 8 * part) * 2); }
        u = un;
    }
    __syncthreads();
}

__device__ __forceinline__ void prep_dt(const Ctx& C, KArgs& A, int layer) {
    const bf16* P = (const bf16*)(A.ws + WS_P); float* DT = (float*)(A.ws + WS_DT);
    for (int i = C.bid * NTHR + C.tid; i < M_ALL * 16; i += C.G * NTHR) { const int row = i >> 4, j = i & 15;
        const float raw = bf2f(P[(size_t)row * N_INP + OFF_SSM + 1536 + j]) + A.in[25][layer * 16 + j]; const float dt = raw > 20.f ? raw : log1pf(expf(raw));
        DT[i] = dt; DT[(size_t)M_ALL * 16 + i] = -expf(A.in[26][layer * 16 + j]) * dt; }
}
__device__ __forceinline__ void prep_row(const Ctx& C, KArgs& A, int layer, int row) {
    const int lane = C.lane;
    const bf16* prow = (const bf16*)(A.ws + WS_P) + (size_t)row * N_INP;
    const int t = (row - M_LAT) & 255; const bool hp = t > 0, hn = t < LC - 1;
    const bf16* pm = prow - N_INP; const bf16* pp = prow + N_INP;
    const float* sw = A.in[11] + layer * 3 * 1536; const float* sb = A.in[12] + layer * 1536; float* HU = (float*)(A.ws + WS_HU) + (size_t)row * 1536;
#pragma unroll
    for (int i = 0; i < 24; ++i) { const int ch = lane + 64 * i, col = OFF_HY + ch;
        float a = sb[ch] + sw[1536 + ch] * bf2f(prow[col]); if (hp) a += sw[ch] * bf2f(pm[col]); if (hn) a += sw[3072 + ch] * bf2f(pp[col]);
        HU[ch] = a; }
}

constexpr float ATT_SC = 0.125f * 1.4426950408889634f, LOG2E = 1.4426950408889634f;
struct SD_A { int b, base, ilo, nloc;
    __device__ __forceinline__ void init(int b_, int n, int hh) { b = b_; base = n * 128 + 64 * hh - 128; ilo = base < 0 ? (-base) >> 5 : 0; int ihi = (SEQ - base) >> 5; ihi = ihi > 10 ? 10 : ihi; nloc = ihi - ilo; }
    __device__ __forceinline__ int nsteps() const { return nloc + 8; }
    __device__ __forceinline__ int seg(int j, int& code) const { if (j < nloc) { code = ilo + j; return b * SEQ + base + 32 * code; } code = -1; return M_LAT + b * LC + 32 * (j - nloc); }
    __device__ __forceinline__ void mask(int code, int qt, int li, int g, float (&sv)[8]) const { if (code < 0 || (code >= 2 && code <= 7)) return; const int d0 = 32 * code + 4 * g - li - 16 * qt;
#pragma unroll
        for (int j = 0; j < 8; ++j) sv[j] = ((unsigned)(d0 + (j & 3) + 16 * (j >> 2)) <= 256u) ? sv[j] : -INFINITY; } };
struct SD_NA { int b, r, rstart; const LAS float* rpb;
    __device__ __forceinline__ int nsteps() const { return 24; }
    __device__ __forceinline__ int seg(int j, int& code) const { if (j < 16) { code = j; return b * SEQ + (rstart + (j >> 1)) * 64 + 32 * (j & 1); } code = -1; return M_LAT + b * LC + 32 * (j - 16); }
    __device__ __forceinline__ void mask(int code, int qt, int li, int g, float (&sv)[8]) const { if (code < 0) return; const int c = 16 * qt + li; int c0 = c - 8; c0 = c0 < 0 ? 0 : (c0 > 48 ? 48 : c0);
        const int lo = c0 - c, d0 = 32 * (code & 1) + 4 * g - c, rowb = (rstart + (code >> 1) - r + 7) * 31 + 15;
        float bias[8]; const volatile LAS float* rp = (const volatile LAS float*)rpb;
#pragma unroll
        for (int j = 0; j < 8; ++j) { const int d = d0 + (j & 3) + 16 * (j >> 2); const bool ok = (unsigned)(d - lo) < 16u; bias[j] = rp[ok ? rowb + d : 0]; }
#pragma unroll
        for (int j = 0; j < 8; ++j) { const int d = d0 + (j & 3) + 16 * (j >> 2); const bool ok = (unsigned)(d - lo) < 16u; sv[j] = ok ? sv[j] + bias[j] : -INFINITY; } } };
struct SD_CTX { int b;
    __device__ __forceinline__ int nsteps() const { return 8; }
    __device__ __forceinline__ int seg(int j, int& code) const { code = -1; return M_LAT + b * LC + 32 * j; }
    __device__ __forceinline__ void mask(int, int, int, int, float (&)[8]) const {} };

struct AttnKV { bf16x8 kf[2][2], vf[4]; };
__device__ __forceinline__ void attn_load(AttnKV& kv, __amdgpu_buffer_rsrc_t rp, __amdgpu_buffer_rsrc_t rv, int rowstart, int kcol, unsigned koff, unsigned voff) {
    const int ks = (rowstart * N_INP + kcol) * 2, vs = rowstart * 2;
#pragma unroll
    for (int half = 0; half < 2; ++half)
#pragma unroll
        for (int kk = 0; kk < 2; ++kk) { union { v4u u; bf16x8 x; } cv; cv.u = __builtin_amdgcn_raw_buffer_load_b128(rp, koff, ks + 16 * half * N_INP * 2 + 64 * kk, 0); kv.kf[half][kk] = cv.x; }
#pragma unroll
    for (int dt = 0; dt < 4; ++dt) { typedef unsigned v2u_ __attribute__((ext_vector_type(2))); union { v2u_ q[2]; bf16x8 x; } cv;
        cv.q[0] = __builtin_amdgcn_raw_buffer_load_b64(rv, voff, vs + 16 * dt * M_ALL * 2, 0); cv.q[1] = __builtin_amdgcn_raw_buffer_load_b64(rv, voff, vs + 16 * dt * M_ALL * 2 + 32, 0); kv.vf[dt] = cv.x; }
}
template <class SD>
__device__ __forceinline__ void attn_step(const AttnKV& kv, const SD& sd, int code, const LAS bf16x8* ql, f32x4 (&O)[4][4], float (&mrun)[4], float (&lrun)[4], int li, int g) {
    asm volatile("" : "+v"(li), "+v"(g));
#pragma unroll
    for (int qt = 0; qt < 4; ++qt) {
        const bf16x8 q0 = ql[(qt * 2 + 0) * 64], q1 = ql[(qt * 2 + 1) * 64];
        f32x4 s0 = __builtin_amdgcn_mfma_f32_16x16x32_bf16(kv.kf[0][0], q0, (f32x4){0.f, 0.f, 0.f, 0.f}, 0, 0, 0); f32x4 s1 = __builtin_amdgcn_mfma_f32_16x16x32_bf16(kv.kf[1][0], q0, (f32x4){0.f, 0.f, 0.f, 0.f}, 0, 0, 0);
        s0 = __builtin_amdgcn_mfma_f32_16x16x32_bf16(kv.kf[0][1], q1, s0, 0, 0, 0); s1 = __builtin_amdgcn_mfma_f32_16x16x32_bf16(kv.kf[1][1], q1, s1, 0, 0, 0);
        float sv[8];
#pragma unroll
        for (int r = 0; r < 4; ++r) { sv[r] = s0[r]; sv[4 + r] = s1[r]; }
        sd.mask(code, qt, li, g, sv);
        float tmax = fmaxf(fmaxf(fmaxf(sv[0], sv[1]), fmaxf(sv[2], sv[3])), fmaxf(fmaxf(sv[4], sv[5]), fmaxf(sv[6], sv[7])));
        tmax = fmaxf(tmax, __shfl_xor(tmax, 16)); tmax = fmaxf(tmax, __shfl_xor(tmax, 32));
        if (__builtin_amdgcn_ballot_w64(tmax > mrun[qt]) != 0ull) {
            const float mnew = fmaxf(mrun[qt], tmax), alpha = __builtin_amdgcn_exp2f(mrun[qt] - mnew); mrun[qt] = mnew; lrun[qt] *= alpha;
#pragma unroll
            for (int dt = 0; dt < 4; ++dt) O[qt][dt] = O[qt][dt] * alpha; }
        float p[8], ps = 0.f; const float mq = mrun[qt];
#pragma unroll
        for (int j = 0; j < 8; ++j) { p[j] = __builtin_amdgcn_exp2f(sv[j] - mq); ps += p[j]; }
        lrun[qt] += ps;
        union { unsigned u[4]; bf16x8 x; } pf; pf.u[0] = pk2(p[0], p[1]); pf.u[1] = pk2(p[2], p[3]); pf.u[2] = pk2(p[4], p[5]); pf.u[3] = pk2(p[6], p[7]);
#pragma unroll
        for (int dt = 0; dt < 4; ++dt) O[qt][dt] = __builtin_amdgcn_mfma_f32_16x16x32_bf16(kv.vf[dt], pf.x, O[qt][dt], 0, 0, 0);
    }
}
template <class SD, int DIAG = 0>
__device__ __forceinline__ void attn_core(const bf16* P, const bf16* VT, int qrow0, int qcol, int kcol, const SD& sd, bool has_sink, float sink, bf16* Ybase, int ocol, int lane, LAS bf16x8* ql) {
    const int li = lane & 15, g = lane >> 4;
    ql += lane;
    const unsigned koff = (unsigned)(li * N_INP + 8 * g) * 2u, voff = (unsigned)(li * M_ALL + 4 * g) * 2u;
    const int ns = sd.nsteps();
    const __amdgpu_buffer_rsrc_t rp = __builtin_amdgcn_make_buffer_rsrc((void*)P, 0, (int)((size_t)M_ALL * N_INP * 2), 0x00020000);
    const __amdgpu_buffer_rsrc_t rv = __builtin_amdgcn_make_buffer_rsrc((void*)VT, 0, 64 * M_ALL * 2, 0x00020000);
    const __amdgpu_buffer_rsrc_t ry = __builtin_amdgcn_make_buffer_rsrc((void*)Ybase, 0, (int)((size_t)M_ALL * DM * 2), 0x00020000);
    const unsigned yoff = (unsigned)(li * DM + 4 * g) * 2u;
    v4u qraw[4][2];
#pragma unroll
    for (int qt = 0; qt < 4; ++qt)
#pragma unroll
        for (int kk = 0; kk < 2; ++kk) qraw[qt][kk] = *(const v4u*)(P + (size_t)(qrow0 + 16 * qt + li) * N_INP + qcol + 32 * kk + 8 * g);
    AttnKV kva, kvb; int ca, cb;
    { const int rs = sd.seg(0, ca); attn_load(kva, rp, rv, rs, kcol, koff, voff); }
#pragma unroll
    for (int qt = 0; qt < 4; ++qt)
#pragma unroll
        for (int kk = 0; kk < 2; ++kk) { union { v4u u; bf16x8 x; } qv; qv.u = qraw[qt][kk];
#pragma unroll
            for (int e = 0; e < 4; ++e) { const unsigned w = qv.u[e]; qv.u[e] = pk2(__uint_as_float(w << 16) * ATT_SC, __uint_as_float(w & 0xffff0000u) * ATT_SC); }
            ql[(qt * 2 + kk) * 64] = qv.x; }
    LDS_WAIT(); asm volatile("" ::: "memory");
    f32x4 O[4][4]; float mrun[4], lrun[4];
#pragma unroll
    for (int qt = 0; qt < 4; ++qt) { mrun[qt] = has_sink ? sink * LOG2E : -1e30f; lrun[qt] = (has_sink && g == 0) ? 1.f : 0.f;
#pragma unroll
        for (int dt = 0; dt < 4; ++dt) O[qt][dt] = (f32x4){0.f, 0.f, 0.f, 0.f}; }
    if (DIAG == 0) {
#pragma unroll 1
    for (int step = 0; step < ns; step += 2) {
        if (step + 1 < ns) { const int rs = sd.seg(step + 1, cb); attn_load(kvb, rp, rv, rs, kcol, koff, voff); }
        attn_step(kva, sd, ca, ql, O, mrun, lrun, li, g);
        if (step + 1 < ns) {
            if (step + 2 < ns) { const int rs = sd.seg(step + 2, ca); attn_load(kva, rp, rv, rs, kcol, koff, voff); }
            attn_step(kvb, sd, cb, ql, O, mrun, lrun, li, g);
        }
    }
    }
#pragma unroll
    for (int qt = 0; qt < 4; ++qt) { float lt = lrun[qt]; lt += __shfl_xor(lt, 16); lt += __shfl_xor(lt, 32); const float inv = 1.0f / lt;
        const int so = ((qrow0 + 16 * qt) * DM + ocol) * 2;
#pragma unroll
        for (int dt = 0; dt < 4; ++dt) { const f32x4 o = O[qt][dt] * inv; typedef unsigned v2u_ __attribute__((ext_vector_type(2))); v2u_ w; w.x = pk2(o[0], o[1]); w.y = pk2(o[2], o[3]);
            __builtin_amdgcn_raw_buffer_store_b64(w, ry, yoff, so + 32 * dt, 0); } }
}

template <int DIAG = 0>
__device__ __forceinline__ void phase_attn(const Ctx& C, KArgs& A, int layer, bool need_ctx) {
    const bf16* P = (const bf16*)(A.ws + WS_P); bf16* Y = (bf16*)(A.ws + WS_Y); const bf16* VT = (const bf16*)(A.ws + WS_VT);
    const float* sinkp = A.in[10] + layer * 8; const float* rpb = A.in[22] + (size_t)layer * 8 * 15 * 31;
    LAS bf16x8* ql = (LAS bf16x8*)(C.lds + C.wave * 8192);
    const int nA = NB * 32 * 8 * 2, nN = NB * 8 * 64, nC = need_ctx ? NB * 8 * 4 : 0;
    const int ctx_r = (C.bid >= 80 && C.wave < 2) ? (C.bid - 80) + (C.G - 80) * C.wave : 1 << 20;
#pragma unroll 1
    for (int k = 0; k < 3; ++k) { const int it = (k < 2) ? C.gw + k * C.NGW : nA + nN + ctx_r;
        if (it >= nA + nN + 2 * nC) break;
        int r = it;
        if (r < nA) { const int hh = r & 1, hq = (r >> 1) & 7, n = (r >> 4) & 31, b = r >> 9, hk = hq >> 2; SD_A sd; sd.init(b, n, hh);
            attn_core<decltype(sd), DIAG>(P, VT + (size_t)hk * 64 * M_ALL, b * SEQ + n * 128 + 64 * hh, 64 * hq, 512 + 64 * hk, sd, true, sinkp[hq], Y, 64 * hq, C.lane, ql); continue; } r -= nA;
        if (r < nN) { const int h = r & 7, rr = (r >> 3) & 63, b = r >> 9; int rstart = rr - 4; rstart = rstart < 0 ? 0 : (rstart > 56 ? 56 : rstart); LAS float* rl = (LAS float*)(C.lds + 65536 + C.wave * 2048);
            for (int i = C.lane; i < 465; i += 64) rl[i] = rpb[h * 465 + i] * LOG2E;
            LDS_WAIT(); asm volatile("" ::: "memory");
            SD_NA sd{b, rr, rstart, rl};
            attn_core<decltype(sd), DIAG>(P, VT + (size_t)(2 + h) * 64 * M_ALL, b * SEQ + rr * 64, OFF_NA + 64 * h, OFF_NA + 512 + 64 * h, sd, false, 0.f, Y, 1024 + 64 * h, C.lane, ql); continue; } r -= nN;
        if (r < nC) { const int blk = r & 3, hq = (r >> 2) & 7, b = r >> 5, hk = hq >> 2; SD_CTX sd{b};
            attn_core<decltype(sd), DIAG>(P, VT + (size_t)hk * 64 * M_ALL, M_LAT + b * LC + 64 * blk, 64 * hq, 512 + 64 * hk, sd, true, sinkp[hq], Y, 64 * hq, C.lane, ql); continue; } r -= nC;
        { const int blk = r & 3, h = (r >> 2) & 7, b = r >> 5; SD_CTX sd{b};
            attn_core<decltype(sd), DIAG>(P, VT + (size_t)(2 + h) * 64 * M_ALL, M_LAT + b * LC + 64 * blk, OFF_NA + 64 * h, OFF_NA + 512 + 64 * h, sd, false, 0.f, Y, 1024 + 64 * h, C.lane, ql); }
    }
}
__device__ __forceinline__ void vt_prep_tile(const Ctx& C, KArgs& A, int tile) {
    const int lane = C.lane; LAS unsigned* T = (LAS unsigned*)(C.lds + C.wave * 8448);
    const int slot = tile % 10, tt = tile / 10, row0 = tt * 64, col0 = (slot < 2) ? 640 + 64 * slot : OFF_NA + 1024 + 64 * (slot - 2);
    const bf16* p = (const bf16*)(A.ws + WS_P) + (size_t)row0 * N_INP + col0 + lane;
#pragma unroll 8
    for (int i = 0; i < 32; ++i) { const unsigned lo = p[(size_t)(2 * i) * N_INP], hi = p[(size_t)(2 * i + 1) * N_INP]; T[lane * 33 + i] = lo | (hi << 16); }
    LDS_WAIT(); asm volatile("" ::: "memory");
    unsigned* dst = (unsigned*)((bf16*)(A.ws + WS_VT) + (size_t)slot * 64 * M_ALL + row0);
#pragma unroll 8
    for (int ii = 0; ii < 32; ++ii) { const int rr = 2 * ii + (lane >> 5), j = lane & 31; dst[(size_t)rr * (M_ALL / 2) + j] = T[rr * 33 + j]; }
    LDS_WAIT(); asm volatile("" ::: "memory");
}

template <bool OUT_BF16>
__device__ __forceinline__ void hy_conv_unit(const float* U, int ustride, const float* G, int L, int rowbase, int t0, const float* gate, int gstride, void* outp, int ostride, int c) {
    float acc[16], old[16], nw[16], u[16];
#pragma unroll
    for (int i = 0; i < 16; ++i) { acc[i] = 0.f; old[i] = 0.f; }
#pragma unroll
    for (int m = 0; m < 15; ++m) old[m] = G[(size_t)(t0 + 1 + m + L - 1) * 512 + c];
    float un[16], nn[16];
#pragma unroll
    for (int k = 0; k < 16; ++k) un[k] = U[(size_t)(rowbase + k) * ustride + c];
#pragma unroll
    for (int m = 0; m < 16; ++m) nn[m] = G[(size_t)(t0 - 15 + m + L - 1) * 512 + c];
    for (int sb = 0; sb < L; sb += 16) {
#pragma unroll
        for (int k = 0; k < 16; ++k) { u[k] = un[k]; nw[k] = nn[k]; }
        if (sb + 16 < L) {
#pragma unroll
            for (int k = 0; k < 16; ++k) un[k] = U[(size_t)(rowbase + sb + 16 + k) * ustride + c];
#pragma unroll
            for (int m = 0; m < 16; ++m) nn[m] = G[(size_t)(t0 - sb - 16 - 15 + m + L - 1) * 512 + c]; }
#pragma unroll
        for (int i = 0; i < 16; ++i)
#pragma unroll
            for (int k = 0; k < 16; ++k) { const int j = i - k; acc[i] += u[k] * ((j <= 0) ? nw[j + 15] : old[j - 1]); }
#pragma unroll
        for (int m = 0; m < 16; ++m) old[m] = nw[m];
    }
#pragma unroll
    for (int i = 0; i < 16; ++i) { const size_t row = (size_t)(rowbase + t0 + i); const float v = gate[row * gstride + c] * acc[i];
        if (OUT_BF16) ((bf16*)outp)[row * ostride + c] = (bf16)f2bf(v); else ((float*)outp)[row * ostride + c] = v; }
}
__device__ __forceinline__ void phase_hyconv(const Ctx& C, KArgs& A, int layer, int order, bool need_ctx, int first_wg = 0) {
    const float* HU = (const float*)(A.ws + WS_HU); float* Z = (float*)(A.ws + WS_Z); bf16* Y = (bf16*)(A.ws + WS_Y);
    const float* GL = (const float*)(A.ws + WS_GLAT) + (size_t)order * (2 * SEQ - 1) * 512; const float* GC = (const float*)(A.ws + ((layer & 1) ? WS_GCTX1 : WS_GCTX)) + (size_t)order * (2 * LC - 1) * 512;
    const int nl = 0, nc = need_ctx ? NB * (LC / 16) : 0;
    for (int u = (C.bid >= first_wg) ? C.bid - first_wg : C.bid - first_wg + C.G; u < nl + nc; u += C.G) {
        int L, rowbase, t0; const float* G;
        if (u < nl) { const int b = u / (SEQ / 16); t0 = (u % (SEQ / 16)) * 16; L = SEQ; rowbase = b * SEQ; G = GL; }
        else { const int v = u - nl, b = v / (LC / 16); t0 = (v % (LC / 16)) * 16; L = LC; rowbase = M_LAT + b * LC; G = GC; }
        if (order == 0) hy_conv_unit<false>(HU + 1024, 1536, G, L, rowbase, t0, HU, 1536, Z, 512, C.tid);
        else hy_conv_unit<true>(Z, 512, G, L, rowbase, t0, HU + 512, 1536, Y + 512, DM, C.tid);
    }
}

__device__ __forceinline__ int ssd_rowbase(int b, int ci) { return ci < 2 ? M_LAT + b * LC + 128 * ci : b * SEQ + 128 * (ci - 2); }
__device__ __forceinline__ void ssd_tables(const Ctx& C, KArgs& A, int rowbase, int grp, LAS float* cs, LAS float* dtl, LAS float* wtab, float* cd_out) {
    const int w = C.wave, lane = C.lane, h = w & 3, d = w >> 2, head = grp * 4 + h;
    const float* DT = (const float*)(A.ws + WS_DT); const float* DTA = DT + (size_t)M_ALL * 16;
    const size_t i0 = (size_t)(rowbase + 2 * lane) * 16 + d * 8 + head;
    const float a0 = DTA[i0], a1 = DTA[i0 + 16], dt0 = DT[i0], dt1 = DT[i0 + 16];
    float incl = a0 + a1;
#pragma unroll
    for (int o = 1; o < 64; o <<= 1) { const float t = __shfl_up(incl, o); if (lane >= o) incl += t; }
    const float excl = incl - (a0 + a1), tot = __shfl(incl, 63);
    float c0, c1;
    if (d == 0) { c0 = excl + a0; c1 = incl; } else { c0 = tot - excl; c1 = tot - excl - a0; }
    cs[w * 128 + 2 * lane] = c0; cs[w * 128 + 2 * lane + 1] = c1; dtl[w * 128 + 2 * lane] = dt0; dtl[w * 128 + 2 * lane + 1] = dt1;
    wtab[w * 128 + 2 * lane] = dt0 * __expf(tot - c0); wtab[w * 128 + 2 * lane + 1] = dt1 * __expf(tot - c1);
    if (cd_out && lane == 0) cd_out[head * 2 + d] = __expf(tot);
}
constexpr int D1_XS = 12288;
__device__ __forceinline__ void ssd_d1_unit(const Ctx& C, KArgs& A, int b, int ci, int grp) {
    const int w = C.wave, rowbase = ssd_rowbase(b, ci);
    LAS float* cs = (LAS float*)C.lds; LAS float* dtl = cs + 1024; LAS float* wtab = dtl + 1024; LAS unsigned char* lds = C.lds;
    const bf16* XT = (const bf16*)(A.ws + WS_XBCT);
    __syncthreads();
    int tid = C.tid; asm volatile("" : "+v"(tid));
    ssd_tables(C, A, rowbase, grp, cs, dtl, wtab, (float*)(A.ws + WS_CD) + (size_t)(b * 34 + ci) * 16);
    { const bf16* xsrc = XT + (size_t)(grp * 256) * M_ALL + rowbase;
#pragma unroll
      for (int i = 0; i < 8; ++i) { const int q = tid + 512 * i, row = q >> 4, part = q & 15; *(LAS v4u*)(lds + D1_XS + row * 272 + part * 16) = *(const v4u*)(xsrc + (size_t)row * M_ALL + 8 * part); } }
    const int lane = tid & 63, g = lane >> 4, li = lane & 15;
    v4u braw[4];
#pragma unroll
    for (int kq = 0; kq < 4; ++kq) braw[kq] = *(const v4u*)(XT + (size_t)(512 + grp * 128 + 16 * w + li) * M_ALL + rowbase + 32 * kq + 8 * g);
    __syncthreads();
    float* SST = (float*)(A.ws + WS_SST);
#pragma unroll 1
    for (int hd = 0; hd < 8; ++hd) {
        const int h = hd & 3, d = hd >> 2, head = grp * 4 + h;
        bf16x8 bw[4];
#pragma unroll
        for (int kq = 0; kq < 4; ++kq) { const LAS f32x4* wp = (const LAS f32x4*)(wtab + hd * 128 + 32 * kq + 8 * g); const f32x4 w0 = wp[0], w1 = wp[1]; const v4u x = braw[kq];
            union { unsigned u[4]; bf16x8 v; } cv; cv.u[0] = pk2(__uint_as_float(x.x << 16) * w0.x, __uint_as_float(x.x & 0xffff0000u) * w0.y); cv.u[1] = pk2(__uint_as_float(x.y << 16) * w0.z, __uint_as_float(x.y & 0xffff0000u) * w0.w);
            cv.u[2] = pk2(__uint_as_float(x.z << 16) * w1.x, __uint_as_float(x.z & 0xffff0000u) * w1.y); cv.u[3] = pk2(__uint_as_float(x.w << 16) * w1.z, __uint_as_float(x.w & 0xffff0000u) * w1.w); bw[kq] = cv.v; }
        f32x4 acc[4];
        int xo = (h * 64 + li) * 272 + 16 * g; asm volatile("" : "+v"(xo));
#pragma unroll
        for (int pt = 0; pt < 4; ++pt) { acc[pt] = (f32x4){0.f, 0.f, 0.f, 0.f};
#pragma unroll
            for (int kq = 0; kq < 4; ++kq) { const bf16x8 xf = *(const LAS bf16x8*)(lds + D1_XS + xo + 16 * pt * 272 + 64 * kq);
                acc[pt] = __builtin_amdgcn_mfma_f32_16x16x32_bf16(xf, bw[kq], acc[pt], 0, 0, 0); } }
        float* so = SST + ((size_t)((b * 34 + ci) * 8 + head) * 2 + d) * 8192 + 16 * w + li;
#pragma unroll
        for (int pt = 0; pt < 4; ++pt)
#pragma unroll
            for (int r = 0; r < 4; ++r) so[(size_t)(16 * pt + 4 * g + r) * 128] = acc[pt][r];
    }
}
__device__ __forceinline__ void ssd_d2(const Ctx& C, KArgs& A) {
    const float* SST = (const float*)(A.ws + WS_SST); const float* CD = (const float*)(A.ws + WS_CD); bf16* HIN = (bf16*)(A.ws + WS_HIN);
    for (int e = C.bid * NTHR + C.tid; e < NB * 8 * 2 * 8192; e += C.G * NTHR) {
        const int pn = e & 8191, d = (e >> 13) & 1, head = (e >> 14) & 7, b = e >> 17;
        float H = 0.f;
        float sv[34], cv[34];
#pragma unroll
        for (int i = 0; i < 34; ++i) { const int ci = d ? (i < 2 ? 1 - i : 35 - i) : i; const size_t o = ((size_t)((b * 34 + ci) * 8 + head) * 2 + d); sv[i] = SST[o * 8192 + pn]; cv[i] = CD[o]; }
#pragma unroll
        for (int i = 0; i < 34; ++i) { const int ci = d ? (i < 2 ? 1 - i : 35 - i) : i;
            const size_t o = ((size_t)((b * 34 + ci) * 8 + head) * 2 + d); HIN[o * 8192 + pn] = (bf16)f2bf(H); H = cv[i] * H + sv[i]; }
    }
}
constexpr int D3_XS = 8192, D3_HS = D3_XS + 256 * 272, D3_PITCH = 272, D3_BS = D3_HS + 8192;
template <bool CTX>
__device__ __forceinline__ void ssd_d3_unit(const Ctx& C, KArgs& A, int layer, int b, int ci, int grp) {
    const int lane = C.lane, w = C.wave, g = lane >> 4, li = lane & 15, rowbase = ssd_rowbase(b, ci);
    LAS float* cs = (LAS float*)C.lds; LAS float* dtl = cs + 1024; LAS unsigned char* lds = C.lds;
    const bf16* XBC = (const bf16*)(A.ws + WS_XBC); const bf16* XT = (const bf16*)(A.ws + WS_XBCT);
    __syncthreads();
    int tid = C.tid; asm volatile("" : "+v"(tid));
    {
      LAS float* wt = (LAS float*)(lds + D3_HS);
      ssd_tables(C, A, rowbase, grp, cs, dtl, wt, nullptr);
      const bf16* xsrc = XT + (size_t)(grp * 256) * M_ALL + rowbase;
#pragma unroll
      for (int i = 0; i < 8; ++i) { const int q = tid + 512 * i, row = q >> 4, part = q & 15; *(LAS v4u*)(lds + D3_XS + row * D3_PITCH + part * 16) = *(const v4u*)(xsrc + (size_t)row * M_ALL + 8 * part); }
      const bf16* bsrc = XBC + (size_t)rowbase * 1024 + 512 + grp * 128;
#pragma unroll
      for (int i = 0; i < 4; ++i) { const int q = tid + 512 * i, row = q >> 4, part = q & 15; *(LAS v4u*)(lds + D3_BS + row * D3_PITCH + part * 16) = *(const v4u*)(bsrc + (size_t)row * 1024 + 8 * part); } }
    __syncthreads();
    int lrow = 16 * w + li;
    bf16x8 cf[4];
#pragma unroll
    for (int kk = 0; kk < 4; ++kk) cf[kk] = *(const bf16x8*)(XBC + (size_t)(rowbase + lrow) * 1024 + 768 + grp * 128 + 32 * kk + 8 * g);
    f32x4 T[8];
#pragma unroll
    for (int st = 0; st < 8; ++st) { T[st] = (f32x4){0.f, 0.f, 0.f, 0.f};
#pragma unroll
        for (int kk = 0; kk < 4; ++kk) { const bf16x8 bf_ = *(const LAS bf16x8*)(lds + D3_BS + (16 * st + li) * D3_PITCH + 64 * kk + 16 * g);
            T[st] = __builtin_amdgcn_mfma_f32_16x16x32_bf16(bf_, cf[kk], T[st], 0, 0, 0); }
        if ((st & 1) == 1) __builtin_amdgcn_sched_barrier(0); }
    f32x4 acc[4][4];
#pragma unroll
    for (int h = 0; h < 4; ++h)
#pragma unroll
        for (int pt = 0; pt < 4; ++pt) acc[h][pt] = (f32x4){0.f, 0.f, 0.f, 0.f};
    const int xoff0 = li * D3_PITCH + 8 * g, hoff0 = li * D3_PITCH + 16 * g, kqm = w >> 1;
#pragma unroll 1
    for (int d = 0; d < 2; ++d) {
      asm volatile("" : "+v"(tid));
      __syncthreads();
      {
        if (CTX) { const bool zero = (d == 0) ? (ci == 0) : (ci == 1); const float* sst = (const float*)(A.ws + WS_SST) + ((size_t)((b * 34 + (1 - ci)) * 8 + grp * 4) * 2 + d) * 8192;
#pragma unroll
            for (int i = 0; i < 8; ++i) { const int q = tid + 512 * i, h = q >> 10, within = q & 1023, row = within >> 4, part = within & 15; v4u o; o.x = 0u; o.y = 0u; o.z = 0u; o.w = 0u;
                if (!zero) { const f32x4* sp = (const f32x4*)(sst + (size_t)h * 2 * 8192 + row * 128 + 8 * part); const f32x4 a = sp[0], c = sp[1]; o.x = pk2(a[0], a[1]); o.y = pk2(a[2], a[3]); o.z = pk2(c[0], c[1]); o.w = pk2(c[2], c[3]); }
                *(LAS v4u*)(lds + D3_HS + (h * 64 + row) * D3_PITCH + part * 16) = o; } }
        else { const bf16* hsrc = (const bf16*)(A.ws + WS_HIN) + ((size_t)((b * 34 + ci) * 8 + grp * 4) * 2 + d) * 8192;
#pragma unroll
            for (int i = 0; i < 8; ++i) { const int q = tid + 512 * i, h = q >> 10, within = q & 1023, row = within >> 4, part = within & 15;
                *(LAS v4u*)(lds + D3_HS + (h * 64 + row) * D3_PITCH + part * 16) = *(const v4u*)(hsrc + (size_t)h * 2 * 8192 + row * 128 + 8 * part); } } }
      __syncthreads();
#pragma unroll
      for (int h = 0; h < 4; ++h) {
        const int hd = d * 4 + h;
        int lr = lrow; asm volatile("" : "+v"(lr));
        const float csl = cs[hd * 128 + lr];
        bf16x8 mf[4];
#pragma unroll
        for (int kq = 0; kq < 4; ++kq) { if (d ? (kq >= kqm) : (kq <= kqm)) { float v[8];
#pragma unroll
            for (int half = 0; half < 2; ++half) { const int s0 = 32 * kq + 16 * half + 4 * g; const f32x4 cv4 = *(const LAS f32x4*)(cs + hd * 128 + s0), dt4 = *(const LAS f32x4*)(dtl + hd * 128 + s0);
#pragma unroll
                for (int r = 0; r < 4; ++r) { const int s = s0 + r; const bool ok = d ? (s >= lr) : (s <= lr); const float e = __expf(fminf(csl - cv4[r], 0.f)) * dt4[r]; v[half * 4 + r] = ok ? T[2 * kq + half][r] * e : 0.f; } }
            union { unsigned u[4]; bf16x8 x; } cv; cv.u[0] = pk2(v[0], v[1]); cv.u[1] = pk2(v[2], v[3]); cv.u[2] = pk2(v[4], v[5]); cv.u[3] = pk2(v[6], v[7]); mf[kq] = cv.x; } }
        const float el = __expf(csl); bf16x8 cfs[4];
#pragma unroll
        for (int kk = 0; kk < 4; ++kk) { union { bf16x8 x; unsigned u[4]; } ci_, co; ci_.x = cf[kk];
#pragma unroll
            for (int q = 0; q < 4; ++q) co.u[q] = pk2(__uint_as_float(ci_.u[q] << 16) * el, __uint_as_float(ci_.u[q] & 0xffff0000u) * el);
            cfs[kk] = co.x; }
        int xo = xoff0 + h * 64 * D3_PITCH, ho = hoff0 + h * 64 * D3_PITCH; asm volatile("" : "+v"(xo), "+v"(ho));
#pragma unroll
        for (int pt = 0; pt < 4; ++pt) {
            f32x4 a4 = acc[h][pt];
#pragma unroll
            for (int kq = 0; kq < 4; ++kq) { if (d ? (kq >= kqm) : (kq <= kqm)) { union { unsigned long long q[2]; bf16x8 x; } cv; const LAS unsigned char* xp = lds + D3_XS + xo + 16 * pt * D3_PITCH + 64 * kq;
                cv.q[0] = *(const LAS unsigned long long*)xp; cv.q[1] = *(const LAS unsigned long long*)(xp + 32);
                a4 = __builtin_amdgcn_mfma_f32_16x16x32_bf16(cv.x, mf[kq], a4, 0, 0, 0); } }
#pragma unroll
            for (int kk = 0; kk < 4; ++kk) { const bf16x8 hf = *(const LAS bf16x8*)(lds + D3_HS + ho + 16 * pt * D3_PITCH + 64 * kk);
                a4 = __builtin_amdgcn_mfma_f32_16x16x32_bf16(hf, cfs[kk], a4, 0, 0, 0); }
            acc[h][pt] = a4; asm volatile("" ::: "memory"); }
      }
    }
    const size_t row = (size_t)(rowbase + lrow);
    const bf16* xs = XBC + row * 1024 + grp * 256; const bf16* zp = (const bf16*)(A.ws + WS_P) + row * N_INP + OFF_SSM + grp * 256;
    const float* dsk = A.in[27] + layer * 8 + grp * 4; const float* nw = A.in[28] + layer * 512 + grp * 256;
    float ss = 0.f;
#pragma unroll
    for (int h = 0; h < 4; ++h) { const float dh = dsk[h];
#pragma unroll
        for (int pt = 0; pt < 4; ++pt) { const int cb = h * 64 + 16 * pt + 4 * g;
            const unsigned long long xw = *(const unsigned long long*)(xs + cb), zw = *(const unsigned long long*)(zp + cb);
            const unsigned xl = (unsigned)xw, xh = (unsigned)(xw >> 32), zl = (unsigned)zw, zh = (unsigned)(zw >> 32);
            f32x4 v = acc[h][pt];
            v[0] = (v[0] + dh * __uint_as_float(xl << 16)) * silu_f(__uint_as_float(zl << 16)); v[1] = (v[1] + dh * __uint_as_float(xl & 0xffff0000u)) * silu_f(__uint_as_float(zl & 0xffff0000u));
            v[2] = (v[2] + dh * __uint_as_float(xh << 16)) * silu_f(__uint_as_float(zh << 16)); v[3] = (v[3] + dh * __uint_as_float(xh & 0xffff0000u)) * silu_f(__uint_as_float(zh & 0xffff0000u));
            acc[h][pt] = v; ss += (v[0] * v[0] + v[1] * v[1]) + (v[2] * v[2] + v[3] * v[3]); } }
    ss += __shfl_xor(ss, 16); ss += __shfl_xor(ss, 32);
    const float rstd = 1.0f / sqrtf(ss * (1.f / 256.f) + EPS);
    bf16* yo = (bf16*)(A.ws + WS_Y) + row * DM + 1536 + grp * 256;
#pragma unroll
    for (int h = 0; h < 4; ++h)
#pragma unroll
        for (int pt = 0; pt < 4; ++pt) { const int cb = h * 64 + 16 * pt + 4 * g; const f32x4 nv = *(const f32x4*)(nw + cb); const f32x4 v = acc[h][pt];
            *(unsigned long long*)(yo + cb) = (unsigned long long)pk2(v[0] * rstd * nv[0], v[1] * rstd * nv[1]) | ((unsigned long long)pk2(v[2] * rstd * nv[2], v[3] * rstd * nv[3]) << 32); }
}
__device__ __forceinline__ void ssm_prep_tile(const Ctx& C, KArgs& A, int layer, int tile) {
    const int lane = C.lane; LAS unsigned* T = (LAS unsigned*)(C.lds + C.wave * 8448);
    const int ct = tile % 12, tt = tile / 12, cb = ct * 64, row0 = tt * 64;
    int t0, L; if (row0 < M_LAT) { t0 = row0 & 4095; L = SEQ; } else { t0 = (row0 - M_LAT) & 255; L = LC; }
    const float* cw = A.in[23] + layer * 3 * 1024; const float* cbias = A.in[24] + layer * 1024; const int ch = cb + lane;
    const float w0 = cw[ch], w1 = cw[1024 + ch], w2 = cw[2048 + ch], bias = cbias[ch];
    const bf16* p = (const bf16*)(A.ws + WS_P) + (size_t)row0 * N_INP + OFF_SSM + 512 + ch;
    float pm = (t0 > 0) ? bf2f(p[-(ptrdiff_t)N_INP]) : 0.f, pc = bf2f(p[0]), ae = 0.f;
#pragma unroll 8
    for (int i = 0; i < 64; ++i) { const float pn = (t0 + i + 1 < L) ? bf2f(p[(size_t)(i + 1) * N_INP]) : 0.f; const float a = silu_f(bias + w0 * pm + w1 * pc + w2 * pn); pm = pc; pc = pn;
        if (i & 1) T[lane * 33 + (i >> 1)] = pk2(ae, a); else ae = a; }
    LDS_WAIT(); asm volatile("" ::: "memory");
    unsigned* dst = (unsigned*)((bf16*)(A.ws + WS_XBCT) + (size_t)cb * M_ALL + row0);
#pragma unroll 8
    for (int ii = 0; ii < 32; ++ii) { const int rr = 2 * ii + (lane >> 5), j = lane & 31; dst[(size_t)rr * (M_ALL / 2) + j] = T[rr * 33 + j]; }
    LDS_WAIT(); asm volatile("" ::: "memory");
}

__device__ __forceinline__ void filter_unit(const Ctx& C, KArgs& A, int layer, int u) {
    if (u < SEQ / 16) hy_filter_unit16<SEQ>(C, A, layer, 16 * u, A.ws + WS_GT); else hy_filter_unit16<LC>(C, A, layer, 16 * (u - SEQ / 16), A.ws + ((layer & 1) ? WS_GCTX1 : WS_GCTX));
}
constexpr int CW_TAILQ = 8192;
__device__ __forceinline__ void tail_work(const Ctx& C, KArgs& A, int next_layer, volatile LAS unsigned* MISC) {
    const bool ctxf = next_layer < DEPTH - 1; const int nF = SEQ / 16 + (ctxf ? LC / 16 : 0);
    unsigned* head = (unsigned*)(A.ws + WS_CTL) + CW_TAILQ + 64 * next_layer;
    for (;;) {
        __syncthreads();
        if (C.tid == 0) MISC[16] = __hip_atomic_fetch_add(head, 1u, __ATOMIC_RELAXED, __HIP_MEMORY_SCOPE_AGENT);
        __syncthreads();
        const int q = (int)MISC[16];
        if (q >= nF) break;
        filter_unit(C, A, next_layer, q);
    }
    __syncthreads();
}

namespace pg8 {
struct CtxOrder {
    int c;
    __device__ bool next(int i, Unit& u) const { if (i > 0 || c >= 32) return false; u.pm = c >> 3; u.pn = c & 7; return true; }
    __device__ __forceinline__ void a_ready(const Unit&) const {}
    __device__ __forceinline__ void done(const Unit&) const {}
};
}
__global__ void __launch_bounds__(NTHR, 2) mk_fwd(const Args A_unused) {
    KArgs* Ap = (KArgs*)__builtin_amdgcn_kernarg_segment_ptr();
#define A (*Ap)
    extern __shared__ __attribute__((aligned(16))) unsigned char lds_raw[];
    Ctx C;
    C.lds = (LAS unsigned char*)lds_raw;
    C.tid = threadIdx.x; C.lane = C.tid & 63; C.wave = __builtin_amdgcn_readfirstlane(C.tid >> 6);
    C.bid = blockIdx.x; C.G = gridDim.x; C.gw = C.bid * NWAVES + C.wave; C.NGW = C.G * NWAVES;
    volatile LAS unsigned* MISC = (volatile LAS unsigned*)(C.lds + MISC_OFF);
    for (int u = C.tid; u < (LDS_BYTES - MISC_OFF) / 4; u += NTHR) MISC[u] = 0u;
    __syncthreads();
    XcdBarrier bar; bar.bar = (unsigned*)(A.ws + WS_CTL) + CW_BAR; bar.x = 0; bar.st = nullptr;
    if (!MK_SPLIT) bar = xcd_barrier_post((unsigned*)(A.ws + WS_CTL) + CW_BAR, MISC + 8);
    const int lo = A.ph_lo, hi = A.ph_hi;
#define IN(k) (lo <= (k) && (k) < hi && (launder(C), ({ asm volatile("" : "+s"(Ap)); true; })))
#define RELOAD_A_UNUSED() asm volatile("" : "+s"(Ap))
#define REPS(k) ((PROBE_REP == (k)) ? 2 : 1)
#define SEAM(k) do { if (!MK_SPLIT && IN(k) && IN((k) + 1)) xcd_barrier(bar); } while (0)

    if (IN(PH_PRO1)) { phase_pro1(C, A); if (PROBE_REP == 40) { if (!MK_SPLIT) xcd_barrier(bar); launder(C); phase_pro1(C, A); } } SEAM(PH_PRO1);
    if (IN(PH_PRO2)) { phase_pro2(C, A); for (int u = C.bid; u < SEQ / 16 + LC / 16; u += C.G) filter_unit(C, A, 0, u); __syncthreads(); } SEAM(PH_PRO2);

    for (int layer = 0; layer < DEPTH; ++layer) {
        const int pb = PH_L0 + layer * PH_PER_LAYER; const bool last = (layer == DEPTH - 1), need_ctx = !last;
        const unsigned char* wl = A.ws + WS_W + (size_t)layer * W_LAYER;
        const float* mod = (const float*)(A.ws + WS_MOD) + (size_t)layer * 5 * 12288;
        if (IN(pb + 0)) for (int rep_ = 0; rep_ < REPS(0); ++rep_) { if (rep_) { if (!MK_SPLIT) xcd_barrier(bar); launder(C); }
            phase_norm(C, A, layer, 0, layer == 0 ? 0 : M_LAT, M_ALL, C.gw, C.NGW);
            const int nf = SEQ + (need_ctx ? LC : 0);
            (void)nf;
        } SEAM(pb + 0);
        if (IN(pb + 1)) for (int rep_ = 0; rep_ < REPS(1); ++rep_) { if (rep_) { if (!MK_SPLIT) xcd_barrier(bar); launder(C); }
            pg8::Gemm g{(const bf16*)(A.ws + WS_XN), (const bf16*)wl, M_ALL, N_INP, DM}; pg8::StaticOrder S; S.init(M_ALL, N_INP, C.G, C.bid);
            pg8::EpiStoreBf16<0> E{(bf16*)(A.ws + WS_P), N_INP, (const float*)(A.ws + WS_ROPE)};
            pg8::gemm_phase<pg8::EpiStoreBf16<0>, pg8::StaticOrder, true, true>(C.lds, g, S, E);
        } SEAM(pb + 1);
        if (IN(pb + 2)) for (int rep_ = 0; rep_ < REPS(2); ++rep_) { if (rep_) { if (!MK_SPLIT) xcd_barrier(bar); launder(C); } prep_dt(C, A, layer); if (need_ctx) for (int row = M_LAT + C.gw; row < M_ALL; row += C.NGW) prep_row(C, A, layer, row);
            phase_prep_units(C, A, layer); } SEAM(pb + 2);
        if (IN(pb + 3)) for (int rep_ = 0; rep_ < REPS(3); ++rep_) { if (rep_) { if (!MK_SPLIT) xcd_barrier(bar); launder(C); }
            for (int sr = 0; sr < ((PROBE_REP == 32) ? 2 : 1); ++sr) { launder(C); for (int u = C.bid; u < NB * 34 * 2; u += C.G) ssd_d1_unit(C, A, u / 68, (u % 68) >> 1, u & 1); }
            __syncthreads();
            for (int sr = 0; sr < ((PROBE_REP == 30) ? 2 : 1); ++sr) { launder(C); hy_fast_units(C, A); }
            __syncthreads();
            phase_hyconv(C, A, layer, 0, need_ctx, 16);
            for (int sr = 0; sr < ((PROBE_REP == 31) ? 2 : 1); ++sr) { launder(C); phase_attn<0>(C, A, layer, need_ctx); }
        } SEAM(pb + 3);
        if (IN(pb + 4)) for (int rep_ = 0; rep_ < REPS(4); ++rep_) { if (rep_) { if (!MK_SPLIT) xcd_barrier(bar); launder(C); }
            const int nHP = 8 * (M_LAT / 64), nHPx = need_ctx ? 16 * NWAVES : 0;
            if (need_ctx && C.bid >= C.G - 16) { const int u = C.bid - (C.G - 16); ssd_d3_unit<true>(C, A, layer, u >> 2, (u >> 1) & 1, u & 1); __syncthreads();
                launder(C); hy_post_tile(C, A, nHP - nHPx + u * NWAVES + C.wave); }
            else { Ctx C2 = C; if (need_ctx) { C2.G = C.G - 16; C2.NGW = C2.G * NWAVES; }
                ssd_d2(C2, A);
                for (int tile = C2.gw; tile < nHP - nHPx; tile += C2.NGW) hy_post_tile(C2, A, tile);
                phase_hyconv(C2, A, layer, 1, need_ctx, 16); }
        } SEAM(pb + 4);
        if (IN(pb + 5)) for (int rep_ = 0; rep_ < REPS(5); ++rep_) { if (rep_) { if (!MK_SPLIT) xcd_barrier(bar); launder(C); }
            for (int u = C.bid; u < NB * 32 * 2; u += C.G) ssd_d3_unit<false>(C, A, layer, u >> 6, 2 + ((u & 63) >> 1), u & 1);
        } SEAM(pb + 5);
        if (IN(pb + 6)) for (int rep_ = 0; rep_ < REPS(6); ++rep_) { if (rep_) { if (!MK_SPLIT) xcd_barrier(bar); launder(C); }
            float* Xp = (float*)(A.ws + WS_X); const bool first = (layer == 0 && rep_ == 0); const float* bl = first ? A.in[0] : Xp; const float* bc = first ? A.in[2] : Xp + (size_t)M_LAT * DM;
            { pg8::Gemm g{(const bf16*)(A.ws + WS_Y), (const bf16*)(wl + W_OUT_OFF), M_LAT, DM, DM}; pg8::StaticOrder S; S.init(M_LAT, DM, C.G, C.bid);
              pg8::EpiResid E; E.X = Xp; E.gate = mod + 2 * DM; E.gs = rep_ ? 0.f : 1.f; E.base_lat = bl; E.base_ctx = bl;
              pg8::gemm_phase<pg8::EpiResid, pg8::StaticOrder, true, true>(C.lds, g, S, E); }
            if (need_ctx) { if (!MK_SPLIT) xcd_barrier(bar); launder(C);
                if (C.bid < 32) { pg8::Gemm g{(const bf16*)(A.ws + WS_Y) + (size_t)M_LAT * DM, (const bf16*)(wl + W_OUT_OFF), M_CTX, DM, DM}; pg8::CtxOrder S; S.c = C.bid;
                    pg8::EpiResid E; E.X = Xp + (size_t)M_LAT * DM; E.gate = mod + 4 * 12288 + 2 * DM; E.gs = rep_ ? 0.f : 1.f; E.base_lat = bc; E.base_ctx = bc;
                    pg8::gemm_phase<pg8::EpiResid, pg8::CtxOrder, true, true>(C.lds, g, S, E); }
                else phase_norm(C, A, layer, 1, 0, M_LAT, (C.bid - 32) * NWAVES + C.wave, (C.G - 32) * NWAVES); }
        } SEAM(pb + 6);
        if (IN(pb + 7)) for (int rep_ = 0; rep_ < REPS(7); ++rep_) { if (rep_) { if (!MK_SPLIT) xcd_barrier(bar); launder(C); } phase_norm(C, A, layer, 1, need_ctx ? M_LAT : 0, need_ctx ? M_ALL : M_LAT, C.gw, C.NGW); } SEAM(pb + 7);
        if (IN(pb + 8)) for (int rep_ = 0; rep_ < REPS(8); ++rep_) { if (rep_) { if (!MK_SPLIT) xcd_barrier(bar); launder(C); }
            const int Mo = need_ctx ? M_ALL : M_LAT;
            pg8::Gemm g{(const bf16*)(A.ws + WS_XN), (const bf16*)(wl + W_1_OFF), Mo, DFF, DM}; pg8::StaticOrder S; S.init(Mo, DFF, C.G, C.bid);
            pg8::EpiStoreBf16<1> E{(bf16*)(A.ws + WS_H), DFF, nullptr};
            pg8::gemm_phase<pg8::EpiStoreBf16<1>, pg8::StaticOrder, true, true>(C.lds, g, S, E);
        } SEAM(pb + 8);
        if (IN(pb + 9)) for (int rep_ = 0; rep_ < REPS(9); ++rep_) { if (rep_) { if (!MK_SPLIT) xcd_barrier(bar); launder(C); }
            float* Xp = (float*)(A.ws + WS_X);
            { pg8::Gemm g{(const bf16*)(A.ws + WS_H), (const bf16*)(wl + W_2_OFF), M_LAT, DM, DFF}; pg8::StaticOrder S; S.init(M_LAT, DM, C.G, C.bid);
              pg8::EpiResid E; E.X = Xp; E.gate = mod + 5 * DM; E.gs = rep_ ? 0.f : 1.f; E.base_lat = Xp; E.base_ctx = Xp;
              pg8::gemm_phase<pg8::EpiResid, pg8::StaticOrder, true, true>(C.lds, g, S, E); }
            if (need_ctx) { if (!MK_SPLIT) xcd_barrier(bar); launder(C);
                if (C.bid < 32) { pg8::Gemm g{(const bf16*)(A.ws + WS_H) + (size_t)M_LAT * DFF, (const bf16*)(wl + W_2_OFF), M_CTX, DM, DFF}; pg8::CtxOrder S; S.c = C.bid;
                    pg8::EpiResid E; E.X = Xp + (size_t)M_LAT * DM; E.gate = mod + 4 * 12288 + 5 * DM; E.gs = rep_ ? 0.f : 1.f; E.base_lat = Xp + (size_t)M_LAT * DM; E.base_ctx = E.base_lat;
                    pg8::gemm_phase<pg8::EpiResid, pg8::CtxOrder, true, true>(C.lds, g, S, E); }
                else { if (rep_ == 0) tail_work(C, A, layer + 1, MISC); launder(C); phase_norm(C, A, layer + 1, 0, 0, M_LAT, (C.bid - 32) * NWAVES + C.wave, (C.G - 32) * NWAVES); } }
            else if (layer + 1 < DEPTH && rep_ == 0) tail_work(C, A, layer + 1, MISC);
        } SEAM(pb + 9);
    }
    if (IN(PH_FINAL)) phase_final(C, A);
#undef IN
#undef SEAM
#undef A
}

extern "C" void kernel_launch(void* const* d_in, const int* in_sizes, int n_in, void* d_out, int out_size, void* d_ws, size_t ws_size, hipStream_t stream) {
    static int grid = 0;
    if (grid == 0) {
        if (n_in != 32 || out_size != M_LAT * DM || ws_size < WS_END) { fprintf(stderr, "kernel_launch: unexpected shapes (n_in %d, out %d, ws %zu); nothing launched\n", n_in, out_size, ws_size); grid = -1; return; }
        int dev = 0, cus = 0, per_cu = 0;
        if (hipGetDevice(&dev) != hipSuccess || hipDeviceGetAttribute(&cus, hipDeviceAttributeMultiprocessorCount, dev) != hipSuccess) { grid = -1; return; }
        if (hipFuncSetAttribute((const void*)mk_fwd, hipFuncAttributeMaxDynamicSharedMemorySize, LDS_BYTES) != hipSuccess) { fprintf(stderr, "kernel_launch: hipFuncSetAttribute failed\n"); grid = -1; return; }
        if (hipOccupancyMaxActiveBlocksPerMultiprocessor(&per_cu, (const void*)mk_fwd, NTHR, LDS_BYTES) != hipSuccess || per_cu < 1) { fprintf(stderr, "kernel_launch: occupancy query says %d blocks per CU\n", per_cu); }
        (void)hipGetLastError();
        grid = cus;
    }
    if (grid < 0) return;
    if (hipMemsetAsync((char*)d_ws + WS_CTL, 0, CTL_ZERO_BYTES, stream) != hipSuccess) { fprintf(stderr, "kernel_launch: memset failed\n"); return; }
    Args a{};
    for (int i = 0; i < 32; ++i) a.in[i] = (const float*)d_in[i];
    a.out = (float*)d_out; a.ws = (unsigned char*)d_ws;
#if MK_SPLIT
    for (int ph = 0; ph < N_PHASES; ++ph) { a.ph_lo = ph; a.ph_hi = ph + 1; hipLaunchKernelGGL(mk_fwd, dim3(grid), dim3(NTHR), LDS_BYTES, stream, a); }
#else
    a.ph_lo = 0; a.ph_hi = N_PHASES; hipLaunchKernelGGL(mk_fwd, dim3(grid), dim3(NTHR), LDS_BYTES, stream, a);
#endif
    const hipError_t le = hipPeekAtLastError();
    if (le != hipSuccess) fprintf(stderr, "kernel_launch: launch failed: %s\n", hipGetErrorName(le));
}
```

```cpp
#include <hip/hip_runtime.h>
#include <cstdio>
#include <cstdint>
namespace pg8 {
#define PG8_LAS __attribute__((address_space(3)))
typedef unsigned short bf16_t;
typedef short bf16x8 __attribute__((ext_vector_type(8)));
typedef float f32x4 __attribute__((ext_vector_type(4)));
typedef unsigned u32x4 __attribute__((ext_vector_type(4)));
constexpr int BM = 256, BK = 64, HALF = 128, HTB = HALF * BK * 2  , STAGE_BYTES = 8 * HTB, NXCD = 8, WGM = 8;

__host__ __device__ __forceinline__ int lds_byte(int r, int c) { const int st = (r >> 4) * 2 + (c >> 5), rr = r & 15, cc = c & 31, ob = rr * 64 + cc * 2; return st * 1024 + (ob ^ (((ob >> 9) & 1) << 5)); }
__host__ __device__ __forceinline__ void stage_rc(int b, int& R, int& C) { const int st = b / 1024, sb = b % 1024, swz = sb ^ (((sb >> 9) & 1) << 5); R = (st >> 1) * 16 + swz / 64; C = (st & 1) * 32 + (swz % 64) / 2; }
__host__ __device__ __forceinline__ int perm32(int rho) { const int n = rho >> 4, i = rho & 15; return 8 * (i >> 2) + 4 * n + (i & 3); }

struct Unit { int pm, pn; };
struct Gemm { const bf16_t* A; const bf16_t* Bt; int M, N, K; };

struct StaticOrder {
    int nM, nN, nwg, G, c;
    __host__ __device__ void init(int M, int N, int G_, int c_) { nM = M / BM; nN = N / BM; nwg = nM * nN; G = G_; c = c_; }
    __host__ __device__ bool next(int i, Unit& u) const {
        const long L = (long)i * G + c; if (L >= nwg) return false;
        int wgid = (int)L; { const int q = nwg / NXCD, r = nwg % NXCD, xcd = wgid % NXCD, off = wgid / NXCD; wgid = (xcd < r ? xcd * (q + 1) : r * (q + 1) + (xcd - r) * q) + off; }
        const int nig = WGM * nN, gid = wgid / nig, fm = gid * WGM, gsz = (nM - fm) < WGM ? (nM - fm) : WGM;
        u.pm = fm + ((wgid % nig) % gsz); u.pn = (wgid % nig) / gsz; return true;
    }
    __device__ __forceinline__ void a_ready(const Unit&) const {}
    __device__ __forceinline__ void done(const Unit&) const {}
};

__device__ __forceinline__ unsigned cvt_pk_bf16(float lo, float hi) { unsigned r; asm volatile("v_cvt_pk_bf16_f32 %0, %1, %2" : "=v"(r) : "v"(lo), "v"(hi)); return r; }
typedef float f32x2 __attribute__((ext_vector_type(2)));
template <int ACT  > struct EpiStoreBf16 {
    static constexpr bool PERM = true, AFTER_DRAIN = false;
    bf16_t* O; int ldc; const float* rope;
    __device__ __forceinline__ void operator()(const f32x4 (&acc)[2][2][4][2], const Unit& u, int wr, int wc, int fr, int fq) const {
        const int row0 = u.pm * BM + wr * 64 + fr; const int col0 = u.pn * BM + wc * 32 + 8 * fq;
        const bool roped = (ACT == 0) && rope != nullptr && u.pm < 64 && u.pn < 3;
#pragma unroll
        for (int ai = 0; ai < 2; ++ai)
#pragma unroll
            for (int m = 0; m < 4; ++m) { const int row = row0 + ai * HALF + m * 16; bf16_t* rowp = O + (size_t)row * ldc + col0;
                f32x4 c0 = {1.f, 1.f, 1.f, 1.f}, c1 = c0, s0 = {0.f, 0.f, 0.f, 0.f}, s1 = s0;
                if (roped) { const int t = row & 4095, pos = (wc & 1) ? (t & 63) : (t >> 6); const float* tp = rope + pos * 16 + 8 * (fq & 1);
                    c0 = *(const f32x4*)tp; c1 = *(const f32x4*)(tp + 4); s0 = *(const f32x4*)(tp + 1024); s1 = *(const f32x4*)(tp + 1028); if (fq < 2) { s0 = -s0; s1 = -s1; } }
#pragma unroll
                for (int bj = 0; bj < 2; ++bj) { f32x4 v0 = acc[ai][bj][m][0], v1 = acc[ai][bj][m][1];
                    if (ACT == 1) {
#pragma unroll
                        for (int j = 0; j < 4; ++j) { const float a = fmaxf(v0[j], 0.f), b = fmaxf(v1[j], 0.f); v0[j] = a * a; v1[j] = b * b; } }
                    if (roped && (u.pn < 2 || bj == 0)) { f32x4 p0, p1;
#pragma unroll
                        for (int j = 0; j < 4; ++j) { p0[j] = __shfl_xor(v0[j], 32); p1[j] = __shfl_xor(v1[j], 32); }
                        v0 = v0 * c0 + p0 * s0; v1 = v1 * c1 + p1 * s1; }
                    u32x4 w; w.x = cvt_pk_bf16(v0[0], v0[1]); w.y = cvt_pk_bf16(v0[2], v0[3]); w.z = cvt_pk_bf16(v1[0], v1[1]); w.w = cvt_pk_bf16(v1[2], v1[3]);
                    *(u32x4*)(rowp + bj * HALF) = w; } }
    }
};
struct EpiResid {
    static constexpr bool PERM = false, AFTER_DRAIN = false;
    float* X; const float* gate; float gs; const float* base_lat; const float* base_ctx;
    __device__ __forceinline__ void operator()(const f32x4 (&acc)[2][2][4][2], const Unit& u, int wr, int wc, int fr, int fq) const {
        const int row0 = u.pm * BM + wr * 64 + fr, col0 = u.pn * BM + wc * 32 + 4 * fq;
        const int b = (u.pm < 64) ? (u.pm >> 4) : 4;
        const float* bl_ = base_lat; const float* bc_ = base_ctx; const float* sbase = (u.pm < 64) ? bl_ : bc_;
        const float* gp = gate + (size_t)b * 12288 + col0;
        f32x4 gv[2][2];
#pragma unroll
        for (int bj = 0; bj < 2; ++bj)
#pragma unroll
            for (int n = 0; n < 2; ++n) gv[bj][n] = *(const f32x4*)(gp + bj * HALF + n * 16) * gs;
#pragma unroll
        for (int ai = 0; ai < 2; ++ai)
#pragma unroll
            for (int m = 0; m < 4; ++m) { const int rr = row0 + ai * HALF + m * 16; float* rowp = X + (size_t)rr * 2048 + col0; const float* srcp = sbase + (size_t)rr * 2048 + col0;
#pragma unroll
                for (int bj = 0; bj < 2; ++bj)
#pragma unroll
                    for (int n = 0; n < 2; ++n) { f32x4 x = *(const f32x4*)(srcp + bj * HALF + n * 16); x = x + gv[bj][n] * acc[ai][bj][m][n]; *(f32x4*)(rowp + bj * HALF + n * 16) = x; }
                if (m & 1) asm volatile("" ::: "memory"); }
    }
};

template <class Epi, class Sched, bool ALIGN_EPI = false, bool SP2 = false>
__device__ __forceinline__ void gemm_phase(PG8_LAS unsigned char* lds, const Gemm g, const Sched& S, const Epi& E) {
    int tid_ = threadIdx.x; asm volatile("" : "+v"(tid_));
    const int tid = tid_, wid = __builtin_amdgcn_readfirstlane(tid >> 6), lane = tid & 63, wr = wid >> 2, wc = wid & 3, fr = lane & 15, fq = lane >> 4;
    const int K = g.K, nt = K / BK;
    unsigned voffA[2], voffB[2];
#pragma unroll
    for (int i = 0; i < 2; ++i) { int R, C; stage_rc(tid * 16 + i * 8192, R, C); const int Rb = Epi::PERM ? ((R & ~31) + perm32(R & 31)) : R;
        voffA[i] = (unsigned)(R * K + C) * 2u; voffB[i] = (unsigned)(Rb * K + C) * 2u; }
    const size_t kstep = (size_t)(BK * 2);
    const size_t hstep = (size_t)HALF * K * 2;
    const size_t tstep = 2 * hstep;
    const unsigned ldsw = (unsigned)wid * 1024u;
    const int aoff = lds_byte(wr * 64 + fr, fq * 8), boff = lds_byte(wc * 32 + fr, fq * 8);
#define PG8_SA(b, h) (((b) * 2 + (h)) * HTB)
#define PG8_SB(b, h) ((4 + (b) * 2 + (h)) * HTB)
#define PG8_STAGE(bufoff, gbase, voff) do { _Pragma("unroll") for (int _i = 0; _i < 2; ++_i) \
        __builtin_amdgcn_global_load_lds((const unsigned*)((const char*)(gbase) + (voff)[_i]), (PG8_LAS unsigned*)(lds + (bufoff) + ldsw + _i * 8192), 16, 0, 0); } while (0)
#define PG8_LDA(dst, b, h) do { _Pragma("unroll") for (int m = 0; m < 4; ++m) _Pragma("unroll") for (int k = 0; k < 2; ++k) dst[m][k] = *(const PG8_LAS bf16x8*)(lds + PG8_SA(b, h) + aoff + m * 2048 + k * 1024); } while (0)
#define PG8_LDB(dst, b, h) do { _Pragma("unroll") for (int n = 0; n < 2; ++n) _Pragma("unroll") for (int k = 0; k < 2; ++k) dst[n][k] = *(const PG8_LAS bf16x8*)(lds + PG8_SB(b, h) + boff + n * 2048 + k * 1024); } while (0)
#define PG8_MMA(ai, bj, At, Bt) do { __builtin_amdgcn_s_setprio(1); _Pragma("unroll") for (int m = 0; m < 4; ++m) _Pragma("unroll") for (int n = 0; n < 2; ++n) _Pragma("unroll") for (int k = 0; k < 2; ++k) \
        acc[ai][bj][m][n] = __builtin_amdgcn_mfma_f32_16x16x32_bf16(Bt[n][k], At[m][k], acc[ai][bj][m][n], 0, 0, 0); __builtin_amdgcn_s_setprio(0); } while (0)
#define PG8_WAIT_V(n) asm volatile("s_waitcnt vmcnt(" #n ")" ::: "memory")
#define PG8_WAIT_L(n) asm volatile("s_waitcnt lgkmcnt(" #n ")" ::: "memory")
#define PG8_BAR __builtin_amdgcn_s_barrier()
#define PG8_SCHED __builtin_amdgcn_sched_barrier(0)
    Unit cur, nxt; int ui = 0;
    if (!S.next(0, cur)) return;
    f32x4 acc[2][2][4][2];
#pragma unroll
    for (int a = 0; a < 2; ++a)
#pragma unroll
        for (int b = 0; b < 2; ++b)
#pragma unroll
            for (int m = 0; m < 4; ++m)
#pragma unroll
                for (int n = 0; n < 2; ++n) acc[a][b][m][n] = (f32x4){0.f, 0.f, 0.f, 0.f};
    bf16x8 At[4][2], B0[2][2], B1[2][2];
    const char* cA = (const char*)g.A + (size_t)cur.pm * tstep; const char* cB = (const char*)g.Bt + (size_t)cur.pn * tstep;
    S.a_ready(cur);
    if constexpr (SP2) {
        PG8_STAGE(PG8_SB(0, 0), cB, voffB); PG8_STAGE(PG8_SB(0, 1), cB + hstep, voffB); PG8_STAGE(PG8_SA(0, 0), cA, voffA); PG8_STAGE(PG8_SA(0, 1), cA + hstep, voffA);
        if (wr == 1) PG8_BAR;
        PG8_WAIT_V(2); PG8_BAR;
        PG8_STAGE(PG8_SB(1, 0), cB + kstep, voffB); PG8_STAGE(PG8_SA(1, 0), cA + kstep, voffA); PG8_STAGE(PG8_SB(1, 1), cB + hstep + kstep, voffB);
        PG8_WAIT_V(6); PG8_BAR;
    } else {
        PG8_STAGE(PG8_SB(0, 0), cB, voffB); PG8_STAGE(PG8_SA(0, 0), cA, voffA); PG8_STAGE(PG8_SB(0, 1), cB + hstep, voffB); PG8_STAGE(PG8_SA(0, 1), cA + hstep, voffA);
        if (wr == 1) PG8_BAR;
        PG8_WAIT_V(4); PG8_BAR;
        PG8_STAGE(PG8_SB(1, 0), cB + kstep, voffB); PG8_STAGE(PG8_SA(1, 0), cA + kstep, voffA); PG8_STAGE(PG8_SB(1, 1), cB + hstep + kstep, voffB);
        PG8_WAIT_V(6); PG8_BAR;
    }
    for (;;) {
        const bool has_next = S.next(ui + 1, nxt);
        const char* nA = has_next ? (const char*)g.A + (size_t)nxt.pm * tstep : cA; const char* nB = has_next ? (const char*)g.Bt + (size_t)nxt.pn * tstep : cB;
        for (int t = 0; t < nt; t += 2) {
            const bool last = (t == nt - 2);
            const char* a1 = cA + (size_t)(t + 1) * kstep;
            const char* a2 = last ? nA : cA + (size_t)(t + 2) * kstep; const char* b2 = last ? nB : cB + (size_t)(t + 2) * kstep;
            const char* a3 = a2 + kstep; const char* b3 = b2 + kstep;
            if (last && has_next) S.a_ready(nxt);
            if constexpr (SP2) {
            PG8_LDB(B0, 0, 0); PG8_LDB(B1, 0, 1); PG8_SCHED; PG8_LDA(At, 0, 0); PG8_STAGE(PG8_SA(1, 1), a1 + hstep, voffA);
            PG8_WAIT_V(8); PG8_WAIT_L(0); PG8_BAR; PG8_MMA(0, 0, At, B0); PG8_MMA(0, 1, At, B1); PG8_BAR; PG8_SCHED;
            PG8_LDA(At, 0, 1); PG8_STAGE(PG8_SB(0, 0), b2, voffB); PG8_STAGE(PG8_SB(0, 1), b2 + hstep, voffB); PG8_STAGE(PG8_SA(0, 0), a2, voffA);
            PG8_WAIT_V(8); PG8_WAIT_L(0); PG8_BAR; PG8_MMA(1, 0, At, B0); PG8_MMA(1, 1, At, B1); PG8_BAR; PG8_SCHED;
            PG8_LDB(B0, 1, 0); PG8_LDB(B1, 1, 1); PG8_SCHED; PG8_LDA(At, 1, 0); PG8_STAGE(PG8_SA(0, 1), a2 + hstep, voffA);
            PG8_WAIT_V(8); PG8_WAIT_L(0); PG8_BAR; PG8_MMA(0, 0, At, B0); PG8_MMA(0, 1, At, B1); PG8_BAR; PG8_SCHED;
            PG8_LDA(At, 1, 1); PG8_STAGE(PG8_SB(1, 0), b3, voffB); PG8_STAGE(PG8_SB(1, 1), b3 + hstep, voffB); PG8_STAGE(PG8_SA(1, 0), a3, voffA);
            PG8_WAIT_V(8); PG8_WAIT_L(0); PG8_BAR; PG8_MMA(1, 0, At, B0); PG8_MMA(1, 1, At, B1); PG8_BAR; PG8_SCHED;
            } else {
            PG8_LDB(B0, 0, 0); PG8_SCHED; PG8_LDA(At, 0, 0); PG8_STAGE(PG8_SA(1, 1), a1 + hstep, voffA);
            PG8_WAIT_L(8); PG8_BAR; PG8_WAIT_L(0); PG8_MMA(0, 0, At, B0); PG8_BAR; PG8_SCHED;
            PG8_LDB(B1, 0, 1); PG8_STAGE(PG8_SB(0, 0), b2, voffB);
            PG8_BAR; PG8_WAIT_L(0); PG8_MMA(0, 1, At, B1); PG8_BAR;
            PG8_LDA(At, 0, 1); PG8_STAGE(PG8_SA(0, 0), a2, voffA);
            PG8_BAR; PG8_WAIT_L(0); PG8_MMA(1, 0, At, B0); PG8_BAR; PG8_SCHED;
            PG8_STAGE(PG8_SB(0, 1), b2 + hstep, voffB);
            PG8_WAIT_V(6); PG8_BAR; PG8_MMA(1, 1, At, B1); PG8_BAR;
            PG8_LDB(B0, 1, 0); PG8_SCHED; PG8_LDA(At, 1, 0); PG8_STAGE(PG8_SA(0, 1), a2 + hstep, voffA);
            PG8_WAIT_L(8); PG8_BAR; PG8_WAIT_L(0); PG8_MMA(0, 0, At, B0); PG8_BAR; PG8_SCHED;
            PG8_LDB(B1, 1, 1); PG8_STAGE(PG8_SB(1, 0), b3, voffB);
            PG8_BAR; PG8_WAIT_L(0); PG8_MMA(0, 1, At, B1); PG8_BAR;
            PG8_LDA(At, 1, 1); PG8_STAGE(PG8_SA(1, 0), a3, voffA);
            PG8_BAR; PG8_WAIT_L(0); PG8_MMA(1, 0, At, B0); PG8_BAR; PG8_SCHED;
            PG8_STAGE(PG8_SB(1, 1), b3 + hstep, voffB);
            PG8_WAIT_V(6); PG8_BAR; PG8_MMA(1, 1, At, B1); PG8_BAR;
            }
        }
        if constexpr (ALIGN_EPI) { if (wr == 0) PG8_BAR; }
        if constexpr (!Epi::AFTER_DRAIN) { E(acc, cur, wr, wc, fr, fq); S.done(cur); }
        if (!has_next) break;
#pragma unroll
        for (int a = 0; a < 2; ++a)
#pragma unroll
            for (int b = 0; b < 2; ++b)
#pragma unroll
                for (int m = 0; m < 4; ++m)
#pragma unroll
                    for (int n = 0; n < 2; ++n) acc[a][b][m][n] = (f32x4){0.f, 0.f, 0.f, 0.f};
        cur = nxt; cA = nA; cB = nB; ++ui;
        if constexpr (ALIGN_EPI) { if (wr == 1) PG8_BAR; }
    }
    PG8_WAIT_V(0);
    if constexpr (!ALIGN_EPI) { if (wr == 0) PG8_BAR; }
    PG8_BAR;
    if constexpr (Epi::AFTER_DRAIN) { E.fused(acc, cur, wr, wc, fr, fq, lds, wid, lane); S.done(cur); }
#undef PG8_SA
#undef PG8_SB
#undef PG8_STAGE
#undef PG8_LDA
#undef PG8_LDB
#undef PG8_MMA
#undef PG8_WAIT_V
#undef PG8_WAIT_L
#undef PG8_BAR
#undef PG8_SCHED
}
}
#define GAS __attribute__((address_space(1)))
#define LAS __attribute__((address_space(3)))
typedef unsigned short bf16;
typedef unsigned v4u __attribute__((ext_vector_type(4)));
typedef float f32x4 __attribute__((ext_vector_type(4)));
typedef short bf16x8 __attribute__((ext_vector_type(8)));
typedef GAS unsigned gu32;
typedef GAS unsigned long long gu64;
#define RLX_AGENT __ATOMIC_RELAXED, __HIP_MEMORY_SCOPE_AGENT
#define LDS_WAIT() asm volatile("s_waitcnt lgkmcnt(0)" ::: "memory")
#define VM_WAIT() asm volatile("s_waitcnt vmcnt(0)" ::: "memory")
__device__ __forceinline__ unsigned long long rt() { return __builtin_amdgcn_s_memrealtime(); }
__device__ __forceinline__ unsigned f2bf(float f) { unsigned u = __builtin_bit_cast(unsigned, f); return (u + 0x7fffu + ((u >> 16) & 1u)) >> 16; }
__device__ __forceinline__ unsigned pk2(float lo, float hi) { unsigned r; asm("v_cvt_pk_bf16_f32 %0, %1, %2" : "=v"(r) : "v"(lo), "v"(hi)); return r; }
#define XB_TMO      128
#define XB_XCNT(j)  (256  + 64 * (j))
#define XB_XSUB(j)  (1280 + 64 * (j))
#define XB_XGEN(j)  (2304 + 64 * (j))
#define XB_TOP      3328
#define XB_TOPGEN   3392
#define XCD_BAR_WORDS 3456
#define XB_SPIN_CAP (1u << 18)

__device__ __forceinline__ unsigned xb_ld(unsigned* p)              { return __hip_atomic_load(p, __ATOMIC_RELAXED, __HIP_MEMORY_SCOPE_AGENT); }
__device__ __forceinline__ unsigned xb_add(unsigned* p, unsigned v) { return __hip_atomic_fetch_add(p, v, __ATOMIC_RELAXED, __HIP_MEMORY_SCOPE_AGENT); }
__device__ __forceinline__ unsigned xb_xcc_id() { return (unsigned)__builtin_amdgcn_s_getreg((3 << 11) | 20) & 0xFu; }
#define XB_SPIN(cond, bar) do { unsigned _sp = 0; while (cond) { __builtin_amdgcn_s_sleep(1); \
    if ((++_sp & 255u) == 0u) { if (xb_ld(&(bar)[XB_TMO])) break; if (_sp > XB_SPIN_CAP) { atomicAdd(&(bar)[XB_TMO], 1u); break; } } } } while (0)

struct XcdBarrier {
    unsigned* bar; unsigned x;
    volatile LAS unsigned* st;
};

__device__ __forceinline__ XcdBarrier xcd_barrier_post(unsigned* bar, volatile LAS unsigned* st) {
    XcdBarrier b; b.bar = bar; b.x = xb_xcc_id(); b.st = st;
    if (threadIdx.x == 0) (void)xb_add(&bar[XB_XCNT(b.x)], 1u);
    return b;
}
__device__ __forceinline__ void xcd_barrier_complete(unsigned* bar, unsigned x, unsigned& nloc, unsigned& nx) {
    const unsigned G = gridDim.x * gridDim.y * gridDim.z;
    unsigned sum, cnt, mine, sp = 0u;
    for (;;) {
        sum = 0u; cnt = 0u; mine = 0u;
#pragma unroll
        for (unsigned j = 0; j < 16; ++j) { const unsigned c = xb_ld(&bar[XB_XCNT(j)]); sum += c; cnt += (c > 0u) ? 1u : 0u; mine = (j == x) ? c : mine; }
        if (sum == G) break;
        __builtin_amdgcn_s_sleep(1);
        if ((++sp & 255u) == 0u) { if (xb_ld(&bar[XB_TMO])) break; if (sp > XB_SPIN_CAP) { atomicAdd(&bar[XB_TMO], 1u); break; } }
    }
    nloc = mine > 0u ? mine : 1u; nx = cnt > 0u ? cnt : 1u;
}

__device__ __forceinline__ void xcd_barrier(const XcdBarrier& b) {
    asm volatile("s_waitcnt vmcnt(0)" ::: "memory");
    __syncthreads();
    if (threadIdx.x == 0) {
        unsigned* bar = b.bar; unsigned bx = b.x; asm volatile("" : "+s"(bar), "+s"(bx));
        __builtin_amdgcn_s_waitcnt(0);
        unsigned nloc = b.st[0], nx = b.st[1];
        if (nloc == 0u) { xcd_barrier_complete(bar, bx, nloc, nx); b.st[0] = nloc; b.st[1] = nx; }
        const unsigned old = xb_add(&bar[XB_XSUB(bx)], 1u);
        const unsigned gen = old / nloc;
        if (old + 1u == (gen + 1u) * nloc) {
            __builtin_amdgcn_fence(__ATOMIC_RELEASE, "agent");
            asm volatile("s_waitcnt vmcnt(0)" ::: "memory");
            const unsigned og = xb_add(&bar[XB_TOP], 1u);
            const unsigned tg = og / nx;
            if (og + 1u == (tg + 1u) * nx) xb_add(&bar[XB_TOPGEN], 1u);
            else XB_SPIN(xb_ld(&bar[XB_TOPGEN]) == tg, bar);
            __builtin_amdgcn_fence(__ATOMIC_ACQUIRE, "agent");
            xb_add(&bar[XB_XGEN(bx)], 1u);
            asm volatile("s_waitcnt vmcnt(0)" ::: "memory");
        } else {
            XB_SPIN(xb_ld(&bar[XB_XGEN(bx)]) == gen, bar);
            __builtin_amdgcn_fence(__ATOMIC_ACQUIRE, "agent");
            asm volatile("s_waitcnt vmcnt(0)" ::: "memory");
        }
    }
    __syncthreads();
}

constexpr int DM = 2048, NB = 4, SEQ = 4096, LC = 256, DEPTH = 4, DFF = 8192;
constexpr int M_LAT = NB * SEQ, M_CTX = NB * LC, M_ALL = M_LAT + M_CTX;
constexpr int N_IN = 5392, N_INP = 5632;
constexpr int OFF_HY = 768, OFF_NA = 2304, OFF_SSM = 3840;
constexpr int NWAVES = 8, NTHR = 512;
constexpr float EPS = 1e-6f;

constexpr size_t MiB = 1u << 20;
constexpr size_t WS_CTL = 0, CTL_ZERO_BYTES = 1 * MiB;
constexpr size_t WS_MOD = 1 * MiB;
constexpr size_t WS_MODP = 2 * MiB;
constexpr size_t WS_ROPE = 10 * MiB;
constexpr size_t WS_GLAT = 11 * MiB;
constexpr size_t WS_GCTX = 43 * MiB;
constexpr size_t WS_GCTX1 = 28 * MiB;
constexpr size_t WS_W4T = 46 * MiB;
constexpr size_t WS_W = 48 * MiB;
constexpr size_t W_LAYER = 94 * MiB, W_OUT_OFF = 22 * MiB, W_1_OFF = 30 * MiB, W_2_OFF = 62 * MiB;
constexpr size_t WS_X = 424 * MiB;
constexpr size_t WS_XN = 560 * MiB;
constexpr size_t WS_P = 628 * MiB;
constexpr size_t WS_Y = 815 * MiB;
constexpr size_t WS_H = 883 * MiB;
constexpr size_t WS_XBC = 1155 * MiB;
constexpr size_t WS_XBCT = WS_XBC + 34 * MiB;
constexpr size_t WS_DT = 1223 * MiB;
constexpr size_t WS_YF = 1226 * MiB;
constexpr size_t WS_HIN = WS_YF;
constexpr size_t WS_YB = 1260 * MiB;
constexpr size_t WS_CD = WS_YB;
constexpr size_t WS_HU = 1294 * MiB;
constexpr size_t WS_SST = WS_HU;
constexpr size_t WS_Z = 1396 * MiB;
constexpr size_t WS_HUT = 1430 * MiB;
constexpr size_t WS_YT = 1478 * MiB;
constexpr size_t WS_GT = WS_GLAT;
constexpr size_t WS_VT = 1494 * MiB;
constexpr size_t WS_END = 1516 * MiB;
constexpr int CW_BAR = 4096;

constexpr int RING_BYTES = 131072, MISC_OFF = 147456, LDS_BYTES = MISC_OFF + 1024;

constexpr int PH_PRO1 = 0, PH_PRO2 = 1, PH_L0 = 2, PH_PER_LAYER = 10, PH_FINAL = PH_L0 + DEPTH * PH_PER_LAYER, N_PHASES = PH_FINAL + 1;
#ifndef PROBE_REP
#define PROBE_REP -1
#endif
#ifndef MK_SPLIT
#define MK_SPLIT 0
#endif

__device__ __forceinline__ float bf2f(bf16 h) { return __uint_as_float(((unsigned)h) << 16); }
__device__ __forceinline__ float wave_sum(float v) {
#pragma unroll
    for (int o = 1; o < 64; o <<= 1) v += __shfl_xor(v, o);
    return v;
}
__device__ __forceinline__ float wave_max(float v) {
#pragma unroll
    for (int o = 1; o < 64; o <<= 1) v = fmaxf(v, __shfl_xor(v, o));
    return v;
}
__device__ __forceinline__ float silu_f(float v) { return v / (1.f + __expf(-v)); }

struct Ctx {
    LAS unsigned char* lds;
    int tid, lane, wave, G, gw, NGW, bid;
};
__device__ __forceinline__ void launder(Ctx& C) { int t = threadIdx.x, bx = blockIdx.x, gx = gridDim.x; asm volatile("" : "+v"(t), "+s"(bx), "+s"(gx));
    C.tid = t; C.lane = t & 63; C.wave = __builtin_amdgcn_readfirstlane(t >> 6); C.bid = bx; C.G = gx; C.gw = bx * NWAVES + C.wave; C.NGW = gx * NWAVES; }
struct Args { const float* in[32]; float* out; unsigned char* ws; int ph_lo, ph_hi; };
typedef const Args __attribute__((address_space(4))) KArgs;

__device__ __forceinline__ void transpose_item(const float* W, int K, int N, bf16* WT, LAS float* scr, int kb, int nb, int lane) {
    const int k0 = 64 * kb, n0 = 64 * nb;
    const int nn = n0 + lane; const bool okn = nn < N;
    float tv[64];
#pragma unroll
    for (int i = 0; i < 64; ++i) tv[i] = okn ? W[(size_t)(k0 + i) * N + nn] : 0.f;
#pragma unroll
    for (int i = 0; i < 64; ++i) scr[i * 65 + lane] = tv[i];
    LDS_WAIT(); asm volatile("" ::: "memory");
    const int c = lane & 7;
#pragma unroll
    for (int j = 0; j < 8; ++j) { const int n = (lane >> 3) + 8 * j; const LAS float* s = scr + (8 * c) * 65 + n;
        v4u o; o.x = pk2(s[0 * 65], s[1 * 65]); o.y = pk2(s[2 * 65], s[3 * 65]); o.z = pk2(s[4 * 65], s[5 * 65]); o.w = pk2(s[6 * 65], s[7 * 65]);
        *(v4u*)(WT + (size_t)(n0 + n) * K + k0 + 8 * c) = o; }
    LDS_WAIT(); asm volatile("" ::: "memory");
}

__device__ __forceinline__ void phase_pro1(const Ctx& C, KArgs& A) {
    LAS float* sl = (LAS float*)C.lds;
    const float* cvec = A.in[1]; const float* cctx = A.in[3]; const float* ada_w = A.in[4];
    float* modp = (float*)(A.ws + WS_MODP);
    for (int sr = 0; sr < ((PROBE_REP == 43) ? 2 : 1); ++sr)
    for (int u = C.bid; u < 768; u += C.G) {
        const int layer = u / 192, r = u % 192, kc = r / 24, nb = r % 24;
        __syncthreads();
        for (int i = C.tid; i < 5 * 256; i += NTHR) { const int b = i >> 8, kk = i & 255, k = kc * 256 + kk; const float v = (b < 4) ? cvec[b * DM + k] : cctx[k]; sl[i] = v / (1.f + expf(-v)); }
        __syncthreads();
        const int n = nb * 512 + C.tid; const float* w = ada_w + ((size_t)layer * DM + kc * 256) * 12288 + n;
        float a0 = 0.f, a1 = 0.f, a2 = 0.f, a3 = 0.f, a4 = 0.f;
#pragma unroll 8
        for (int kk = 0; kk < 256; ++kk) { const float wv = w[(size_t)kk * 12288]; a0 += sl[kk] * wv; a1 += sl[256 + kk] * wv; a2 += sl[512 + kk] * wv; a3 += sl[768 + kk] * wv; a4 += sl[1024 + kk] * wv; }
        float* o = modp + ((size_t)(kc * 4 + layer) * 5) * 12288 + n;
        o[0] = a0; o[12288] = a1; o[2 * 12288] = a2; o[3 * 12288] = a3; o[4 * 12288] = a4;
    }
    __syncthreads();
    if (C.bid == 0) { float* rc = (float*)(A.ws + WS_ROPE); float* rs = rc + 1024;
        for (int i = C.tid; i < 1024; i += NTHR) { const int pos = i >> 4, j = i & 15; const float inv = powf(10000.f, -(float)j / 16.f); const float ang = (float)pos * inv; rc[i] = cosf(ang); rs[i] = sinf(ang); } }
    { const float* w4 = A.in[19]; bf16* w4t = (bf16*)(A.ws + WS_W4T);
      for (int i = C.bid * NTHR + C.tid; i < DEPTH * 2048; i += C.G * NTHR) { const int layer = i >> 11, n = i & 2047; const float* s = w4 + (size_t)layer * 64 * 2048 + n; v4u* d = (v4u*)(w4t + (size_t)i * 64);
#pragma unroll
          for (int q = 0; q < 8; ++q) { v4u o; o.x = pk2(s[(8 * q + 0) * 2048], s[(8 * q + 1) * 2048]); o.y = pk2(s[(8 * q + 2) * 2048], s[(8 * q + 3) * 2048]); o.z = pk2(s[(8 * q + 4) * 2048], s[(8 * q + 5) * 2048]); o.w = pk2(s[(8 * q + 6) * 2048], s[(8 * q + 7) * 2048]); d[q] = o; } } }
    LAS float* scr = (LAS float*)(C.lds + C.wave * 16896);
    constexpr int I_IN = 32 * 88, I_OUT = 32 * 32, I_1 = 32 * 128, I_2 = 128 * 32, I_LAYER = I_IN + I_OUT + I_1 + I_2;
    for (int it = C.gw; it < DEPTH * I_LAYER; it += C.NGW) {
        const int layer = it / I_LAYER; int r = it % I_LAYER;
        bf16* wl = (bf16*)(A.ws + WS_W + (size_t)layer * W_LAYER);
        if (r < I_IN) { transpose_item(A.in[8] + (size_t)layer * DM * N_IN, DM, N_IN, wl, scr, r / 88, r % 88, C.lane); continue; } r -= I_IN;
        if (r < I_OUT) { transpose_item(A.in[9] + (size_t)layer * DM * DM, DM, DM, (bf16*)((unsigned char*)wl + W_OUT_OFF), scr, r / 32, r % 32, C.lane); continue; } r -= I_OUT;
        if (r < I_1) { transpose_item(A.in[29] + (size_t)layer * DM * DFF, DM, DFF, (bf16*)((unsigned char*)wl + W_1_OFF), scr, r / 128, r % 128, C.lane); continue; } r -= I_1;
        transpose_item(A.in[30] + (size_t)layer * DFF * DM, DFF, DM, (bf16*)((unsigned char*)wl + W_2_OFF), scr, r / 32, r % 32, C.lane);
    }
}
__device__ __forceinline__ void phase_pro2(const Ctx& C, KArgs& A) {
    const float* modp = (const float*)(A.ws + WS_MODP); const float* ada_b = A.in[5]; float* mod = (float*)(A.ws + WS_MOD);
    for (int i = C.bid * NTHR + C.tid; i < DEPTH * 5 * 12288; i += C.G * NTHR) {
        const int layer = i / (5 * 12288), r = i % (5 * 12288), n = r % 12288;
        float s = ada_b[layer * 12288 + n];
#pragma unroll
        for (int kc = 0; kc < 8; ++kc) s += modp[(size_t)(kc * 4 + layer) * 5 * 12288 + r];
        mod[i] = s;
    }
}

__device__ __forceinline__ void norm_row_v(const f32x4 (&v)[8], const float* nw, const float* sh, const float* sc, bf16* orow, int lane) {
    float s = 0.f;
#pragma unroll
    for (int j = 0; j < 8; ++j) s += (v[j].x * v[j].x + v[j].y * v[j].y) + (v[j].z * v[j].z + v[j].w * v[j].w);
    const float rstd = 1.0f / sqrtf(wave_sum(s) * (1.f / DM) + EPS);
#pragma unroll
    for (int j = 0; j < 8; ++j) { const int c4 = lane + 64 * j; const f32x4 w = ((const f32x4*)nw)[c4], a = ((const f32x4*)sc)[c4], b = ((const f32x4*)sh)[c4];
        const f32x4 y = v[j] * rstd * w * (a + 1.0f) + b;
        *(unsigned long long*)(orow + 4 * c4) = (unsigned long long)pk2(y.x, y.y) | ((unsigned long long)pk2(y.z, y.w) << 32); }
}
__device__ __forceinline__ const float* norm_src(KArgs& A, int layer, int which, int m) {
    return (layer == 0 && which == 0) ? ((m < M_LAT) ? A.in[0] + (size_t)m * DM : A.in[2] + (size_t)(m - M_LAT) * DM) : (const float*)(A.ws + WS_X) + (size_t)m * DM;
}
__device__ __forceinline__ void phase_norm(const Ctx& C, KArgs& A, int layer, int which  , int row_lo, int row_hi, int gw, int ngw) {
    bf16* XN = (bf16*)(A.ws + WS_XN);
    const float* nw = A.in[which ? 7 : 6] + layer * DM;
    const float* mod = (const float*)(A.ws + WS_MOD) + (size_t)layer * 5 * 12288 + (which ? 3 * DM : 0);
    int m = row_lo + gw; f32x4 cur[8];
    if (m < row_hi) { const f32x4* xr = (const f32x4*)norm_src(A, layer, which, m);
#pragma unroll
        for (int j = 0; j < 8; ++j) cur[j] = xr[C.lane + 64 * j]; }
    while (m < row_hi) { const int mn = m + ngw; f32x4 nxt[8];
        if (mn < row_hi) { const f32x4* xr = (const f32x4*)norm_src(A, layer, which, mn);
#pragma unroll
            for (int j = 0; j < 8; ++j) nxt[j] = xr[C.lane + 64 * j]; }
        const int b = (m < M_LAT) ? (m >> 12) : 4; const float* mb = mod + (size_t)b * 12288;
        norm_row_v(cur, nw, mb, mb + DM, XN + (size_t)m * DM, C.lane);
#pragma unroll
        for (int j = 0; j < 8; ++j) cur[j] = nxt[j];
        m = mn; }
}
__device__ __forceinline__ void phase_final(const Ctx& C, KArgs& A) {
    const float* X = (const float*)(A.ws + WS_X); const float* nw = A.in[31];
    int m = C.gw; f32x4 cur[8];
    if (m < M_LAT) { const f32x4* xr = (const f32x4*)(X + (size_t)m * DM);
#pragma unroll
        for (int j = 0; j < 8; ++j) cur[j] = xr[C.lane + 64 * j]; }
    while (m < M_LAT) { const int mn = m + C.NGW; f32x4 nxt[8];
        if (mn < M_LAT) { const f32x4* xr = (const f32x4*)(X + (size_t)mn * DM);
#pragma unroll
            for (int j = 0; j < 8; ++j) nxt[j] = xr[C.lane + 64 * j]; }
        float s = 0.f;
#pragma unroll
        for (int j = 0; j < 8; ++j) s += (cur[j].x * cur[j].x + cur[j].y * cur[j].y) + (cur[j].z * cur[j].z + cur[j].w * cur[j].w);
        const float rstd = 1.0f / sqrtf(wave_sum(s) * (1.f / DM) + EPS);
        f32x4* o = (f32x4*)(A.out + (size_t)m * DM);
#pragma unroll
        for (int j = 0; j < 8; ++j) { const int c4 = C.lane + 64 * j; o[c4] = cur[j] * rstd * ((const f32x4*)nw)[c4]; }
#pragma unroll
        for (int j = 0; j < 8; ++j) cur[j] = nxt[j];
        m = mn; }
}

__device__ __forceinline__ float hy_filter_hidden(const Ctx& C, KArgs& A, int layer, int L, int t) {
    const int lane = C.lane;
    const float* w1 = A.in[13] + layer * 33 * 64; const float* b1 = A.in[14] + layer * 64; const float* w2 = A.in[15] + layer * 4096; const float* b2 = A.in[16] + layer * 64;
    const float* w3 = A.in[17] + layer * 4096; const float* b3 = A.in[18] + layer * 64; const float* fr = A.in[20] + layer * 64;
    const float tl = (float)t / (float)(L - 1);
    const float wpos = (6.283185307179586f * (float)t) / (float)L;
    float z = 0.f;
    if (lane == 0) z = tl;
    else if (lane <= 32) { const int k = (lane - 1) & 15; const float f = 1e-4f + (float)k * ((15.0f - 1e-4f) / 15.0f); const float a = f * wpos; z = (lane <= 16) ? cosf(a) : -sinf(a); }
    const float frl = fr[lane];
    float pre = b1[lane];
    for (int e = 0; e < 33; ++e) pre += __shfl(z, e) * w1[e * 64 + lane];
    float h = sinf(frl * pre);
    pre = b2[lane];
    for (int i = 0; i < 64; ++i) pre += __shfl(h, i) * w2[i * 64 + lane];
    h = sinf(frl * pre);
    pre = b3[lane];
    for (int i = 0; i < 64; ++i) pre += __shfl(h, i) * w3[i * 64 + lane];
    return sinf(frl * pre);
}
__device__ __forceinline__ void hy_filter_core(const Ctx& C, KArgs& A, int layer, int L, int t, float (&acc)[32]) {
    const int lane = C.lane; const float* w4 = A.in[19] + (size_t)layer * 64 * 2048;
    const float tl = (float)t / (float)(L - 1);
    const float h = hy_filter_hidden(C, A, layer, L, t);
#pragma unroll
    for (int cc = 0; cc < 32; ++cc) acc[cc] = 0.f;
    for (int i = 0; i < 64; ++i) { const float hi = __shfl(h, i); const float* wr = w4 + (size_t)i * 2048 + lane;
#pragma unroll
        for (int cc = 0; cc < 32; ++cc) acc[cc] += hi * wr[cc * 64]; }
    const float dmin = 3.0701134573253945f, dmax = 15.350567286626973f;
#pragma unroll
    for (int cc = 0; cc < 32; ++cc) { const int c = (cc * 64 + lane) & 511; const float delta = dmin + (float)c * ((dmax - dmin) / 511.0f); acc[cc] *= expf(-tl * delta); }
}
__device__ __forceinline__ void hy_filter_item(const Ctx& C, KArgs& A, int layer, int L, int t, float* G) {
    float acc[32]; hy_filter_core(C, A, layer, L, t, acc);
    const float* skip = A.in[21] + layer * 1024; const int W = 2 * L - 1, lane = C.lane;
#pragma unroll
    for (int cc = 0; cc < 32; ++cc) { const int col = cc * 64 + lane, o = col >> 10, r = (col >> 9) & 1, c = col & 511;
        float val = acc[cc];
        if (r == 0) { if (t == 0) val += skip[o * 512 + c]; G[((size_t)o * W + (L - 1 + t)) * 512 + c] = val; }
        else if (t > 0) G[((size_t)o * W + (L - 1 - t)) * 512 + c] = val; }
}
template <int L>
__device__ __forceinline__ void hy_filter_unit16(const Ctx& C, KArgs& A, int layer, int t0, void* Gout) {
    LAS bf16* H3 = (LAS bf16*)C.lds;
    __syncthreads();
#pragma unroll 1
    for (int q = 0; q < 2; ++q) { const int pi = 2 * C.wave + q; const float h = hy_filter_hidden(C, A, layer, L, t0 + pi); H3[pi * 64 + C.lane] = (bf16)f2bf(h); }
    __syncthreads();
    int lane = C.lane; asm volatile("" : "+v"(lane));
    const int li = lane & 15, g = lane >> 4, tq = t0 + 4 * g;
    const bf16x8 ha0 = *(const LAS bf16x8*)(H3 + li * 64 + 8 * g), ha1 = *(const LAS bf16x8*)(H3 + li * 64 + 32 + 8 * g);
    const bf16* w4t = (const bf16*)(A.ws + WS_W4T) + (size_t)layer * 2048 * 64; const float* skip = A.in[21] + layer * 1024;
    const float dmin = 3.0701134573253945f, dmax = 15.350567286626973f, inv = 1.0f / (float)(L - 1);
#pragma unroll 2
    for (int i = 0; i < 16; ++i) { const int n = 16 * (C.wave * 16 + i) + li;
        const bf16* wr = w4t + (size_t)n * 64 + 8 * g;
        f32x4 acc = __builtin_amdgcn_mfma_f32_16x16x32_bf16(ha0, *(const bf16x8*)wr, (f32x4){0.f, 0.f, 0.f, 0.f}, 0, 0, 0);
        acc = __builtin_amdgcn_mfma_f32_16x16x32_bf16(ha1, *(const bf16x8*)(wr + 32), acc, 0, 0, 0);
        const int o = n >> 10, dir = (n >> 9) & 1, c = n & 511; const float delta = dmin + (float)c * ((dmax - dmin) / 511.0f);
        float v[4];
#pragma unroll
        for (int r = 0; r < 4; ++r) v[r] = acc[r] * expf(-((float)(tq + r) * inv) * delta);
        if (dir == 0 && tq == 0) v[0] += skip[o * 512 + c];
        if (L == SEQ) { bf16* gp = (bf16*)Gout + ((size_t)(o * 512 + c)) * 8192 + (dir ? 0 : 4096) + tq;
            *(unsigned long long*)gp = (unsigned long long)pk2(v[0], v[1]) | ((unsigned long long)pk2(v[2], v[3]) << 32); }
        else { float* gq = (float*)Gout + (size_t)o * (2 * L - 1) * 512 + c;
#pragma unroll
            for (int r = 0; r < 4; ++r) { const int t = tq + r; if (dir == 0) gq[(size_t)(L - 1 + t) * 512] = v[r]; else if (t > 0) gq[(size_t)(L - 1 - t) * 512] = v[r]; } } }
}

constexpr int HY_CP_STRIDE = 16384 + 64;
constexpr int HY_U_OFF = 4 * HY_CP_STRIDE;
constexpr int HY_U_PITCH = 8992;
struct HyF { v4u w0, w1; };
__device__ __forceinline__ void hy_load_filter(HyF& f, const bf16* grow, int tid) { const v4u* gp = (const v4u*)(grow + 16 * tid); f.w0 = gp[0]; f.w1 = gp[1]; }
__device__ __forceinline__ void hy_store_filter(LAS unsigned char* lds, const HyF& f, int tid) {
    const v4u w0 = f.w0, w1 = f.w1;
    unsigned e[16];
    e[0] = w0.x & 0xffffu; e[1] = w0.x >> 16; e[2] = w0.y & 0xffffu; e[3] = w0.y >> 16; e[4] = w0.z & 0xffffu; e[5] = w0.z >> 16; e[6] = w0.w & 0xffffu; e[7] = w0.w >> 16;
    e[8] = w1.x & 0xffffu; e[9] = w1.x >> 16; e[10] = w1.y & 0xffffu; e[11] = w1.y >> 16; e[12] = w1.z & 0xffffu; e[13] = w1.z >> 16; e[14] = w1.w & 0xffffu; e[15] = w1.w >> 16;
#pragma unroll
    for (int j = 0; j < 16; ++j) { const int i = 16 * tid + j, x = (i >= 4096) ? 8191 - i : (i == 0 ? 8191 : 4095 + i); const bf16 val = (i == 0) ? (bf16)0 : (bf16)e[j];
#pragma unroll
        for (int k = 0; k < 4; ++k) { const int y = x - k; if (y >= 0) *(LAS bf16*)(lds + k * HY_CP_STRIDE + 2 * y) = val; } }
}
__device__ __forceinline__ void hy_load_u(v4u (&u)[4], const bf16* src, int tid) {
#pragma unroll
    for (int q = 0; q < 4; ++q) u[q] = ((const v4u*)src)[tid + 512 * q];
}
__device__ __forceinline__ void hy_store_u(LAS unsigned char* lds, const v4u (&u)[4], int tid) {
#pragma unroll
    for (int q = 0; q < 4; ++q) { const int idx = tid + 512 * q, el = 8 * idx, b = el >> 12, s = el & 4095; *(LAS v4u*)(lds + HY_U_OFF + b * HY_U_PITCH + 384 + 2 * s) = u[q]; }
    if (tid < 192) { const int b = tid / 48, r = tid % 48, side = r / 24, off = (r % 24) * 16; unsigned z0 = 0u; asm volatile("" : "+v"(z0)); v4u zz; zz.x = z0; zz.y = z0; zz.z = z0; zz.w = z0;
        *(LAS v4u*)(lds + HY_U_OFF + b * HY_U_PITCH + (side ? 384 + 8192 : 0) + off) = zz; }
}
__device__ __forceinline__ void hy_conv_mfma(LAS unsigned char* lds, f32x4 (&acc)[2][4], int wave, int lane) {
    typedef unsigned long long u64;
    const int wm = wave & 1, wn = wave >> 1, r = lane & 15, g = lane >> 4;
    const int kcp = (4095 - r) & 3;
    const int abase = kcp * HY_CP_STRIDE + 2 * (4095 - r - kcp + 8 * g) - 64 * wm;
    const int bbase = HY_U_OFF + (lane & 3) * HY_U_PITCH + 384 + 2 * (64 * (16 * wn + ((lane & 15) >> 2)) + 8 * g);
#pragma unroll 1
    for (int rho = 0; rho < 4; ++rho) {
        bf16x8 ring[4][2];
#pragma unroll 1
        for (int jq = 0; jq < 5; ++jq) {
#pragma unroll
            for (int k = 0; k < 4; ++k) {
                const int Dp = -63 + rho + 4 * (4 * jq + k);
                if (Dp <= 15) {
                    const int D = 16 * wn + Dp;
                    if (Dp <= 3) {
#pragma unroll
                        for (int kk = 0; kk < 2; ++kk) ring[k][kk] = *(const LAS bf16x8*)(lds + bbase - 128 * D + 64 * kk); }
                    bf16x8 af[2][2];
#pragma unroll
                    for (int m = 0; m < 2; ++m)
#pragma unroll
                        for (int kk = 0; kk < 2; ++kk) { const LAS u64* ap = (const LAS u64*)(lds + abase - 128 * D - 32 * m + 64 * kk); union { u64 q[2]; bf16x8 v; } cv; cv.q[0] = ap[0]; cv.q[1] = ap[1]; af[m][kk] = cv.v; }
#pragma unroll
                    for (int kk = 0; kk < 2; ++kk)
#pragma unroll
                        for (int nt = 0; nt < 4; ++nt) { const int e = Dp - 4 * nt;
                            if (e >= -63 && e <= 3) {
#pragma unroll
                                for (int m = 0; m < 2; ++m) acc[m][nt] = __builtin_amdgcn_mfma_f32_16x16x32_bf16(af[m][kk], ring[(k - nt) & 3][kk], acc[m][nt], 0, 0, 0); } }
                }
            }
        }
    }
}
__device__ __forceinline__ void hy_fast_units(const Ctx& C, KArgs& A) {
    LAS unsigned char* lds = C.lds;
    const bf16* GT = (const bf16*)(A.ws + WS_GT); const bf16* HUT = (const bf16*)(A.ws + WS_HUT); bf16* YT = (bf16*)(A.ws + WS_YT);
    int tid = C.tid; asm volatile("" : "+v"(tid));
    const int wave = C.wave, lane = tid & 63, wm = wave & 1, wn = wave >> 1, g = lane >> 4, bb = lane & 3, il = (lane & 15) >> 2;
    int c = C.bid; if (c >= 512) return;
    HyF fa; v4u ua[4];
    hy_load_filter(fa, GT + (size_t)c * 8192, tid); hy_load_u(ua, HUT + ((size_t)(2 * 512 + c)) * M_LAT, tid);
    while (c < 512) {
        const int cn = c + C.G;
        __syncthreads();
        hy_store_filter(lds, fa, tid); hy_store_u(lds, ua, tid);
        HyF fb; hy_load_filter(fb, GT + (size_t)(512 + c) * 8192, tid);
        unsigned long long xg[2][4];
        { const bf16* x1 = HUT + (size_t)c * M_LAT + bb * SEQ;
#pragma unroll
          for (int m = 0; m < 2; ++m)
#pragma unroll
              for (int nt = 0; nt < 4; ++nt) xg[m][nt] = *(const unsigned long long*)(x1 + 64 * (16 * wn + 4 * nt + il) + 16 * (2 * wm + m) + 4 * g); }
        __syncthreads();
        f32x4 acc[2][4];
#pragma unroll
        for (int m = 0; m < 2; ++m)
#pragma unroll
            for (int nt = 0; nt < 4; ++nt) acc[m][nt] = (f32x4){0.f, 0.f, 0.f, 0.f};
        hy_conv_mfma(lds, acc, wave, lane);
        __syncthreads();
#pragma unroll
        for (int m = 0; m < 2; ++m)
#pragma unroll
            for (int nt = 0; nt < 4; ++nt) { const int t = 64 * (16 * wn + 4 * nt + il) + 16 * (2 * wm + m) + 4 * g;
                const unsigned lo = (unsigned)xg[m][nt], hi = (unsigned)(xg[m][nt] >> 32);
                const float z0 = __uint_as_float(lo << 16) * acc[m][nt][0], z1 = __uint_as_float(lo & 0xffff0000u) * acc[m][nt][1], z2 = __uint_as_float(hi << 16) * acc[m][nt][2], z3 = __uint_as_float(hi & 0xffff0000u) * acc[m][nt][3];
                *(LAS unsigned long long*)(lds + HY_U_OFF + bb * HY_U_PITCH + 384 + 2 * t) = (unsigned long long)pk2(z0, z1) | ((unsigned long long)pk2(z2, z3) << 32); }
        hy_store_filter(lds, fb, tid);
        { const bf16* x2 = HUT + ((size_t)(512 + c)) * M_LAT + bb * SEQ;
#pragma unroll
          for (int m = 0; m < 2; ++m)
#pragma unroll
              for (int nt = 0; nt < 4; ++nt) xg[m][nt] = *(const unsigned long long*)(x2 + 64 * (16 * wn + 4 * nt + il) + 16 * (2 * wm + m) + 4 * g); }
        if (cn < 512) { hy_load_filter(fa, GT + (size_t)cn * 8192, tid); hy_load_u(ua, HUT + ((size_t)(2 * 512 + cn)) * M_LAT, tid); }
        __syncthreads();
#pragma unroll
        for (int m = 0; m < 2; ++m)
#pragma unroll
            for (int nt = 0; nt < 4; ++nt) acc[m][nt] = (f32x4){0.f, 0.f, 0.f, 0.f};
        hy_conv_mfma(lds, acc, wave, lane);
        { bf16* yo = YT + (size_t)c * M_LAT + bb * SEQ;
#pragma unroll
          for (int m = 0; m < 2; ++m)
#pragma unroll
              for (int nt = 0; nt < 4; ++nt) { const int t = 64 * (16 * wn + 4 * nt + il) + 16 * (2 * wm + m) + 4 * g;
                  const unsigned lo = (unsigned)xg[m][nt], hi = (unsigned)(xg[m][nt] >> 32);
                  const float z0 = __uint_as_float(lo << 16) * acc[m][nt][0], z1 = __uint_as_float(lo & 0xffff0000u) * acc[m][nt][1], z2 = __uint_as_float(hi << 16) * acc[m][nt][2], z3 = __uint_as_float(hi & 0xffff0000u) * acc[m][nt][3];
                  *(unsigned long long*)(yo + t) = (unsigned long long)pk2(z0, z1) | ((unsigned long long)pk2(z2, z3) << 32); } }
        c = cn;
    }
}
__device__ __forceinline__ void hy_prep_tile(const Ctx& C, KArgs& A, int layer, int tile) {
    const int lane = C.lane; LAS unsigned* T = (LAS unsigned*)(C.lds + C.wave * 8448);
    const int ct = tile % 24, tt = tile / 24, cb = ct * 64, row0 = tt * 64, t0 = row0 & 4095;
    const float* sw = A.in[11] + layer * 3 * 1536; const float* sb = A.in[12] + layer * 1536; const int ch = cb + lane;
    const float w0 = sw[ch], w1 = sw[1536 + ch], w2 = sw[3072 + ch], bias = sb[ch];
    const bf16* p = (const bf16*)(A.ws + WS_P) + (size_t)row0 * N_INP + OFF_HY + ch;
    float pm = (t0 > 0) ? bf2f(p[-(ptrdiff_t)N_INP]) : 0.f, pc = bf2f(p[0]), ae = 0.f;
#pragma unroll 8
    for (int i = 0; i < 64; ++i) { const float pn = (t0 + i + 1 < SEQ) ? bf2f(p[(size_t)(i + 1) * N_INP]) : 0.f; const float a = bias + w0 * pm + w1 * pc + w2 * pn; pm = pc; pc = pn;
        if (i & 1) T[lane * 33 + (i >> 1)] = pk2(ae, a); else ae = a; }
    LDS_WAIT(); asm volatile("" ::: "memory");
    unsigned* dst = (unsigned*)((bf16*)(A.ws + WS_HUT) + (size_t)cb * M_LAT + row0);
#pragma unroll 8
    for (int ii = 0; ii < 32; ++ii) { const int rr = 2 * ii + (lane >> 5), j = lane & 31; dst[(size_t)rr * (M_LAT / 2) + j] = T[rr * 33 + j]; }
    LDS_WAIT(); asm volatile("" ::: "memory");
}
__device__ __forceinline__ void hy_post_tile(const Ctx& C, KArgs& A, int tile) {
    const int lane = C.lane; LAS unsigned char* T = C.lds + C.wave * 8448;
    const int ct = tile & 7, tt = tile >> 3, cb = ct * 64, row0 = tt * 64;
    const unsigned* src = (const unsigned*)((const bf16*)(A.ws + WS_YT) + (size_t)cb * M_LAT + row0);
#pragma unroll
    for (int ii = 0; ii < 32; ++ii) { const int rr = 2 * ii + (lane >> 5), j = lane & 31; const unsigned w = src[(size_t)rr * (M_LAT / 2) + j];
        *(LAS bf16*)(T + (2 * j) * 132 + 2 * rr) = (bf16)(w & 0xffffu); *(LAS bf16*)(T + (2 * j + 1) * 132 + 2 * rr) = (bf16)(w >> 16); }
    LDS_WAIT(); asm volatile("" ::: "memory");
    unsigned* dst = (unsigned*)((bf16*)(A.ws + WS_Y) + (size_t)row0 * DM + 512 + cb);
#pragma unroll
    for (int ii = 0; ii < 32; ++ii) { const int rr = 2 * ii + (lane >> 5), j = lane & 31; dst[(size_t)rr * (DM / 2) + j] = *(const LAS unsigned*)(T + rr * 132 + 4 * j); }
    LDS_WAIT(); asm volatile("" ::: "memory");
}

struct PrepDesc { int col0, nch; const float* w; int wstride; const float* bias; bool silu; int cm_count; bf16* dst_cm; size_t cm_stride; int cm_col; bf16* dst_tm; int tm_stride; };
__device__ __forceinline__ void prep_load(KArgs& A, const PrepDesc& D, int r0, int t0, int L, int tid, v4u (&v)[5]) {
    const bf16* P = (const bf16*)(A.ws + WS_P); const int cpr = D.nch >> 3; const bool conv = D.w != nullptr, hp = conv && t0 > 0, hn = conv && (t0 + 32 < L);
#pragma unroll
    for (int i = 0; i < 5; ++i) { const int idx = tid + NTHR * i, rr = idx / cpr, part = idx - rr * cpr; const bool ok = idx < 34 * cpr && ((rr == 0) ? hp : ((rr == 33) ? hn : true));
        v[i].x = 0u; v[i].y = 0u; v[i].z = 0u; v[i].w = 0u; if (ok) v[i] = *(const v4u*)(P + (size_t)(r0 - 1 + rr) * N_INP + D.col0 + 8 * part); }
}
__device__ __forceinline__ void prep_desc(KArgs& A, int layer, int u, PrepDesc& D, int& r0, int& t0, int& L) {
    const int NT_L = M_LAT / 32, NT_A = M_ALL / 32; const int nH = 3 * NT_L, nS = 2 * NT_A; int tt;
    if (u < nH) { const int k = u / NT_L; tt = u - k * NT_L; D.col0 = OFF_HY + 512 * k; D.nch = 512; D.w = A.in[11] + layer * 3 * 1536 + 512 * k; D.wstride = 1536; D.bias = A.in[12] + layer * 1536 + 512 * k; D.silu = false;
        D.cm_count = 512; D.dst_cm = (bf16*)(A.ws + WS_HUT) + (size_t)(512 * k) * M_LAT; D.cm_stride = M_LAT; D.cm_col = 32 * tt; D.dst_tm = nullptr; D.tm_stride = 0; }
    else if (u < nH + nS) { const int v = u - nH, k = v / NT_A; tt = v - k * NT_A; D.col0 = OFF_SSM + 512 + 512 * k; D.nch = 512; D.w = A.in[23] + layer * 3 * 1024 + 512 * k; D.wstride = 1024; D.bias = A.in[24] + layer * 1024 + 512 * k; D.silu = true;
        D.cm_count = k ? 256 : 512; D.dst_cm = (bf16*)(A.ws + WS_XBCT) + (size_t)(512 * k) * M_ALL; D.cm_stride = M_ALL; D.cm_col = 32 * tt; D.dst_tm = (bf16*)(A.ws + WS_XBC) + 512 * k; D.tm_stride = 1024; }
    else { const int v = u - nH - nS, k = v / NT_A; tt = v - k * NT_A; D.col0 = k ? OFF_NA + 1024 : 640; D.nch = k ? 512 : 128; D.w = nullptr; D.wstride = 0; D.bias = nullptr; D.silu = false;
        D.cm_count = D.nch; D.dst_cm = (bf16*)(A.ws + WS_VT) + (size_t)(k ? 128 : 0) * M_ALL; D.cm_stride = M_ALL; D.cm_col = 32 * tt; D.dst_tm = nullptr; D.tm_stride = 0; }
    r0 = 32 * tt; if (r0 < M_LAT) { t0 = r0 & 4095; L = SEQ; } else { t0 = (r0 - M_LAT) & 255; L = LC; }
}
__device__ __forceinline__ void phase_prep_units(const Ctx& C, KArgs& A, int layer) {
    LAS unsigned char* lds = C.lds; constexpr int OFF_T = 36864, OFF_O = 81920;
    const int N = 3 * (M_LAT / 32) + 4 * (M_ALL / 32);
    int tid = C.tid; asm volatile("" : "+v"(tid));
    int u = C.bid; v4u v[5];
    if (u < N) { PrepDesc D0; int a0, b0, c0; prep_desc(A, layer, u, D0, a0, b0, c0); prep_load(A, D0, a0, b0, c0, tid, v); }
    while (u < N) {
        PrepDesc D; int r0, t0, L; prep_desc(A, layer, u, D, r0, t0, L);
        const int cpr = D.nch >> 3;
        __syncthreads();
#pragma unroll
        for (int i = 0; i < 5; ++i) { const int idx = tid + NTHR * i, rr = idx / cpr, part = idx - rr * cpr; if (idx < 34 * cpr) *(LAS v4u*)(lds + (rr * D.nch + 8 * part) * 2) = v[i]; }
        const int un = u + C.G;
        if (un < N) { PrepDesc Dn; int r0n, t0n, Ln; prep_desc(A, layer, un, Dn, r0n, t0n, Ln); prep_load(A, Dn, r0n, t0n, Ln, tid, v); }
        __syncthreads();
        if (tid < D.nch) { const int c = tid; float w0 = 0.f, w1 = 1.f, w2 = 0.f, bs = 0.f;
            if (D.w != nullptr) { w0 = D.w[c]; w1 = D.w[D.wstride + c]; w2 = D.w[2 * D.wstride + c]; bs = D.bias[c]; }
            const LAS bf16* in = (const LAS bf16*)lds + c; float pm = bf2f(in[0]), pc = bf2f(in[D.nch]), ae = 0.f;
            const bool cm = c < D.cm_count, tm = D.dst_tm != nullptr;
#pragma unroll 8
            for (int t = 0; t < 32; ++t) { const float pn = bf2f(in[(t + 2) * D.nch]); float a = bs + w0 * pm + w1 * pc + w2 * pn; if (D.silu) a = silu_f(a); pm = pc; pc = pn;
                if (tm) *(LAS bf16*)(lds + OFF_O + (t * D.nch + c) * 2) = (bf16)f2bf(a);
                if (t & 1) { if (cm) *(LAS unsigned*)(lds + OFF_T + c * 80 + (t >> 1) * 4) = pk2(ae, a); } else ae = a; } }
        __syncthreads();
        for (int idx = tid; idx < D.cm_count * 4; idx += NTHR) { const int c = idx >> 2, part = idx & 3; *(v4u*)(D.dst_cm + (size_t)c * D.cm_stride + D.cm_col + 8 * part) = *(const LAS v4u*)(lds + OFF_T + c * 80 + part * 16); }
        if (D.dst_tm) for (int idx = tid; idx < 32 * cpr; idx += NTHR) { const int t = idx / cpr, part = idx - t * cpr; *(v4u*)(D.dst_tm + (size_t)(r0 + t) * D.tm_stride + 8 * part) = *(const LAS v4u*)(lds + OFF_O + (t * D.nch + 8 * part) * 2); }
        u = un;
    }
    __syncthreads();
}

__device__ __forceinline__ void prep_dt(const Ctx& C, KArgs& A, int layer) {
    const bf16* P = (const bf16*)(A.ws + WS_P); float* DT = (float*)(A.ws + WS_DT);
    for (int i = C.bid * NTHR + C.tid; i < M_ALL * 16; i += C.G * NTHR) { const int row = i >> 4, j = i & 15;
        const float raw = bf2f(P[(size_t)row * N_INP + OFF_SSM + 1536 + j]) + A.in[25][layer * 16 + j]; const float dt = raw > 20.f ? raw : log1pf(expf(raw));
        DT[i] = dt; DT[(size_t)M_ALL * 16 + i] = -expf(A.in[26][layer * 16 + j]) * dt; }
}
__device__ __forceinline__ void prep_row(const Ctx& C, KArgs& A, int layer, int row) {
    const int lane = C.lane;
    const bf16* prow = (const bf16*)(A.ws + WS_P) + (size_t)row * N_INP;
    const int t = (row - M_LAT) & 255; const bool hp = t > 0, hn = t < LC - 1;
    const bf16* pm = prow - N_INP; const bf16* pp = prow + N_INP;
    const float* sw = A.in[11] + layer * 3 * 1536; const float* sb = A.in[12] + layer * 1536; float* HU = (float*)(A.ws + WS_HU) + (size_t)row * 1536;
#pragma unroll
    for (int i = 0; i < 24; ++i) { const int ch = lane + 64 * i, col = OFF_HY + ch;
        float a = sb[ch] + sw[1536 + ch] * bf2f(prow[col]); if (hp) a += sw[ch] * bf2f(pm[col]); if (hn) a += sw[3072 + ch] * bf2f(pp[col]);
        HU[ch] = a; }
}

constexpr float ATT_SC = 0.125f * 1.4426950408889634f, LOG2E = 1.4426950408889634f;
struct SD_A { int b, base, ilo, nloc;
    __device__ __forceinline__ void init(int b_, int n, int hh) { b = b_; base = n * 128 + 64 * hh - 128; ilo = base < 0 ? (-base) >> 5 : 0; int ihi = (SEQ - base) >> 5; ihi = ihi > 10 ? 10 : ihi; nloc = ihi - ilo; }
    __device__ __forceinline__ int nsteps() const { return nloc + 8; }
    __device__ __forceinline__ int seg(int j, int& code) const { if (j < nloc) { code = ilo + j; return b * SEQ + base + 32 * code; } code = -1; return M_LAT + b * LC + 32 * (j - nloc); }
    __device__ __forceinline__ void mask(int code, int qt, int li, int g, float (&sv)[8]) const { if (code < 0 || (code >= 2 && code <= 7)) return; const int d0 = 32 * code + 4 * g - li - 16 * qt;
#pragma unroll
        for (int j = 0; j < 8; ++j) sv[j] = ((unsigned)(d0 + (j & 3) + 16 * (j >> 2)) <= 256u) ? sv[j] : -INFINITY; } };
struct SD_NA { int b, r, rstart; const LAS float* rpb;
    __device__ __forceinline__ int nsteps() const { return 24; }
    __device__ __forceinline__ int seg(int j, int& code) const { if (j < 16) { code = j; return b * SEQ + (rstart + (j >> 1)) * 64 + 32 * (j & 1); } code = -1; return M_LAT + b * LC + 32 * (j - 16); }
    __device__ __forceinline__ void mask(int code, int qt, int li, int g, float (&sv)[8]) const { if (code < 0) return; const int c = 16 * qt + li; int c0 = c - 8; c0 = c0 < 0 ? 0 : (c0 > 48 ? 48 : c0);
        const int lo = c0 - c, d0 = 32 * (code & 1) + 4 * g - c, rowb = (rstart + (code >> 1) - r + 7) * 31 + 15;
        float bias[8]; const volatile LAS float* rp = (const volatile LAS float*)rpb;
#pragma unroll
        for (int j = 0; j < 8; ++j) { const int d = d0 + (j & 3) + 16 * (j >> 2); const bool ok = (unsigned)(d - lo) < 16u; bias[j] = rp[ok ? rowb + d : 0]; }
#pragma unroll
        for (int j = 0; j < 8; ++j) { const int d = d0 + (j & 3) + 16 * (j >> 2); const bool ok = (unsigned)(d - lo) < 16u; sv[j] = ok ? sv[j] + bias[j] : -INFINITY; } } };
struct SD_CTX { int b;
    __device__ __forceinline__ int nsteps() const { return 8; }
    __device__ __forceinline__ int seg(int j, int& code) const { code = -1; return M_LAT + b * LC + 32 * j; }
    __device__ __forceinline__ void mask(int, int, int, int, float (&)[8]) const {} };

struct AttnKV { bf16x8 kf[2][2], vf[4]; };
__device__ __forceinline__ void attn_load(AttnKV& kv, __amdgpu_buffer_rsrc_t rp, __amdgpu_buffer_rsrc_t rv, int rowstart, int kcol, unsigned koff, unsigned voff) {
    const int ks = (rowstart * N_INP + kcol) * 2, vs = rowstart * 2;
#pragma unroll
    for (int half = 0; half < 2; ++half)
#pragma unroll
        for (int kk = 0; kk < 2; ++kk) { union { v4u u; bf16x8 x; } cv; cv.u = __builtin_amdgcn_raw_buffer_load_b128(rp, koff, ks + 16 * half * N_INP * 2 + 64 * kk, 0); kv.kf[half][kk] = cv.x; }
#pragma unroll
    for (int dt = 0; dt < 4; ++dt) { typedef unsigned v2u_ __attribute__((ext_vector_type(2))); union { v2u_ q[2]; bf16x8 x; } cv;
        cv.q[0] = __builtin_amdgcn_raw_buffer_load_b64(rv, voff, vs + 16 * dt * M_ALL * 2, 0); cv.q[1] = __builtin_amdgcn_raw_buffer_load_b64(rv, voff, vs + 16 * dt * M_ALL * 2 + 32, 0); kv.vf[dt] = cv.x; }
}
template <class SD>
__device__ __forceinline__ void attn_step(const AttnKV& kv, const SD& sd, int code, const LAS bf16x8* ql, f32x4 (&O)[4][4], float (&mrun)[4], float (&lrun)[4], int li, int g) {
    asm volatile("" : "+v"(li), "+v"(g));
#pragma unroll
    for (int qt = 0; qt < 4; ++qt) {
        const bf16x8 q0 = ql[(qt * 2 + 0) * 64], q1 = ql[(qt * 2 + 1) * 64];
        f32x4 s0 = __builtin_amdgcn_mfma_f32_16x16x32_bf16(kv.kf[0][0], q0, (f32x4){0.f, 0.f, 0.f, 0.f}, 0, 0, 0); f32x4 s1 = __builtin_amdgcn_mfma_f32_16x16x32_bf16(kv.kf[1][0], q0, (f32x4){0.f, 0.f, 0.f, 0.f}, 0, 0, 0);
        s0 = __builtin_amdgcn_mfma_f32_16x16x32_bf16(kv.kf[0][1], q1, s0, 0, 0, 0); s1 = __builtin_amdgcn_mfma_f32_16x16x32_bf16(kv.kf[1][1], q1, s1, 0, 0, 0);
        float sv[8];
#pragma unroll
        for (int r = 0; r < 4; ++r) { sv[r] = s0[r]; sv[4 + r] = s1[r]; }
        sd.mask(code, qt, li, g, sv);
        float tmax = fmaxf(fmaxf(fmaxf(sv[0], sv[1]), fmaxf(sv[2], sv[3])), fmaxf(fmaxf(sv[4], sv[5]), fmaxf(sv[6], sv[7])));
        tmax = fmaxf(tmax, __shfl_xor(tmax, 16)); tmax = fmaxf(tmax, __shfl_xor(tmax, 32));
        if (__builtin_amdgcn_ballot_w64(tmax > mrun[qt]) != 0ull) {
            const float mnew = fmaxf(mrun[qt], tmax), alpha = __builtin_amdgcn_exp2f(mrun[qt] - mnew); mrun[qt] = mnew; lrun[qt] *= alpha;
#pragma unroll
            for (int dt = 0; dt < 4; ++dt) O[qt][dt] = O[qt][dt] * alpha; }
        float p[8], ps = 0.f; const float mq = mrun[qt];
#pragma unroll
        for (int j = 0; j < 8; ++j) { p[j] = __builtin_amdgcn_exp2f(sv[j] - mq); ps += p[j]; }
        lrun[qt] += ps;
        union { unsigned u[4]; bf16x8 x; } pf; pf.u[0] = pk2(p[0], p[1]); pf.u[1] = pk2(p[2], p[3]); pf.u[2] = pk2(p[4], p[5]); pf.u[3] = pk2(p[6], p[7]);
#pragma unroll
        for (int dt = 0; dt < 4; ++dt) O[qt][dt] = __builtin_amdgcn_mfma_f32_16x16x32_bf16(kv.vf[dt], pf.x, O[qt][dt], 0, 0, 0);
    }
}
template <class SD, int DIAG = 0>
__device__ __forceinline__ void attn_core(const bf16* P, const bf16* VT, int qrow0, int qcol, int kcol, const SD& sd, bool has_sink, float sink, bf16* Ybase, int ocol, int lane, LAS bf16x8* ql) {
    const int li = lane & 15, g = lane >> 4;
    ql += lane;
    const unsigned koff = (unsigned)(li * N_INP + 8 * g) * 2u, voff = (unsigned)(li * M_ALL + 4 * g) * 2u;
    const int ns = sd.nsteps();
    const __amdgpu_buffer_rsrc_t rp = __builtin_amdgcn_make_buffer_rsrc((void*)P, 0, (int)((size_t)M_ALL * N_INP * 2), 0x00020000);
    const __amdgpu_buffer_rsrc_t rv = __builtin_amdgcn_make_buffer_rsrc((void*)VT, 0, 64 * M_ALL * 2, 0x00020000);
    const __amdgpu_buffer_rsrc_t ry = __builtin_amdgcn_make_buffer_rsrc((void*)Ybase, 0, (int)((size_t)M_ALL * DM * 2), 0x00020000);
    const unsigned yoff = (unsigned)(li * DM + 4 * g) * 2u;
    v4u qraw[4][2];
#pragma unroll
    for (int qt = 0; qt < 4; ++qt)
#pragma unroll
        for (int kk = 0; kk < 2; ++kk) qraw[qt][kk] = *(const v4u*)(P + (size_t)(qrow0 + 16 * qt + li) * N_INP + qcol + 32 * kk + 8 * g);
    AttnKV kva, kvb; int ca, cb;
    { const int rs = sd.seg(0, ca); attn_load(kva, rp, rv, rs, kcol, koff, voff); }
#pragma unroll
    for (int qt = 0; qt < 4; ++qt)
#pragma unroll
        for (int kk = 0; kk < 2; ++kk) { union { v4u u; bf16x8 x; } qv; qv.u = qraw[qt][kk];
#pragma unroll
            for (int e = 0; e < 4; ++e) { const unsigned w = qv.u[e]; qv.u[e] = pk2(__uint_as_float(w << 16) * ATT_SC, __uint_as_float(w & 0xffff0000u) * ATT_SC); }
            ql[(qt * 2 + kk) * 64] = qv.x; }
    LDS_WAIT(); asm volatile("" ::: "memory");
    f32x4 O[4][4]; float mrun[4], lrun[4];
#pragma unroll
    for (int qt = 0; qt < 4; ++qt) { mrun[qt] = has_sink ? sink * LOG2E : -1e30f; lrun[qt] = (has_sink && g == 0) ? 1.f : 0.f;
#pragma unroll
        for (int dt = 0; dt < 4; ++dt) O[qt][dt] = (f32x4){0.f, 0.f, 0.f, 0.f}; }
    if (DIAG == 0) {
#pragma unroll 1
    for (int step = 0; step < ns; step += 2) {
        if (step + 1 < ns) { const int rs = sd.seg(step + 1, cb); attn_load(kvb, rp, rv, rs, kcol, koff, voff); }
        attn_step(kva, sd, ca, ql, O, mrun, lrun, li, g);
        if (step + 1 < ns) {
            if (step + 2 < ns) { const int rs = sd.seg(step + 2, ca); attn_load(kva, rp, rv, rs, kcol, koff, voff); }
            attn_step(kvb, sd, cb, ql, O, mrun, lrun, li, g);
        }
    }
    }
#pragma unroll
    for (int qt = 0; qt < 4; ++qt) { float lt = lrun[qt]; lt += __shfl_xor(lt, 16); lt += __shfl_xor(lt, 32); const float inv = 1.0f / lt;
        const int so = ((qrow0 + 16 * qt) * DM + ocol) * 2;
#pragma unroll
        for (int dt = 0; dt < 4; ++dt) { const f32x4 o = O[qt][dt] * inv; typedef unsigned v2u_ __attribute__((ext_vector_type(2))); v2u_ w; w.x = pk2(o[0], o[1]); w.y = pk2(o[2], o[3]);
            __builtin_amdgcn_raw_buffer_store_b64(w, ry, yoff, so + 32 * dt, 0); } }
}

template <int DIAG = 0>
__device__ __forceinline__ void phase_attn(const Ctx& C, KArgs& A, int layer, bool need_ctx) {
    const bf16* P = (const bf16*)(A.ws + WS_P); bf16* Y = (bf16*)(A.ws + WS_Y); const bf16* VT = (const bf16*)(A.ws + WS_VT);
    const float* sinkp = A.in[10] + layer * 8; const float* rpb = A.in[22] + (size_t)layer * 8 * 15 * 31;
    LAS bf16x8* ql = (LAS bf16x8*)(C.lds + C.wave * 8192);
    const int nA = NB * 32 * 8 * 2, nN = NB * 8 * 64, nC = need_ctx ? NB * 8 * 4 : 0;
    const int ctx_r = (C.bid >= 80 && C.wave < 2) ? (C.bid - 80) + (C.G - 80) * C.wave : 1 << 20;
#pragma unroll 1
    for (int k = 0; k < 3; ++k) { const int it = (k < 2) ? C.gw + k * C.NGW : nA + nN + ctx_r;
        if (it >= nA + nN + 2 * nC) break;
        int r = it;
        if (r < nA) { const int hh = r & 1, hq = (r >> 1) & 7, n = (r >> 4) & 31, b = r >> 9, hk = hq >> 2; SD_A sd; sd.init(b, n, hh);
            attn_core<decltype(sd), DIAG>(P, VT + (size_t)hk * 64 * M_ALL, b * SEQ + n * 128 + 64 * hh, 64 * hq, 512 + 64 * hk, sd, true, sinkp[hq], Y, 64 * hq, C.lane, ql); continue; } r -= nA;
        if (r < nN) { const int h = r & 7, rr = (r >> 3) & 63, b = r >> 9; int rstart = rr - 4; rstart = rstart < 0 ? 0 : (rstart > 56 ? 56 : rstart); LAS float* rl = (LAS float*)(C.lds + 65536 + C.wave * 2048);
            for (int i = C.lane; i < 465; i += 64) rl[i] = rpb[h * 465 + i] * LOG2E;
            LDS_WAIT(); asm volatile("" ::: "memory");
            SD_NA sd{b, rr, rstart, rl};
            attn_core<decltype(sd), DIAG>(P, VT + (size_t)(2 + h) * 64 * M_ALL, b * SEQ + rr * 64, OFF_NA + 64 * h, OFF_NA + 512 + 64 * h, sd, false, 0.f, Y, 1024 + 64 * h, C.lane, ql); continue; } r -= nN;
        if (r < nC) { const int blk = r & 3, hq = (r >> 2) & 7, b = r >> 5, hk = hq >> 2; SD_CTX sd{b};
            attn_core<decltype(sd), DIAG>(P, VT + (size_t)hk * 64 * M_ALL, M_LAT + b * LC + 64 * blk, 64 * hq, 512 + 64 * hk, sd, true, sinkp[hq], Y, 64 * hq, C.lane, ql); continue; } r -= nC;
        { const int blk = r & 3, h = (r >> 2) & 7, b = r >> 5; SD_CTX sd{b};
            attn_core<decltype(sd), DIAG>(P, VT + (size_t)(2 + h) * 64 * M_ALL, M_LAT + b * LC + 64 * blk, OFF_NA + 64 * h, OFF_NA + 512 + 64 * h, sd, false, 0.f, Y, 1024 + 64 * h, C.lane, ql); }
    }
}
__device__ __forceinline__ void vt_prep_tile(const Ctx& C, KArgs& A, int tile) {
    const int lane = C.lane; LAS unsigned* T = (LAS unsigned*)(C.lds + C.wave * 8448);
    const int slot = tile % 10, tt = tile / 10, row0 = tt * 64, col0 = (slot < 2) ? 640 + 64 * slot : OFF_NA + 1024 + 64 * (slot - 2);
    const bf16* p = (const bf16*)(A.ws + WS_P) + (size_t)row0 * N_INP + col0 + lane;
#pragma unroll 8
    for (int i = 0; i < 32; ++i) { const unsigned lo = p[(size_t)(2 * i) * N_INP], hi = p[(size_t)(2 * i + 1) * N_INP]; T[lane * 33 + i] = lo | (hi << 16); }
    LDS_WAIT(); asm volatile("" ::: "memory");
    unsigned* dst = (unsigned*)((bf16*)(A.ws + WS_VT) + (size_t)slot * 64 * M_ALL + row0);
#pragma unroll 8
    for (int ii = 0; ii < 32; ++ii) { const int rr = 2 * ii + (lane >> 5), j = lane & 31; dst[(size_t)rr * (M_ALL / 2) + j] = T[rr * 33 + j]; }
    LDS_WAIT(); asm volatile("" ::: "memory");
}

template <bool OUT_BF16>
__device__ __forceinline__ void hy_conv_unit(const float* U, int ustride, const float* G, int L, int rowbase, int t0, const float* gate, int gstride, void* outp, int ostride, int c) {
    float acc[16], old[16], nw[16], u[16];
#pragma unroll
    for (int i = 0; i < 16; ++i) { acc[i] = 0.f; old[i] = 0.f; }
#pragma unroll
    for (int m = 0; m < 15; ++m) old[m] = G[(size_t)(t0 + 1 + m + L - 1) * 512 + c];
    float un[16], nn[16];
#pragma unroll
    for (int k = 0; k < 16; ++k) un[k] = U[(size_t)(rowbase + k) * ustride + c];
#pragma unroll
    for (int m = 0; m < 16; ++m) nn[m] = G[(size_t)(t0 - 15 + m + L - 1) * 512 + c];
    for (int sb = 0; sb < L; sb += 16) {
#pragma unroll
        for (int k = 0; k < 16; ++k) { u[k] = un[k]; nw[k] = nn[k]; }
        if (sb + 16 < L) {
#pragma unroll
            for (int k = 0; k < 16; ++k) un[k] = U[(size_t)(rowbase + sb + 16 + k) * ustride + c];
#pragma unroll
            for (int m = 0; m < 16; ++m) nn[m] = G[(size_t)(t0 - sb - 16 - 15 + m + L - 1) * 512 + c]; }
#pragma unroll
        for (int i = 0; i < 16; ++i)
#pragma unroll
            for (int k = 0; k < 16; ++k) { const int j = i - k; acc[i] += u[k] * ((j <= 0) ? nw[j + 15] : old[j - 1]); }
#pragma unroll
        for (int m = 0; m < 16; ++m) old[m] = nw[m];
    }
#pragma unroll
    for (int i = 0; i < 16; ++i) { const size_t row = (size_t)(rowbase + t0 + i); const float v = gate[row * gstride + c] * acc[i];
        if (OUT_BF16) ((bf16*)outp)[row * ostride + c] = (bf16)f2bf(v); else ((float*)outp)[row * ostride + c] = v; }
}
__device__ __forceinline__ void phase_hyconv(const Ctx& C, KArgs& A, int layer, int order, bool need_ctx, int first_wg = 0) {
    const float* HU = (const float*)(A.ws + WS_HU); float* Z = (float*)(A.ws + WS_Z); bf16* Y = (bf16*)(A.ws + WS_Y);
    const float* GL = (const float*)(A.ws + WS_GLAT) + (size_t)order * (2 * SEQ - 1) * 512; const float* GC = (const float*)(A.ws + ((layer & 1) ? WS_GCTX1 : WS_GCTX)) + (size_t)order * (2 * LC - 1) * 512;
    const int nl = 0, nc = need_ctx ? NB * (LC / 16) : 0;
    for (int u = (C.bid >= first_wg) ? C.bid - first_wg : C.bid - first_wg + C.G; u < nl + nc; u += C.G) {
        int L, rowbase, t0; const float* G;
        if (u < nl) { const int b = u / (SEQ / 16); t0 = (u % (SEQ / 16)) * 16; L = SEQ; rowbase = b * SEQ; G = GL; }
        else { const int v = u - nl, b = v / (LC / 16); t0 = (v % (LC / 16)) * 16; L = LC; rowbase = M_LAT + b * LC; G = GC; }
        if (order == 0) hy_conv_unit<false>(HU + 1024, 1536, G, L, rowbase, t0, HU, 1536, Z, 512, C.tid);
        else hy_conv_unit<true>(Z, 512, G, L, rowbase, t0, HU + 512, 1536, Y + 512, DM, C.tid);
    }
}

__device__ __forceinline__ int ssd_rowbase(int b, int ci) { return ci < 2 ? M_LAT + b * LC + 128 * ci : b * SEQ + 128 * (ci - 2); }
__device__ __forceinline__ void ssd_tables(const Ctx& C, KArgs& A, int rowbase, int grp, LAS float* cs, LAS float* dtl, LAS float* wtab, float* cd_out) {
    const int w = C.wave, lane = C.lane, h = w & 3, d = w >> 2, head = grp * 4 + h;
    const float* DT = (const float*)(A.ws + WS_DT); const float* DTA = DT + (size_t)M_ALL * 16;
    const size_t i0 = (size_t)(rowbase + 2 * lane) * 16 + d * 8 + head;
    const float a0 = DTA[i0], a1 = DTA[i0 + 16], dt0 = DT[i0], dt1 = DT[i0 + 16];
    float incl = a0 + a1;
#pragma unroll
    for (int o = 1; o < 64; o <<= 1) { const float t = __shfl_up(incl, o); if (lane >= o) incl += t; }
    const float excl = incl - (a0 + a1), tot = __shfl(incl, 63);
    float c0, c1;
    if (d == 0) { c0 = excl + a0; c1 = incl; } else { c0 = tot - excl; c1 = tot - excl - a0; }
    cs[w * 128 + 2 * lane] = c0; cs[w * 128 + 2 * lane + 1] = c1; dtl[w * 128 + 2 * lane] = dt0; dtl[w * 128 + 2 * lane + 1] = dt1;
    wtab[w * 128 + 2 * lane] = dt0 * __expf(tot - c0); wtab[w * 128 + 2 * lane + 1] = dt1 * __expf(tot - c1);
    if (cd_out && lane == 0) cd_out[head * 2 + d] = __expf(tot);
}
constexpr int D1_XS = 12288;
__device__ __forceinline__ void ssd_d1_unit(const Ctx& C, KArgs& A, int b, int ci, int grp) {
    const int w = C.wave, rowbase = ssd_rowbase(b, ci);
    LAS float* cs = (LAS float*)C.lds; LAS float* dtl = cs + 1024; LAS float* wtab = dtl + 1024; LAS unsigned char* lds = C.lds;
    const bf16* XT = (const bf16*)(A.ws + WS_XBCT);
    __syncthreads();
    int tid = C.tid; asm volatile("" : "+v"(tid));
    ssd_tables(C, A, rowbase, grp, cs, dtl, wtab, (float*)(A.ws + WS_CD) + (size_t)(b * 34 + ci) * 16);
    { const bf16* xsrc = XT + (size_t)(grp * 256) * M_ALL + rowbase;
#pragma unroll
      for (int i = 0; i < 8; ++i) { const int q = tid + 512 * i, row = q >> 4, part = q & 15; *(LAS v4u*)(lds + D1_XS + row * 272 + part * 16) = *(const v4u*)(xsrc + (size_t)row * M_ALL + 8 * part); } }
    const int lane = tid & 63, g = lane >> 4, li = lane & 15;
    v4u braw[4];
#pragma unroll
    for (int kq = 0; kq < 4; ++kq) braw[kq] = *(const v4u*)(XT + (size_t)(512 + grp * 128 + 16 * w + li) * M_ALL + rowbase + 32 * kq + 8 * g);
    __syncthreads();
    float* SST = (float*)(A.ws + WS_SST);
#pragma unroll 1
    for (int hd = 0; hd < 8; ++hd) {
        const int h = hd & 3, d = hd >> 2, head = grp * 4 + h;
        bf16x8 bw[4];
#pragma unroll
        for (int kq = 0; kq < 4; ++kq) { const LAS f32x4* wp = (const LAS f32x4*)(wtab + hd * 128 + 32 * kq + 8 * g); const f32x4 w0 = wp[0], w1 = wp[1]; const v4u x = braw[kq];
            union { unsigned u[4]; bf16x8 v; } cv; cv.u[0] = pk2(__uint_as_float(x.x << 16) * w0.x, __uint_as_float(x.x & 0xffff0000u) * w0.y); cv.u[1] = pk2(__uint_as_float(x.y << 16) * w0.z, __uint_as_float(x.y & 0xffff0000u) * w0.w);
            cv.u[2] = pk2(__uint_as_float(x.z << 16) * w1.x, __uint_as_float(x.z & 0xffff0000u) * w1.y); cv.u[3] = pk2(__uint_as_float(x.w << 16) * w1.z, __uint_as_float(x.w & 0xffff0000u) * w1.w); bw[kq] = cv.v; }
        f32x4 acc[4];
        int xo = (h * 64 + li) * 272 + 16 * g; asm volatile("" : "+v"(xo));
#pragma unroll
        for (int pt = 0; pt < 4; ++pt) { acc[pt] = (f32x4){0.f, 0.f, 0.f, 0.f};
#pragma unroll
            for (int kq = 0; kq < 4; ++kq) { const bf16x8 xf = *(const LAS bf16x8*)(lds + D1_XS + xo + 16 * pt * 272 + 64 * kq);
                acc[pt] = __builtin_amdgcn_mfma_f32_16x16x32_bf16(xf, bw[kq], acc[pt], 0, 0, 0); } }
        float* so = SST + ((size_t)((b * 34 + ci) * 8 + head) * 2 + d) * 8192 + 16 * w + li;
#pragma unroll
        for (int pt = 0; pt < 4; ++pt)
#pragma unroll
            for (int r = 0; r < 4; ++r) so[(size_t)(16 * pt + 4 * g + r) * 128] = acc[pt][r];
    }
}
__device__ __forceinline__ void ssd_d2(const Ctx& C, KArgs& A) {
    const float* SST = (const float*)(A.ws + WS_SST); const float* CD = (const float*)(A.ws + WS_CD); bf16* HIN = (bf16*)(A.ws + WS_HIN);
    for (int e = C.bid * NTHR + C.tid; e < NB * 8 * 2 * 8192; e += C.G * NTHR) {
        const int pn = e & 8191, d = (e >> 13) & 1, head = (e >> 14) & 7, b = e >> 17;
        float H = 0.f;
        float sv[34], cv[34];
#pragma unroll
        for (int i = 0; i < 34; ++i) { const int ci = d ? (i < 2 ? 1 - i : 35 - i) : i; const size_t o = ((size_t)((b * 34 + ci) * 8 + head) * 2 + d); sv[i] = SST[o * 8192 + pn]; cv[i] = CD[o]; }
#pragma unroll
        for (int i = 0; i < 34; ++i) { const int ci = d ? (i < 2 ? 1 - i : 35 - i) : i;
            const size_t o = ((size_t)((b * 34 + ci) * 8 + head) * 2 + d); HIN[o * 8192 + pn] = (bf16)f2bf(H); H = cv[i] * H + sv[i]; }
    }
}
constexpr int D3_XS = 8192, D3_HS = D3_XS + 256 * 272, D3_PITCH = 272, D3_BS = D3_HS + 8192;
template <bool CTX>
__device__ __forceinline__ void ssd_d3_unit(const Ctx& C, KArgs& A, int layer, int b, int ci, int grp) {
    const int lane = C.lane, w = C.wave, g = lane >> 4, li = lane & 15, rowbase = ssd_rowbase(b, ci);
    LAS float* cs = (LAS float*)C.lds; LAS float* dtl = cs + 1024; LAS unsigned char* lds = C.lds;
    const bf16* XBC = (const bf16*)(A.ws + WS_XBC); const bf16* XT = (const bf16*)(A.ws + WS_XBCT);
    __syncthreads();
    int tid = C.tid; asm volatile("" : "+v"(tid));
    {
      LAS float* wt = (LAS float*)(lds + D3_HS);
      ssd_tables(C, A, rowbase, grp, cs, dtl, wt, nullptr);
      const bf16* xsrc = XT + (size_t)(grp * 256) * M_ALL + rowbase;
#pragma unroll
      for (int i = 0; i < 8; ++i) { const int q = tid + 512 * i, row = q >> 4, part = q & 15; *(LAS v4u*)(lds + D3_XS + row * D3_PITCH + part * 16) = *(const v4u*)(xsrc + (size_t)row * M_ALL + 8 * part); }
      const bf16* bsrc = XBC + (size_t)rowbase * 1024 + 512 + grp * 128;
#pragma unroll
      for (int i = 0; i < 4; ++i) { const int q = tid + 512 * i, row = q >> 4, part = q & 15; *(LAS v4u*)(lds + D3_BS + row * D3_PITCH + part * 16) = *(const v4u*)(bsrc + (size_t)row * 1024 + 8 * part); } }
    __syncthreads();
    int lrow = 16 * w + li;
    bf16x8 cf[4];
#pragma unroll
    for (int kk = 0; kk < 4; ++kk) cf[kk] = *(const bf16x8*)(XBC + (size_t)(rowbase + lrow) * 1024 + 768 + grp * 128 + 32 * kk + 8 * g);
    f32x4 T[8];
#pragma unroll
    for (int st = 0; st < 8; ++st) { T[st] = (f32x4){0.f, 0.f, 0.f, 0.f};
#pragma unroll
        for (int kk = 0; kk < 4; ++kk) { const bf16x8 bf_ = *(const LAS bf16x8*)(lds + D3_BS + (16 * st + li) * D3_PITCH + 64 * kk + 16 * g);
            T[st] = __builtin_amdgcn_mfma_f32_16x16x32_bf16(bf_, cf[kk], T[st], 0, 0, 0); }
        if ((st & 1) == 1) __builtin_amdgcn_sched_barrier(0); }
    f32x4 acc[4][4];
#pragma unroll
    for (int h = 0; h < 4; ++h)
#pragma unroll
        for (int pt = 0; pt < 4; ++pt) acc[h][pt] = (f32x4){0.f, 0.f, 0.f, 0.f};
    const int xoff0 = li * D3_PITCH + 8 * g, hoff0 = li * D3_PITCH + 16 * g, kqm = w >> 1;
#pragma unroll 1
    for (int d = 0; d < 2; ++d) {
      asm volatile("" : "+v"(tid));
      __syncthreads();
      {
        if (CTX) { const bool zero = (d == 0) ? (ci == 0) : (ci == 1); const float* sst = (const float*)(A.ws + WS_SST) + ((size_t)((b * 34 + (1 - ci)) * 8 + grp * 4) * 2 + d) * 8192;
#pragma unroll
            for (int i = 0; i < 8; ++i) { const int q = tid + 512 * i, h = q >> 10, within = q & 1023, row = within >> 4, part = within & 15; v4u o; o.x = 0u; o.y = 0u; o.z = 0u; o.w = 0u;
                if (!zero) { const f32x4* sp = (const f32x4*)(sst + (size_t)h * 2 * 8192 + row * 128 + 8 * part); const f32x4 a = sp[0], c = sp[1]; o.x = pk2(a[0], a[1]); o.y = pk2(a[2], a[3]); o.z = pk2(c[0], c[1]); o.w = pk2(c[2], c[3]); }
                *(LAS v4u*)(lds + D3_HS + (h * 64 + row) * D3_PITCH + part * 16) = o; } }
        else { const bf16* hsrc = (const bf16*)(A.ws + WS_HIN) + ((size_t)((b * 34 + ci) * 8 + grp * 4) * 2 + d) * 8192;
#pragma unroll
            for (int i = 0; i < 8; ++i) { const int q = tid + 512 * i, h = q >> 10, within = q & 1023, row = within >> 4, part = within & 15;
                *(LAS v4u*)(lds + D3_HS + (h * 64 + row) * D3_PITCH + part * 16) = *(const v4u*)(hsrc + (size_t)h * 2 * 8192 + row * 128 + 8 * part); } } }
      __syncthreads();
#pragma unroll
      for (int h = 0; h < 4; ++h) {
        const int hd = d * 4 + h;
        int lr = lrow; asm volatile("" : "+v"(lr));
        const float csl = cs[hd * 128 + lr];
        bf16x8 mf[4];
#pragma unroll
        for (int kq = 0; kq < 4; ++kq) { if (d ? (kq >= kqm) : (kq <= kqm)) { float v[8];
#pragma unroll
            for (int half = 0; half < 2; ++half) { const int s0 = 32 * kq + 16 * half + 4 * g; const f32x4 cv4 = *(const LAS f32x4*)(cs + hd * 128 + s0), dt4 = *(const LAS f32x4*)(dtl + hd * 128 + s0);
#pragma unroll
                for (int r = 0; r < 4; ++r) { const int s = s0 + r; const bool ok = d ? (s >= lr) : (s <= lr); const float e = __expf(fminf(csl - cv4[r], 0.f)) * dt4[r]; v[half * 4 + r] = ok ? T[2 * kq + half][r] * e : 0.f; } }
            union { unsigned u[4]; bf16x8 x; } cv; cv.u[0] = pk2(v[0], v[1]); cv.u[1] = pk2(v[2], v[3]); cv.u[2] = pk2(v[4], v[5]); cv.u[3] = pk2(v[6], v[7]); mf[kq] = cv.x; } }
        const float el = __expf(csl); bf16x8 cfs[4];
#pragma unroll
        for (int kk = 0; kk < 4; ++kk) { union { bf16x8 x; unsigned u[4]; } ci_, co; ci_.x = cf[kk];
#pragma unroll
            for (int q = 0; q < 4; ++q) co.u[q] = pk2(__uint_as_float(ci_.u[q] << 16) * el, __uint_as_float(ci_.u[q] & 0xffff0000u) * el);
            cfs[kk] = co.x; }
        int xo = xoff0 + h * 64 * D3_PITCH, ho = hoff0 + h * 64 * D3_PITCH; asm volatile("" : "+v"(xo), "+v"(ho));
#pragma unroll
        for (int pt = 0; pt < 4; ++pt) {
            f32x4 a4 = acc[h][pt];
#pragma unroll
            for (int kq = 0; kq < 4; ++kq) { if (d ? (kq >= kqm) : (kq <= kqm)) { union { unsigned long long q[2]; bf16x8 x; } cv; const LAS unsigned char* xp = lds + D3_XS + xo + 16 * pt * D3_PITCH + 64 * kq;
                cv.q[0] = *(const LAS unsigned long long*)xp; cv.q[1] = *(const LAS unsigned long long*)(xp + 32);
                a4 = __builtin_amdgcn_mfma_f32_16x16x32_bf16(cv.x, mf[kq], a4, 0, 0, 0); } }
#pragma unroll
            for (int kk = 0; kk < 4; ++kk) { const bf16x8 hf = *(const LAS bf16x8*)(lds + D3_HS + ho + 16 * pt * D3_PITCH + 64 * kk);
                a4 = __builtin_amdgcn_mfma_f32_16x16x32_bf16(hf, cfs[kk], a4, 0, 0, 0); }
            acc[h][pt] = a4; asm volatile("" ::: "memory"); }
      }
    }
    const size_t row = (size_t)(rowbase + lrow);
    const bf16* xs = XBC + row * 1024 + grp * 256; const bf16* zp = (const bf16*)(A.ws + WS_P) + row * N_INP + OFF_SSM + grp * 256;
    const float* dsk = A.in[27] + layer * 8 + grp * 4; const float* nw = A.in[28] + layer * 512 + grp * 256;
    float ss = 0.f;
#pragma unroll
    for (int h = 0; h < 4; ++h) { const float dh = dsk[h];
#pragma unroll
        for (int pt = 0; pt < 4; ++pt) { const int cb = h * 64 + 16 * pt + 4 * g;
            const unsigned long long xw = *(const unsigned long long*)(xs + cb), zw = *(const unsigned long long*)(zp + cb);
            const unsigned xl = (unsigned)xw, xh = (unsigned)(xw >> 32), zl = (unsigned)zw, zh = (unsigned)(zw >> 32);
            f32x4 v = acc[h][pt];
            v[0] = (v[0] + dh * __uint_as_float(xl << 16)) * silu_f(__uint_as_float(zl << 16)); v[1] = (v[1] + dh * __uint_as_float(xl & 0xffff0000u)) * silu_f(__uint_as_float(zl & 0xffff0000u));
            v[2] = (v[2] + dh * __uint_as_float(xh << 16)) * silu_f(__uint_as_float(zh << 16)); v[3] = (v[3] + dh * __uint_as_float(xh & 0xffff0000u)) * silu_f(__uint_as_float(zh & 0xffff0000u));
            acc[h][pt] = v; ss += (v[0] * v[0] + v[1] * v[1]) + (v[2] * v[2] + v[3] * v[3]); } }
    ss += __shfl_xor(ss, 16); ss += __shfl_xor(ss, 32);
    const float rstd = 1.0f / sqrtf(ss * (1.f / 256.f) + EPS);
    bf16* yo = (bf16*)(A.ws + WS_Y) + row * DM + 1536 + grp * 256;
#pragma unroll
    for (int h = 0; h < 4; ++h)
#pragma unroll
        for (int pt = 0; pt < 4; ++pt) { const int cb = h * 64 + 16 * pt + 4 * g; const f32x4 nv = *(const f32x4*)(nw + cb); const f32x4 v = acc[h][pt];
            *(unsigned long long*)(yo + cb) = (unsigned long long)pk2(v[0] * rstd * nv[0], v[1] * rstd * nv[1]) | ((unsigned long long)pk2(v[2] * rstd * nv[2], v[3] * rstd * nv[3]) << 32); }
}
__device__ __forceinline__ void ssm_prep_tile(const Ctx& C, KArgs& A, int layer, int tile) {
    const int lane = C.lane; LAS unsigned* T = (LAS unsigned*)(C.lds + C.wave * 8448);
    const int ct = tile % 12, tt = tile / 12, cb = ct * 64, row0 = tt * 64;
    int t0, L; if (row0 < M_LAT) { t0 = row0 & 4095; L = SEQ; } else { t0 = (row0 - M_LAT) & 255; L = LC; }
    const float* cw = A.in[23] + layer * 3 * 1024; const float* cbias = A.in[24] + layer * 1024; const int ch = cb + lane;
    const float w0 = cw[ch], w1 = cw[1024 + ch], w2 = cw[2048 + ch], bias = cbias[ch];
    const bf16* p = (const bf16*)(A.ws + WS_P) + (size_t)row0 * N_INP + OFF_SSM + 512 + ch;
    float pm = (t0 > 0) ? bf2f(p[-(ptrdiff_t)N_INP]) : 0.f, pc = bf2f(p[0]), ae = 0.f;
#pragma unroll 8
    for (int i = 0; i < 64; ++i) { const float pn = (t0 + i + 1 < L) ? bf2f(p[(size_t)(i + 1) * N_INP]) : 0.f; const float a = silu_f(bias + w0 * pm + w1 * pc + w2 * pn); pm = pc; pc = pn;
        if (i & 1) T[lane * 33 + (i >> 1)] = pk2(ae, a); else ae = a; }
    LDS_WAIT(); asm volatile("" ::: "memory");
    unsigned* dst = (unsigned*)((bf16*)(A.ws + WS_XBCT) + (size_t)cb * M_ALL + row0);
#pragma unroll 8
    for (int ii = 0; ii < 32; ++ii) { const int rr = 2 * ii + (lane >> 5), j = lane & 31; dst[(size_t)rr * (M_ALL / 2) + j] = T[rr * 33 + j]; }
    LDS_WAIT(); asm volatile("" ::: "memory");
}

__device__ __forceinline__ void filter_unit(const Ctx& C, KArgs& A, int layer, int u) {
    if (u < SEQ / 16) hy_filter_unit16<SEQ>(C, A, layer, 16 * u, A.ws + WS_GT); else hy_filter_unit16<LC>(C, A, layer, 16 * (u - SEQ / 16), A.ws + ((layer & 1) ? WS_GCTX1 : WS_GCTX));
}
constexpr int CW_TAILQ = 8192;
__device__ __forceinline__ void tail_work(const Ctx& C, KArgs& A, int next_layer, volatile LAS unsigned* MISC) {
    const bool ctxf = next_layer < DEPTH - 1; const int nF = SEQ / 16 + (ctxf ? LC / 16 : 0);
    unsigned* head = (unsigned*)(A.ws + WS_CTL) + CW_TAILQ + 64 * next_layer;
    for (;;) {
        __syncthreads();
        if (C.tid == 0) MISC[16] = __hip_atomic_fetch_add(head, 1u, __ATOMIC_RELAXED, __HIP_MEMORY_SCOPE_AGENT);
        __syncthreads();
        const int q = (int)MISC[16];
        if (q >= nF) break;
        filter_unit(C, A, next_layer, q);
    }
    __syncthreads();
}

namespace pg8 {
struct CtxOrder {
    int c;
    __device__ bool next(int i, Unit& u) const { if (i > 0 || c >= 32) return false; u.pm = c >> 3; u.pn = c & 7; return true; }
    __device__ __forceinline__ void a_ready(const Unit&) const {}
    __device__ __forceinline__ void done(const Unit&) const {}
};
}
__global__ void __launch_bounds__(NTHR, 2) mk_fwd(const Args A_unused) {
    KArgs* Ap = (KArgs*)__builtin_amdgcn_kernarg_segment_ptr();
#define A (*Ap)
    extern __shared__ __attribute__((aligned(16))) unsigned char lds_raw[];
    Ctx C;
    C.lds = (LAS unsigned char*)lds_raw;
    C.tid = threadIdx.x; C.lane = C.tid & 63; C.wave = __builtin_amdgcn_readfirstlane(C.tid >> 6);
    C.bid = blockIdx.x; C.G = gridDim.x; C.gw = C.bid * NWAVES + C.wave; C.NGW = C.G * NWAVES;
    volatile LAS unsigned* MISC = (volatile LAS unsigned*)(C.lds + MISC_OFF);
    for (int u = C.tid; u < (LDS_BYTES - MISC_OFF) / 4; u += NTHR) MISC[u] = 0u;
    __syncthreads();
    XcdBarrier bar; bar.bar = (unsigned*)(A.ws + WS_CTL) + CW_BAR; bar.x = 0; bar.st = nullptr;
    if (!MK_SPLIT) bar = xcd_barrier_post((unsigned*)(A.ws + WS_CTL) + CW_BAR, MISC + 8);
    const int lo = A.ph_lo, hi = A.ph_hi;
#define IN(k) (lo <= (k) && (k) < hi && (launder(C), ({ asm volatile("" : "+s"(Ap)); true; })))
#define RELOAD_A_UNUSED() asm volatile("" : "+s"(Ap))
#define REPS(k) ((PROBE_REP == (k)) ? 2 : 1)
#define SEAM(k) do { if (!MK_SPLIT && IN(k) && IN((k) + 1)) xcd_barrier(bar); } while (0)

    if (IN(PH_PRO1)) { phase_pro1(C, A); if (PROBE_REP == 40) { if (!MK_SPLIT) xcd_barrier(bar); launder(C); phase_pro1(C, A); } } SEAM(PH_PRO1);
    if (IN(PH_PRO2)) { phase_pro2(C, A); for (int u = C.bid; u < SEQ / 16 + LC / 16; u += C.G) filter_unit(C, A, 0, u); __syncthreads(); } SEAM(PH_PRO2);

    for (int layer = 0; layer < DEPTH; ++layer) {
        const int pb = PH_L0 + layer * PH_PER_LAYER; const bool last = (layer == DEPTH - 1), need_ctx = !last;
        const unsigned char* wl = A.ws + WS_W + (size_t)layer * W_LAYER;
        const float* mod = (const float*)(A.ws + WS_MOD) + (size_t)layer * 5 * 12288;
        if (IN(pb + 0)) for (int rep_ = 0; rep_ < REPS(0); ++rep_) { if (rep_) { if (!MK_SPLIT) xcd_barrier(bar); launder(C); }
            phase_norm(C, A, layer, 0, layer == 0 ? 0 : M_LAT, M_ALL, C.gw, C.NGW);
            const int nf = SEQ + (need_ctx ? LC : 0);
            (void)nf;
        } SEAM(pb + 0);
        if (IN(pb + 1)) for (int rep_ = 0; rep_ < REPS(1); ++rep_) { if (rep_) { if (!MK_SPLIT) xcd_barrier(bar); launder(C); }
            pg8::Gemm g{(const bf16*)(A.ws + WS_XN), (const bf16*)wl, M_ALL, N_INP, DM}; pg8::StaticOrder S; S.init(M_ALL, N_INP, C.G, C.bid);
            pg8::EpiStoreBf16<0> E{(bf16*)(A.ws + WS_P), N_INP, (const float*)(A.ws + WS_ROPE)};
            pg8::gemm_phase<pg8::EpiStoreBf16<0>, pg8::StaticOrder, true, true>(C.lds, g, S, E);
        } SEAM(pb + 1);
        if (IN(pb + 2)) for (int rep_ = 0; rep_ < REPS(2); ++rep_) { if (rep_) { if (!MK_SPLIT) xcd_barrier(bar); launder(C); } prep_dt(C, A, layer); if (need_ctx) { const int gws = C.gw - (C.NGW >> 1);
                for (int row = M_LAT + (gws < 0 ? gws + C.NGW : gws); row < M_ALL; row += C.NGW) prep_row(C, A, layer, row); }
            phase_prep_units(C, A, layer); } SEAM(pb + 2);
        if (IN(pb + 3)) for (int rep_ = 0; rep_ < REPS(3); ++rep_) { if (rep_) { if (!MK_SPLIT) xcd_barrier(bar); launder(C); }
            for (int sr = 0; sr < ((PROBE_REP == 32) ? 2 : 1); ++sr) { launder(C); for (int u = C.bid; u < NB * 34 * 2; u += C.G) ssd_d1_unit(C, A, u / 68, (u % 68) >> 1, u & 1); }
            __syncthreads();
            for (int sr = 0; sr < ((PROBE_REP == 30) ? 2 : 1); ++sr) { launder(C); hy_fast_units(C, A); }
            __syncthreads();
            phase_hyconv(C, A, layer, 0, need_ctx, 16);
            for (int sr = 0; sr < ((PROBE_REP == 31) ? 2 : 1); ++sr) { launder(C); phase_attn<0>(C, A, layer, need_ctx); }
        } SEAM(pb + 3);
        if (IN(pb + 4)) for (int rep_ = 0; rep_ < REPS(4); ++rep_) { if (rep_) { if (!MK_SPLIT) xcd_barrier(bar); launder(C); }
            const int nHP = 8 * (M_LAT / 64), nHPx = need_ctx ? 16 * NWAVES : 0;
            if (need_ctx && C.bid >= C.G - 16) { const int u = C.bid - (C.G - 16); ssd_d3_unit<true>(C, A, layer, u >> 2, (u >> 1) & 1, u & 1); __syncthreads();
                launder(C); hy_post_tile(C, A, nHP - nHPx + u * NWAVES + C.wave); }
            else { Ctx C2 = C; if (need_ctx) { C2.G = C.G - 16; C2.NGW = C2.G * NWAVES; }
                ssd_d2(C2, A);
                for (int tile = C2.gw; tile < nHP - nHPx; tile += C2.NGW) hy_post_tile(C2, A, tile);
                phase_hyconv(C2, A, layer, 1, need_ctx, 16); }
        } SEAM(pb + 4);
        if (IN(pb + 5)) for (int rep_ = 0; rep_ < REPS(5); ++rep_) { if (rep_) { if (!MK_SPLIT) xcd_barrier(bar); launder(C); }
            for (int u = C.bid; u < NB * 32 * 2; u += C.G) ssd_d3_unit<false>(C, A, layer, u >> 6, 2 + ((u & 63) >> 1), u & 1);
        } SEAM(pb + 5);
        if (IN(pb + 6)) for (int rep_ = 0; rep_ < REPS(6); ++rep_) { if (rep_) { if (!MK_SPLIT) xcd_barrier(bar); launder(C); }
            float* Xp = (float*)(A.ws + WS_X); const bool first = (layer == 0 && rep_ == 0); const float* bl = first ? A.in[0] : Xp; const float* bc = first ? A.in[2] : Xp + (size_t)M_LAT * DM;
            { pg8::Gemm g{(const bf16*)(A.ws + WS_Y), (const bf16*)(wl + W_OUT_OFF), M_LAT, DM, DM}; pg8::StaticOrder S; S.init(M_LAT, DM, C.G, C.bid);
              pg8::EpiResid E; E.X = Xp; E.gate = mod + 2 * DM; E.gs = rep_ ? 0.f : 1.f; E.base_lat = bl; E.base_ctx = bl;
              pg8::gemm_phase<pg8::EpiResid, pg8::StaticOrder, true, true>(C.lds, g, S, E); }
            if (need_ctx) { if (!MK_SPLIT) xcd_barrier(bar); launder(C);
                if (C.bid < 32) { pg8::Gemm g{(const bf16*)(A.ws + WS_Y) + (size_t)M_LAT * DM, (const bf16*)(wl + W_OUT_OFF), M_CTX, DM, DM}; pg8::CtxOrder S; S.c = C.bid;
                    pg8::EpiResid E; E.X = Xp + (size_t)M_LAT * DM; E.gate = mod + 4 * 12288 + 2 * DM; E.gs = rep_ ? 0.f : 1.f; E.base_lat = bc; E.base_ctx = bc;
                    pg8::gemm_phase<pg8::EpiResid, pg8::CtxOrder, true, true>(C.lds, g, S, E); }
                else phase_norm(C, A, layer, 1, 0, M_LAT, (C.bid - 32) * NWAVES + C.wave, (C.G - 32) * NWAVES); }
        } SEAM(pb + 6);
        if (IN(pb + 7)) for (int rep_ = 0; rep_ < REPS(7); ++rep_) { if (rep_) { if (!MK_SPLIT) xcd_barrier(bar); launder(C); } phase_norm(C, A, layer, 1, need_ctx ? M_LAT : 0, need_ctx ? M_ALL : M_LAT, C.gw, C.NGW); } SEAM(pb + 7);
        if (IN(pb + 8)) for (int rep_ = 0; rep_ < REPS(8); ++rep_) { if (rep_) { if (!MK_SPLIT) xcd_barrier(bar); launder(C); }
            const int Mo = need_ctx ? M_ALL : M_LAT;
            pg8::Gemm g{(const bf16*)(A.ws + WS_XN), (const bf16*)(wl + W_1_OFF), Mo, DFF, DM}; pg8::StaticOrder S; S.init(Mo, DFF, C.G, C.bid);
            pg8::EpiStoreBf16<1> E{(bf16*)(A.ws + WS_H), DFF, nullptr};
            pg8::gemm_phase<pg8::EpiStoreBf16<1>, pg8::StaticOrder, true, true>(C.lds, g, S, E);
        } SEAM(pb + 8);
        if (IN(pb + 9)) for (int rep_ = 0; rep_ < REPS(9); ++rep_) { if (rep_) { if (!MK_SPLIT) xcd_barrier(bar); launder(C); }
            float* Xp = (float*)(A.ws + WS_X);
            { pg8::Gemm g{(const bf16*)(A.ws + WS_H), (const bf16*)(wl + W_2_OFF), M_LAT, DM, DFF}; pg8::StaticOrder S; S.init(M_LAT, DM, C.G, C.bid);
              pg8::EpiResid E; E.X = Xp; E.gate = mod + 5 * DM; E.gs = rep_ ? 0.f : 1.f; E.base_lat = Xp; E.base_ctx = Xp;
              pg8::gemm_phase<pg8::EpiResid, pg8::StaticOrder, true, true>(C.lds, g, S, E); }
            if (need_ctx) { if (!MK_SPLIT) xcd_barrier(bar); launder(C);
                if (C.bid < 32) { pg8::Gemm g{(const bf16*)(A.ws + WS_H) + (size_t)M_LAT * DFF, (const bf16*)(wl + W_2_OFF), M_CTX, DM, DFF}; pg8::CtxOrder S; S.c = C.bid;
                    pg8::EpiResid E; E.X = Xp + (size_t)M_LAT * DM; E.gate = mod + 4 * 12288 + 5 * DM; E.gs = rep_ ? 0.f : 1.f; E.base_lat = Xp + (size_t)M_LAT * DM; E.base_ctx = E.base_lat;
                    pg8::gemm_phase<pg8::EpiResid, pg8::CtxOrder, true, true>(C.lds, g, S, E); }
                else { if (rep_ == 0) tail_work(C, A, layer + 1, MISC); launder(C); phase_norm(C, A, layer + 1, 0, 0, M_LAT, (C.bid - 32) * NWAVES + C.wave, (C.G - 32) * NWAVES); } }
            else if (layer + 1 < DEPTH && rep_ == 0) tail_work(C, A, layer + 1, MISC);
        } SEAM(pb + 9);
    }
    if (IN(PH_FINAL)) phase_final(C, A);
#undef IN
#undef SEAM
#undef A
}

extern "C" void kernel_launch(void* const* d_in, const int* in_sizes, int n_in, void* d_out, int out_size, void* d_ws, size_t ws_size, hipStream_t stream) {
    static int grid = 0;
    if (grid == 0) {
        if (n_in != 32 || out_size != M_LAT * DM || ws_size < WS_END) { fprintf(stderr, "kernel_launch: unexpected shapes (n_in %d, out %d, ws %zu); nothing launched\n", n_in, out_size, ws_size); grid = -1; return; }
        int dev = 0, cus = 0, per_cu = 0;
        if (hipGetDevice(&dev) != hipSuccess || hipDeviceGetAttribute(&cus, hipDeviceAttributeMultiprocessorCount, dev) != hipSuccess) { grid = -1; return; }
        if (hipFuncSetAttribute((const void*)mk_fwd, hipFuncAttributeMaxDynamicSharedMemorySize, LDS_BYTES) != hipSuccess) { fprintf(stderr, "kernel_launch: hipFuncSetAttribute failed\n"); grid = -1; return; }
        if (hipOccupancyMaxActiveBlocksPerMultiprocessor(&per_cu, (const void*)mk_fwd, NTHR, LDS_BYTES) != hipSuccess || per_cu < 1) { fprintf(stderr, "kernel_launch: occupancy query says %d blocks per CU\n", per_cu); }
        (void)hipGetLastError();
        grid = cus;
    }
    if (grid < 0) return;
    if (hipMemsetAsync((char*)d_ws + WS_CTL, 0, CTL_ZERO_BYTES, stream) != hipSuccess) { fprintf(stderr, "kernel_launch: memset failed\n"); return; }
    Args a{};
    for (int i = 0; i < 32; ++i) a.in[i] = (const float*)d_in[i];
    a.out = (float*)d_out; a.ws = (unsigned char*)d_ws;
#if MK_SPLIT
    for (int ph = 0; ph < N_PHASES; ++ph) { a.ph_lo = ph; a.ph_hi = ph + 1; hipLaunchKernelGGL(mk_fwd, dim3(grid), dim3(NTHR), LDS_BYTES, stream, a); }
#else
    a.ph_lo = 0; a.ph_hi = N_PHASES; hipLaunchKernelGGL(mk_fwd, dim3(grid), dim3(NTHR), LDS_BYTES, stream, a);
#endif
    const hipError_t le = hipPeekAtLastError();
    if (le != hipSuccess) fprintf(stderr, "kernel_launch: launch failed: %s\n", hipGetErrorName(le));
}
```

```cpp
#include <hip/hip_runtime.h>
#include <cstdio>
#include <cstdint>
namespace pg8 {
#define PG8_LAS __attribute__((address_space(3)))
typedef unsigned short bf16_t;
typedef short bf16x8 __attribute__((ext_vector_type(8)));
typedef float f32x4 __attribute__((ext_vector_type(4)));
typedef unsigned u32x4 __attribute__((ext_vector_type(4)));
constexpr int BM = 256, BK = 64, HALF = 128, HTB = HALF * BK * 2  , STAGE_BYTES = 8 * HTB, NXCD = 8, WGM = 8;

__host__ __device__ __forceinline__ int lds_byte(int r, int c) { const int st = (r >> 4) * 2 + (c >> 5), rr = r & 15, cc = c & 31, ob = rr * 64 + cc * 2; return st * 1024 + (ob ^ (((ob >> 9) & 1) << 5)); }
__host__ __device__ __forceinline__ void stage_rc(int b, int& R, int& C) { const int st = b / 1024, sb = b % 1024, swz = sb ^ (((sb >> 9) & 1) << 5); R = (st >> 1) * 16 + swz / 64; C = (st & 1) * 32 + (swz % 64) / 2; }
__host__ __device__ __forceinline__ int perm32(int rho) { const int n = rho >> 4, i = rho & 15; return 8 * (i >> 2) + 4 * n + (i & 3); }

struct Unit { int pm, pn; };
struct Gemm { const bf16_t* A; const bf16_t* Bt; int M, N, K; };

struct StaticOrder {
    int nM, nN, nwg, G, c;
    __host__ __device__ void init(int M, int N, int G_, int c_) { nM = M / BM; nN = N / BM; nwg = nM * nN; G = G_; c = c_; }
    __host__ __device__ bool next(int i, Unit& u) const {
        const long L = (long)i * G + c; if (L >= nwg) return false;
        int wgid = (int)L; { const int q = nwg / NXCD, r = nwg % NXCD, xcd = wgid % NXCD, off = wgid / NXCD; wgid = (xcd < r ? xcd * (q + 1) : r * (q + 1) + (xcd - r) * q) + off; }
        const int nig = WGM * nN, gid = wgid / nig, fm = gid * WGM, gsz = (nM - fm) < WGM ? (nM - fm) : WGM;
        u.pm = fm + ((wgid % nig) % gsz); u.pn = (wgid % nig) / gsz; return true;
    }
    __device__ __forceinline__ void a_ready(const Unit&) const {}
    __device__ __forceinline__ void done(const Unit&) const {}
};

__device__ __forceinline__ unsigned cvt_pk_bf16(float lo, float hi) { unsigned r; asm volatile("v_cvt_pk_bf16_f32 %0, %1, %2" : "=v"(r) : "v"(lo), "v"(hi)); return r; }
typedef float f32x2 __attribute__((ext_vector_type(2)));
template <int ACT  > struct EpiStoreBf16 {
    static constexpr bool PERM = true, AFTER_DRAIN = false;
    bf16_t* O; int ldc; const float* rope;
    __device__ __forceinline__ void operator()(const f32x4 (&acc)[2][2][4][2], const Unit& u, int wr, int wc, int fr, int fq) const {
        const int row0 = u.pm * BM + wr * 64 + fr; const int col0 = u.pn * BM + wc * 32 + 8 * fq;
        const bool roped = (ACT == 0) && rope != nullptr && u.pm < 64 && u.pn < 3;
#pragma unroll
        for (int ai = 0; ai < 2; ++ai)
#pragma unroll
            for (int m = 0; m < 4; ++m) { const int row = row0 + ai * HALF + m * 16; bf16_t* rowp = O + (size_t)row * ldc + col0;
                f32x4 c0 = {1.f, 1.f, 1.f, 1.f}, c1 = c0, s0 = {0.f, 0.f, 0.f, 0.f}, s1 = s0;
                if (roped) { const int t = row & 4095, pos = (wc & 1) ? (t & 63) : (t >> 6); const float* tp = rope + pos * 16 + 8 * (fq & 1);
                    c0 = *(const f32x4*)tp; c1 = *(const f32x4*)(tp + 4); s0 = *(const f32x4*)(tp + 1024); s1 = *(const f32x4*)(tp + 1028); if (fq < 2) { s0 = -s0; s1 = -s1; } }
#pragma unroll
                for (int bj = 0; bj < 2; ++bj) { f32x4 v0 = acc[ai][bj][m][0], v1 = acc[ai][bj][m][1];
                    if (ACT == 1) {
#pragma unroll
                        for (int j = 0; j < 4; ++j) { const float a = fmaxf(v0[j], 0.f), b = fmaxf(v1[j], 0.f); v0[j] = a * a; v1[j] = b * b; } }
                    if (roped && (u.pn < 2 || bj == 0)) { f32x4 p0, p1;
#pragma unroll
                        for (int j = 0; j < 4; ++j) { p0[j] = __shfl_xor(v0[j], 32); p1[j] = __shfl_xor(v1[j], 32); }
                        v0 = v0 * c0 + p0 * s0; v1 = v1 * c1 + p1 * s1; }
                    u32x4 w; w.x = cvt_pk_bf16(v0[0], v0[1]); w.y = cvt_pk_bf16(v0[2], v0[3]); w.z = cvt_pk_bf16(v1[0], v1[1]); w.w = cvt_pk_bf16(v1[2], v1[3]);
                    *(u32x4*)(rowp + bj * HALF) = w; } }
    }
};
struct EpiResid {
    static constexpr bool PERM = false, AFTER_DRAIN = false;
    float* X; const float* gate; float gs; const float* base_lat; const float* base_ctx;
    __device__ __forceinline__ void operator()(const f32x4 (&acc)[2][2][4][2], const Unit& u, int wr, int wc, int fr, int fq) const {
        const int row0 = u.pm * BM + wr * 64 + fr, col0 = u.pn * BM + wc * 32 + 4 * fq;
        const int b = (u.pm < 64) ? (u.pm >> 4) : 4;
        const float* bl_ = base_lat; const float* bc_ = base_ctx; const float* sbase = (u.pm < 64) ? bl_ : bc_;
        const float* gp = gate + (size_t)b * 12288 + col0;
        f32x4 gv[2][2];
#pragma unroll
        for (int bj = 0; bj < 2; ++bj)
#pragma unroll
            for (int n = 0; n < 2; ++n) gv[bj][n] = *(const f32x4*)(gp + bj * HALF + n * 16) * gs;
#pragma unroll
        for (int ai = 0; ai < 2; ++ai)
#pragma unroll
            for (int m = 0; m < 4; ++m) { const int rr = row0 + ai * HALF + m * 16; float* rowp = X + (size_t)rr * 2048 + col0; const float* srcp = sbase + (size_t)rr * 2048 + col0;
#pragma unroll
                for (int bj = 0; bj < 2; ++bj)
#pragma unroll
                    for (int n = 0; n < 2; ++n) { f32x4 x = *(const f32x4*)(srcp + bj * HALF + n * 16); x = x + gv[bj][n] * acc[ai][bj][m][n]; *(f32x4*)(rowp + bj * HALF + n * 16) = x; }
                if (m & 1) asm volatile("" ::: "memory"); }
    }
};

template <class Epi, class Sched, bool ALIGN_EPI = false, bool SP2 = false>
__device__ __forceinline__ void gemm_phase(PG8_LAS unsigned char* lds, const Gemm g, const Sched& S, const Epi& E) {
    int tid_ = threadIdx.x; asm volatile("" : "+v"(tid_));
    const int tid = tid_, wid = __builtin_amdgcn_readfirstlane(tid >> 6), lane = tid & 63, wr = wid >> 2, wc = wid & 3, fr = lane & 15, fq = lane >> 4;
    const int K = g.K, nt = K / BK;
    unsigned voffA[2], voffB[2];
#pragma unroll
    for (int i = 0; i < 2; ++i) { int R, C; stage_rc(tid * 16 + i * 8192, R, C); const int Rb = Epi::PERM ? ((R & ~31) + perm32(R & 31)) : R;
        voffA[i] = (unsigned)(R * K + C) * 2u; voffB[i] = (unsigned)(Rb * K + C) * 2u; }
    const size_t kstep = (size_t)(BK * 2);
    const size_t hstep = (size_t)HALF * K * 2;
    const size_t tstep = 2 * hstep;
    const unsigned ldsw = (unsigned)wid * 1024u;
    const int aoff = lds_byte(wr * 64 + fr, fq * 8), boff = lds_byte(wc * 32 + fr, fq * 8);
#define PG8_SA(b, h) (((b) * 2 + (h)) * HTB)
#define PG8_SB(b, h) ((4 + (b) * 2 + (h)) * HTB)
#define PG8_STAGE(bufoff, gbase, voff) do { _Pragma("unroll") for (int _i = 0; _i < 2; ++_i) \
        __builtin_amdgcn_global_load_lds((const unsigned*)((const char*)(gbase) + (voff)[_i]), (PG8_LAS unsigned*)(lds + (bufoff) + ldsw + _i * 8192), 16, 0, 0); } while (0)
#define PG8_LDA(dst, b, h) do { _Pragma("unroll") for (int m = 0; m < 4; ++m) _Pragma("unroll") for (int k = 0; k < 2; ++k) dst[m][k] = *(const PG8_LAS bf16x8*)(lds + PG8_SA(b, h) + aoff + m * 2048 + k * 1024); } while (0)
#define PG8_LDB(dst, b, h) do { _Pragma("unroll") for (int n = 0; n < 2; ++n) _Pragma("unroll") for (int k = 0; k < 2; ++k) dst[n][k] = *(const PG8_LAS bf16x8*)(lds + PG8_SB(b, h) + boff + n * 2048 + k * 1024); } while (0)
#define PG8_MMA(ai, bj, At, Bt) do { __builtin_amdgcn_s_setprio(1); _Pragma("unroll") for (int m = 0; m < 4; ++m) _Pragma("unroll") for (int n = 0; n < 2; ++n) _Pragma("unroll") for (int k = 0; k < 2; ++k) \
        acc[ai][bj][m][n] = __builtin_amdgcn_mfma_f32_16x16x32_bf16(Bt[n][k], At[m][k], acc[ai][bj][m][n], 0, 0, 0); __builtin_amdgcn_s_setprio(0); } while (0)
#define PG8_WAIT_V(n) asm volatile("s_waitcnt vmcnt(" #n ")" ::: "memory")
#define PG8_WAIT_L(n) asm volatile("s_waitcnt lgkmcnt(" #n ")" ::: "memory")
#define PG8_BAR __builtin_amdgcn_s_barrier()
#define PG8_SCHED __builtin_amdgcn_sched_barrier(0)
    Unit cur, nxt; int ui = 0;
    if (!S.next(0, cur)) return;
    f32x4 acc[2][2][4][2];
#pragma unroll
    for (int a = 0; a < 2; ++a)
#pragma unroll
        for (int b = 0; b < 2; ++b)
#pragma unroll
            for (int m = 0; m < 4; ++m)
#pragma unroll
                for (int n = 0; n < 2; ++n) acc[a][b][m][n] = (f32x4){0.f, 0.f, 0.f, 0.f};
    bf16x8 At[4][2], B0[2][2], B1[2][2];
    const char* cA = (const char*)g.A + (size_t)cur.pm * tstep; const char* cB = (const char*)g.Bt + (size_t)cur.pn * tstep;
    S.a_ready(cur);
    if constexpr (SP2) {
        PG8_STAGE(PG8_SB(0, 0), cB, voffB); PG8_STAGE(PG8_SB(0, 1), cB + hstep, voffB); PG8_STAGE(PG8_SA(0, 0), cA, voffA); PG8_STAGE(PG8_SA(0, 1), cA + hstep, voffA);
        if (wr == 1) PG8_BAR;
        PG8_WAIT_V(2); PG8_BAR;
        PG8_STAGE(PG8_SB(1, 0), cB + kstep, voffB); PG8_STAGE(PG8_SA(1, 0), cA + kstep, voffA); PG8_STAGE(PG8_SB(1, 1), cB + hstep + kstep, voffB);
        PG8_WAIT_V(6); PG8_BAR;
    } else {
        PG8_STAGE(PG8_SB(0, 0), cB, voffB); PG8_STAGE(PG8_SA(0, 0), cA, voffA); PG8_STAGE(PG8_SB(0, 1), cB + hstep, voffB); PG8_STAGE(PG8_SA(0, 1), cA + hstep, voffA);
        if (wr == 1) PG8_BAR;
        PG8_WAIT_V(4); PG8_BAR;
        PG8_STAGE(PG8_SB(1, 0), cB + kstep, voffB); PG8_STAGE(PG8_SA(1, 0), cA + kstep, voffA); PG8_STAGE(PG8_SB(1, 1), cB + hstep + kstep, voffB);
        PG8_WAIT_V(6); PG8_BAR;
    }
    for (;;) {
        const bool has_next = S.next(ui + 1, nxt);
        const char* nA = has_next ? (const char*)g.A + (size_t)nxt.pm * tstep : cA; const char* nB = has_next ? (const char*)g.Bt + (size_t)nxt.pn * tstep : cB;
        for (int t = 0; t < nt; t += 2) {
            const bool last = (t == nt - 2);
            const char* a1 = cA + (size_t)(t + 1) * kstep;
            const char* a2 = last ? nA : cA + (size_t)(t + 2) * kstep; const char* b2 = last ? nB : cB + (size_t)(t + 2) * kstep;
            const char* a3 = a2 + kstep; const char* b3 = b2 + kstep;
            if (last && has_next) S.a_ready(nxt);
            if constexpr (SP2) {
            PG8_LDB(B0, 0, 0); PG8_LDB(B1, 0, 1); PG8_SCHED; PG8_LDA(At, 0, 0); PG8_STAGE(PG8_SA(1, 1), a1 + hstep, voffA);
            PG8_WAIT_V(8); PG8_WAIT_L(0); PG8_BAR; PG8_MMA(0, 0, At, B0); PG8_MMA(0, 1, At, B1); PG8_BAR; PG8_SCHED;
            PG8_LDA(At, 0, 1); PG8_STAGE(PG8_SB(0, 0), b2, voffB); PG8_STAGE(PG8_SB(0, 1), b2 + hstep, voffB); PG8_STAGE(PG8_SA(0, 0), a2, voffA);
            PG8_WAIT_V(8); PG8_WAIT_L(0); PG8_BAR; PG8_MMA(1, 0, At, B0); PG8_MMA(1, 1, At, B1); PG8_BAR; PG8_SCHED;
            PG8_LDB(B0, 1, 0); PG8_LDB(B1, 1, 1); PG8_SCHED; PG8_LDA(At, 1, 0); PG8_STAGE(PG8_SA(0, 1), a2 + hstep, voffA);
            PG8_WAIT_V(8); PG8_WAIT_L(0); PG8_BAR; PG8_MMA(0, 0, At, B0); PG8_MMA(0, 1, At, B1); PG8_BAR; PG8_SCHED;
            PG8_LDA(At, 1, 1); PG8_STAGE(PG8_SB(1, 0), b3, voffB); PG8_STAGE(PG8_SB(1, 1), b3 + hstep, voffB); PG8_STAGE(PG8_SA(1, 0), a3, voffA);
            PG8_WAIT_V(8); PG8_WAIT_L(0); PG8_BAR; PG8_MMA(1, 0, At, B0); PG8_MMA(1, 1, At, B1); PG8_BAR; PG8_SCHED;
            } else {
            PG8_LDB(B0, 0, 0); PG8_SCHED; PG8_LDA(At, 0, 0); PG8_STAGE(PG8_SA(1, 1), a1 + hstep, voffA);
            PG8_WAIT_L(8); PG8_BAR; PG8_WAIT_L(0); PG8_MMA(0, 0, At, B0); PG8_BAR; PG8_SCHED;
            PG8_LDB(B1, 0, 1); PG8_STAGE(PG8_SB(0, 0), b2, voffB);
            PG8_BAR; PG8_WAIT_L(0); PG8_MMA(0, 1, At, B1); PG8_BAR;
            PG8_LDA(At, 0, 1); PG8_STAGE(PG8_SA(0, 0), a2, voffA);
            PG8_BAR; PG8_WAIT_L(0); PG8_MMA(1, 0, At, B0); PG8_BAR; PG8_SCHED;
            PG8_STAGE(PG8_SB(0, 1), b2 + hstep, voffB);
            PG8_WAIT_V(6); PG8_BAR; PG8_MMA(1, 1, At, B1); PG8_BAR;
            PG8_LDB(B0, 1, 0); PG8_SCHED; PG8_LDA(At, 1, 0); PG8_STAGE(PG8_SA(0, 1), a2 + hstep, voffA);
            PG8_WAIT_L(8); PG8_BAR; PG8_WAIT_L(0); PG8_MMA(0, 0, At, B0); PG8_BAR; PG8_SCHED;
            PG8_LDB(B1, 1, 1); PG8_STAGE(PG8_SB(1, 0), b3, voffB);
            PG8_BAR; PG8_WAIT_L(0); PG8_MMA(0, 1, At, B1); PG8_BAR;
            PG8_LDA(At, 1, 1); PG8_STAGE(PG8_SA(1, 0), a3, voffA);
            PG8_BAR; PG8_WAIT_L(0); PG8_MMA(1, 0, At, B0); PG8_BAR; PG8_SCHED;
            PG8_STAGE(PG8_SB(1, 1), b3 + hstep, voffB);
            PG8_WAIT_V(6); PG8_BAR; PG8_MMA(1, 1, At, B1); PG8_BAR;
            }
        }
        if constexpr (ALIGN_EPI) { if (wr == 0) PG8_BAR; }
        if constexpr (!Epi::AFTER_DRAIN) { E(acc, cur, wr, wc, fr, fq); S.done(cur); }
        if (!has_next) break;
#pragma unroll
        for (int a = 0; a < 2; ++a)
#pragma unroll
            for (int b = 0; b < 2; ++b)
#pragma unroll
                for (int m = 0; m < 4; ++m)
#pragma unroll
                    for (int n = 0; n < 2; ++n) acc[a][b][m][n] = (f32x4){0.f, 0.f, 0.f, 0.f};
        cur = nxt; cA = nA; cB = nB; ++ui;
        if constexpr (ALIGN_EPI) { if (wr == 1) PG8_BAR; }
    }
    PG8_WAIT_V(0);
    if constexpr (!ALIGN_EPI) { if (wr == 0) PG8_BAR; }
    PG8_BAR;
    if constexpr (Epi::AFTER_DRAIN) { E.fused(acc, cur, wr, wc, fr, fq, lds, wid, lane); S.done(cur); }
#undef PG8_SA
#undef PG8_SB
#undef PG8_STAGE
#undef PG8_LDA
#undef PG8_LDB
#undef PG8_MMA
#undef PG8_WAIT_V
#undef PG8_WAIT_L
#undef PG8_BAR
#undef PG8_SCHED
}
}
#define GAS __attribute__((address_space(1)))
#define LAS __attribute__((address_space(3)))
typedef unsigned short bf16;
typedef unsigned v4u __attribute__((ext_vector_type(4)));
typedef float f32x4 __attribute__((ext_vector_type(4)));
typedef short bf16x8 __attribute__((ext_vector_type(8)));
typedef GAS unsigned gu32;
typedef GAS unsigned long long gu64;
#define RLX_AGENT __ATOMIC_RELAXED, __HIP_MEMORY_SCOPE_AGENT
#define LDS_WAIT() asm volatile("s_waitcnt lgkmcnt(0)" ::: "memory")
#define VM_WAIT() asm volatile("s_waitcnt vmcnt(0)" ::: "memory")
__device__ __forceinline__ unsigned long long rt() { return __builtin_amdgcn_s_memrealtime(); }
__device__ __forceinline__ unsigned f2bf(float f) { unsigned u = __builtin_bit_cast(unsigned, f); return (u + 0x7fffu + ((u >> 16) & 1u)) >> 16; }
__device__ __forceinline__ unsigned pk2(float lo, float hi) { unsigned r; asm("v_cvt_pk_bf16_f32 %0, %1, %2" : "=v"(r) : "v"(lo), "v"(hi)); return r; }
#define XB_TMO      128
#define XB_XCNT(j)  (256  + 64 * (j))
#define XB_XSUB(j)  (1280 + 64 * (j))
#define XB_XGEN(j)  (2304 + 64 * (j))
#define XB_TOP      3328
#define XB_TOPGEN   3392
#define XCD_BAR_WORDS 3456
#define XB_SPIN_CAP (1u << 18)

__device__ __forceinline__ unsigned xb_ld(unsigned* p)              { return __hip_atomic_load(p, __ATOMIC_RELAXED, __HIP_MEMORY_SCOPE_AGENT); }
__device__ __forceinline__ unsigned xb_add(unsigned* p, unsigned v) { return __hip_atomic_fetch_add(p, v, __ATOMIC_RELAXED, __HIP_MEMORY_SCOPE_AGENT); }
__device__ __forceinline__ unsigned xb_xcc_id() { return (unsigned)__builtin_amdgcn_s_getreg((3 << 11) | 20) & 0xFu; }
#define XB_SPIN(cond, bar) do { unsigned _sp = 0; while (cond) { __builtin_amdgcn_s_sleep(1); \
    if ((++_sp & 255u) == 0u) { if (xb_ld(&(bar)[XB_TMO])) break; if (_sp > XB_SPIN_CAP) { atomicAdd(&(bar)[XB_TMO], 1u); break; } } } } while (0)

struct XcdBarrier {
    unsigned* bar; unsigned x;
    volatile LAS unsigned* st;
};

__device__ __forceinline__ XcdBarrier xcd_barrier_post(unsigned* bar, volatile LAS unsigned* st) {
    XcdBarrier b; b.bar = bar; b.x = xb_xcc_id(); b.st = st;
    if (threadIdx.x == 0) (void)xb_add(&bar[XB_XCNT(b.x)], 1u);
    return b;
}
__device__ __forceinline__ void xcd_barrier_complete(unsigned* bar, unsigned x, unsigned& nloc, unsigned& nx) {
    const unsigned G = gridDim.x * gridDim.y * gridDim.z;
    unsigned sum, cnt, mine, sp = 0u;
    for (;;) {
        sum = 0u; cnt = 0u; mine = 0u;
#pragma unroll
        for (unsigned j = 0; j < 16; ++j) { const unsigned c = xb_ld(&bar[XB_XCNT(j)]); sum += c; cnt += (c > 0u) ? 1u : 0u; mine = (j == x) ? c : mine; }
        if (sum == G) break;
        __builtin_amdgcn_s_sleep(1);
        if ((++sp & 255u) == 0u) { if (xb_ld(&bar[XB_TMO])) break; if (sp > XB_SPIN_CAP) { atomicAdd(&bar[XB_TMO], 1u); break; } }
    }
    nloc = mine > 0u ? mine : 1u; nx = cnt > 0u ? cnt : 1u;
}

__device__ __forceinline__ void xcd_barrier(const XcdBarrier& b) {
    asm volatile("s_waitcnt vmcnt(0)" ::: "memory");
    __syncthreads();
    if (threadIdx.x == 0) {
        unsigned* bar = b.bar; unsigned bx = b.x; asm volatile("" : "+s"(bar), "+s"(bx));
        __builtin_amdgcn_s_waitcnt(0);
        unsigned nloc = b.st[0], nx = b.st[1];
        if (nloc == 0u) { xcd_barrier_complete(bar, bx, nloc, nx); b.st[0] = nloc; b.st[1] = nx; }
        const unsigned old = xb_add(&bar[XB_XSUB(bx)], 1u);
        const unsigned gen = old / nloc;
        if (old + 1u == (gen + 1u) * nloc) {
            __builtin_amdgcn_fence(__ATOMIC_RELEASE, "agent");
            asm volatile("s_waitcnt vmcnt(0)" ::: "memory");
            const unsigned og = xb_add(&bar[XB_TOP], 1u);
            const unsigned tg = og / nx;
            if (og + 1u == (tg + 1u) * nx) xb_add(&bar[XB_TOPGEN], 1u);
            else XB_SPIN(xb_ld(&bar[XB_TOPGEN]) == tg, bar);
            __builtin_amdgcn_fence(__ATOMIC_ACQUIRE, "agent");
            xb_add(&bar[XB_XGEN(bx)], 1u);
            asm volatile("s_waitcnt vmcnt(0)" ::: "memory");
        } else {
            XB_SPIN(xb_ld(&bar[XB_XGEN(bx)]) == gen, bar);
            __builtin_amdgcn_fence(__ATOMIC_ACQUIRE, "agent");
            asm volatile("s_waitcnt vmcnt(0)" ::: "memory");
        }
    }
    __syncthreads();
}

constexpr int DM = 2048, NB = 4, SEQ = 4096, LC = 256, DEPTH = 4, DFF = 8192;
constexpr int M_LAT = NB * SEQ, M_CTX = NB * LC, M_ALL = M_LAT + M_CTX;
constexpr int N_IN = 5392, N_INP = 5632;
constexpr int OFF_HY = 768, OFF_NA = 2304, OFF_SSM = 3840;
constexpr int NWAVES = 8, NTHR = 512;
constexpr float EPS = 1e-6f;

constexpr size_t MiB = 1u << 20;
constexpr size_t WS_CTL = 0, CTL_ZERO_BYTES = 1 * MiB;
constexpr size_t WS_MOD = 1 * MiB;
constexpr size_t WS_MODP = 2 * MiB;
constexpr size_t WS_ROPE = 10 * MiB;
constexpr size_t WS_GLAT = 11 * MiB;
constexpr size_t WS_GCTX = 43 * MiB;
constexpr size_t WS_GCTX1 = 28 * MiB;
constexpr size_t WS_W4T = 46 * MiB;
constexpr size_t WS_W = 48 * MiB;
constexpr size_t W_LAYER = 94 * MiB, W_OUT_OFF = 22 * MiB, W_1_OFF = 30 * MiB, W_2_OFF = 62 * MiB;
constexpr size_t WS_X = 424 * MiB;
constexpr size_t WS_XN = 560 * MiB;
constexpr size_t WS_P = 628 * MiB;
constexpr size_t WS_Y = 815 * MiB;
constexpr size_t WS_H = 883 * MiB;
constexpr size_t WS_XBC = 1155 * MiB;
constexpr size_t WS_XBCT = WS_XBC + 34 * MiB;
constexpr size_t WS_DT = 1223 * MiB;
constexpr size_t WS_YF = 1226 * MiB;
constexpr size_t WS_HIN = WS_YF;
constexpr size_t WS_YB = 1260 * MiB;
constexpr size_t WS_CD = WS_YB;
constexpr size_t WS_HU = 1294 * MiB;
constexpr size_t WS_SST = WS_HU;
constexpr size_t WS_Z = 1396 * MiB;
constexpr size_t WS_HUT = 1430 * MiB;
constexpr size_t WS_YT = 1478 * MiB;
constexpr size_t WS_GT = WS_GLAT;
constexpr size_t WS_VT = 1494 * MiB;
constexpr size_t WS_END = 1516 * MiB;
constexpr int CW_BAR = 4096;

constexpr int RING_BYTES = 131072, MISC_OFF = 147456, LDS_BYTES = MISC_OFF + 1024;

constexpr int PH_PRO1 = 0, PH_PRO2 = 1, PH_L0 = 2, PH_PER_LAYER = 10, PH_FINAL = PH_L0 + DEPTH * PH_PER_LAYER, N_PHASES = PH_FINAL + 1;
#ifndef PROBE_REP
#define PROBE_REP -1
#endif
#ifndef MK_SPLIT
#define MK_SPLIT 0
#endif

__device__ __forceinline__ float bf2f(bf16 h) { return __uint_as_float(((unsigned)h) << 16); }
__device__ __forceinline__ float wave_sum(float v) {
#pragma unroll
    for (int o = 1; o < 64; o <<= 1) v += __shfl_xor(v, o);
    return v;
}
__device__ __forceinline__ float wave_max(float v) {
#pragma unroll
    for (int o = 1; o < 64; o <<= 1) v = fmaxf(v, __shfl_xor(v, o));
    return v;
}
__device__ __forceinline__ float silu_f(float v) { return v / (1.f + __expf(-v)); }

struct Ctx {
    LAS unsigned char* lds;
    int tid, lane, wave, G, gw, NGW, bid;
};
__device__ __forceinline__ void launder(Ctx& C) { int t = threadIdx.x, bx = blockIdx.x, gx = gridDim.x; asm volatile("" : "+v"(t), "+s"(bx), "+s"(gx));
    C.tid = t; C.lane = t & 63; C.wave = __builtin_amdgcn_readfirstlane(t >> 6); C.bid = bx; C.G = gx; C.gw = bx * NWAVES + C.wave; C.NGW = gx * NWAVES; }
struct Args { const float* in[32]; float* out; unsigned char* ws; int ph_lo, ph_hi; };
typedef const Args __attribute__((address_space(4))) KArgs;

__device__ __forceinline__ void transpose_item(const float* W, int K, int N, bf16* WT, LAS float* scr, int kb, int nb, int lane) {
    const int k0 = 64 * kb, n0 = 64 * nb;
    const int nn = n0 + lane; const bool okn = nn < N;
    float tv[64];
#pragma unroll
    for (int i = 0; i < 64; ++i) tv[i] = okn ? W[(size_t)(k0 + i) * N + nn] : 0.f;
#pragma unroll
    for (int i = 0; i < 64; ++i) scr[i * 65 + lane] = tv[i];
    LDS_WAIT(); asm volatile("" ::: "memory");
    const int c = lane & 7;
#pragma unroll
    for (int j = 0; j < 8; ++j) { const int n = (lane >> 3) + 8 * j; const LAS float* s = scr + (8 * c) * 65 + n;
        v4u o; o.x = pk2(s[0 * 65], s[1 * 65]); o.y = pk2(s[2 * 65], s[3 * 65]); o.z = pk2(s[4 * 65], s[5 * 65]); o.w = pk2(s[6 * 65], s[7 * 65]);
        *(v4u*)(WT + (size_t)(n0 + n) * K + k0 + 8 * c) = o; }
    LDS_WAIT(); asm volatile("" ::: "memory");
}

__device__ __forceinline__ void phase_pro1(const Ctx& C, KArgs& A) {
    LAS float* sl = (LAS float*)C.lds;
    const float* cvec = A.in[1]; const float* cctx = A.in[3]; const float* ada_w = A.in[4];
    float* modp = (float*)(A.ws + WS_MODP);
    for (int sr = 0; sr < ((PROBE_REP == 43) ? 2 : 1); ++sr)
    for (int u = C.bid; u < 768; u += C.G) {
        const int layer = u / 192, r = u % 192, kc = r / 24, nb = r % 24;
        __syncthreads();
        for (int i = C.tid; i < 5 * 256; i += NTHR) { const int b = i >> 8, kk = i & 255, k = kc * 256 + kk; const float v = (b < 4) ? cvec[b * DM + k] : cctx[k]; sl[i] = v / (1.f + expf(-v)); }
        __syncthreads();
        const int n = nb * 512 + C.tid; const float* w = ada_w + ((size_t)layer * DM + kc * 256) * 12288 + n;
        float a0 = 0.f, a1 = 0.f, a2 = 0.f, a3 = 0.f, a4 = 0.f;
#pragma unroll 8
        for (int kk = 0; kk < 256; ++kk) { const float wv = w[(size_t)kk * 12288]; a0 += sl[kk] * wv; a1 += sl[256 + kk] * wv; a2 += sl[512 + kk] * wv; a3 += sl[768 + kk] * wv; a4 += sl[1024 + kk] * wv; }
        float* o = modp + ((size_t)(kc * 4 + layer) * 5) * 12288 + n;
        o[0] = a0; o[12288] = a1; o[2 * 12288] = a2; o[3 * 12288] = a3; o[4 * 12288] = a4;
    }
    __syncthreads();
    if (C.bid == 0) { float* rc = (float*)(A.ws + WS_ROPE); float* rs = rc + 1024;
        for (int i = C.tid; i < 1024; i += NTHR) { const int pos = i >> 4, j = i & 15; const float inv = powf(10000.f, -(float)j / 16.f); const float ang = (float)pos * inv; rc[i] = cosf(ang); rs[i] = sinf(ang); } }
    { const float* w4 = A.in[19]; bf16* w4t = (bf16*)(A.ws + WS_W4T);
      for (int i = C.bid * NTHR + C.tid; i < DEPTH * 2048; i += C.G * NTHR) { const int layer = i >> 11, n = i & 2047; const float* s = w4 + (size_t)layer * 64 * 2048 + n; v4u* d = (v4u*)(w4t + (size_t)i * 64);
#pragma unroll
          for (int q = 0; q < 8; ++q) { v4u o; o.x = pk2(s[(8 * q + 0) * 2048], s[(8 * q + 1) * 2048]); o.y = pk2(s[(8 * q + 2) * 2048], s[(8 * q + 3) * 2048]); o.z = pk2(s[(8 * q + 4) * 2048], s[(8 * q + 5) * 2048]); o.w = pk2(s[(8 * q + 6) * 2048], s[(8 * q + 7) * 2048]); d[q] = o; } } }
    LAS float* scr = (LAS float*)(C.lds + C.wave * 16896);
    constexpr int I_IN = 32 * 88, I_OUT = 32 * 32, I_1 = 32 * 128, I_2 = 128 * 32, I_LAYER = I_IN + I_OUT + I_1 + I_2;
    for (int it = C.gw; it < DEPTH * I_LAYER; it += C.NGW) {
        const int layer = it / I_LAYER; int r = it % I_LAYER;
        bf16* wl = (bf16*)(A.ws + WS_W + (size_t)layer * W_LAYER);
        if (r < I_IN) { transpose_item(A.in[8] + (size_t)layer * DM * N_IN, DM, N_IN, wl, scr, r / 88, r % 88, C.lane); continue; } r -= I_IN;
        if (r < I_OUT) { transpose_item(A.in[9] + (size_t)layer * DM * DM, DM, DM, (bf16*)((unsigned char*)wl + W_OUT_OFF), scr, r / 32, r % 32, C.lane); continue; } r -= I_OUT;
        if (r < I_1) { transpose_item(A.in[29] + (size_t)layer * DM * DFF, DM, DFF, (bf16*)((unsigned char*)wl + W_1_OFF), scr, r / 128, r % 128, C.lane); continue; } r -= I_1;
        transpose_item(A.in[30] + (size_t)layer * DFF * DM, DFF, DM, (bf16*)((unsigned char*)wl + W_2_OFF), scr, r / 32, r % 32, C.lane);
    }
}
__device__ __forceinline__ void phase_pro2(const Ctx& C, KArgs& A) {
    const float* modp = (const float*)(A.ws + WS_MODP); const float* ada_b = A.in[5]; float* mod = (float*)(A.ws + WS_MOD);
    for (int i = C.bid * NTHR + C.tid; i < DEPTH * 5 * 12288; i += C.G * NTHR) {
        const int layer = i / (5 * 12288), r = i % (5 * 12288), n = r % 12288;
        float s = ada_b[layer * 12288 + n];
#pragma unroll
        for (int kc = 0; kc < 8; ++kc) s += modp[(size_t)(kc * 4 + layer) * 5 * 12288 + r];
        mod[i] = s;
    }
}

__device__ __forceinline__ void norm_row_v(const f32x4 (&v)[8], const float* nw, const float* sh, const float* sc, bf16* orow, int lane) {
    float s = 0.f;
#pragma unroll
    for (int j = 0; j < 8; ++j) s += (v[j].x * v[j].x + v[j].y * v[j].y) + (v[j].z * v[j].z + v[j].w * v[j].w);
    const float rstd = 1.0f / sqrtf(wave_sum(s) * (1.f / DM) + EPS);
#pragma unroll
    for (int j = 0; j < 8; ++j) { const int c4 = lane + 64 * j; const f32x4 w = ((const f32x4*)nw)[c4], a = ((const f32x4*)sc)[c4], b = ((const f32x4*)sh)[c4];
        const f32x4 y = v[j] * rstd * w * (a + 1.0f) + b;
        *(unsigned long long*)(orow + 4 * c4) = (unsigned long long)pk2(y.x, y.y) | ((unsigned long long)pk2(y.z, y.w) << 32); }
}
__device__ __forceinline__ const float* norm_src(KArgs& A, int layer, int which, int m) {
    return (layer == 0 && which == 0) ? ((m < M_LAT) ? A.in[0] + (size_t)m * DM : A.in[2] + (size_t)(m - M_LAT) * DM) : (const float*)(A.ws + WS_X) + (size_t)m * DM;
}
__device__ __forceinline__ void phase_norm(const Ctx& C, KArgs& A, int layer, int which  , int row_lo, int row_hi, int gw, int ngw) {
    bf16* XN = (bf16*)(A.ws + WS_XN);
    const float* nw = A.in[which ? 7 : 6] + layer * DM;
    const float* mod = (const float*)(A.ws + WS_MOD) + (size_t)layer * 5 * 12288 + (which ? 3 * DM : 0);
    int m = row_lo + gw; f32x4 cur[8];
    if (m < row_hi) { const f32x4* xr = (const f32x4*)norm_src(A, layer, which, m);
#pragma unroll
        for (int j = 0; j < 8; ++j) cur[j] = xr[C.lane + 64 * j]; }
    while (m < row_hi) { const int mn = m + ngw; f32x4 nxt[8];
        if (mn < row_hi) { const f32x4* xr = (const f32x4*)norm_src(A, layer, which, mn);
#pragma unroll
            for (int j = 0; j < 8; ++j) nxt[j] = xr[C.lane + 64 * j]; }
        const int b = (m < M_LAT) ? (m >> 12) : 4; const float* mb = mod + (size_t)b * 12288;
        norm_row_v(cur, nw, mb, mb + DM, XN + (size_t)m * DM, C.lane);
#pragma unroll
        for (int j = 0; j < 8; ++j) cur[j] = nxt[j];
        m = mn; }
}
__device__ __forceinline__ void phase_final(const Ctx& C, KArgs& A) {
    const float* X = (const float*)(A.ws + WS_X); const float* nw = A.in[31];
    int m = C.gw; f32x4 cur[8];
    if (m < M_LAT) { const f32x4* xr = (const f32x4*)(X + (size_t)m * DM);
#pragma unroll
        for (int j = 0; j < 8; ++j) cur[j] = xr[C.lane + 64 * j]; }
    while (m < M_LAT) { const int mn = m + C.NGW; f32x4 nxt[8];
        if (mn < M_LAT) { const f32x4* xr = (const f32x4*)(X + (size_t)mn * DM);
#pragma unroll
            for (int j = 0; j < 8; ++j) nxt[j] = xr[C.lane + 64 * j]; }
        float s = 0.f;
#pragma unroll
        for (int j = 0; j < 8; ++j) s += (cur[j].x * cur[j].x + cur[j].y * cur[j].y) + (cur[j].z * cur[j].z + cur[j].w * cur[j].w);
        const float rstd = 1.0f / sqrtf(wave_sum(s) * (1.f / DM) + EPS);
        f32x4* o = (f32x4*)(A.out + (size_t)m * DM);
#pragma unroll
        for (int j = 0; j < 8; ++j) { const int c4 = C.lane + 64 * j; o[c4] = cur[j] * rstd * ((const f32x4*)nw)[c4]; }
#pragma unroll
        for (int j = 0; j < 8; ++j) cur[j] = nxt[j];
        m = mn; }
}

__device__ __forceinline__ float hy_filter_hidden(const Ctx& C, KArgs& A, int layer, int L, int t) {
    const int lane = C.lane;
    const float* w1 = A.in[13] + layer * 33 * 64; const float* b1 = A.in[14] + layer * 64; const float* w2 = A.in[15] + layer * 4096; const float* b2 = A.in[16] + layer * 64;
    const float* w3 = A.in[17] + layer * 4096; const float* b3 = A.in[18] + layer * 64; const float* fr = A.in[20] + layer * 64;
    const float tl = (float)t / (float)(L - 1);
    const float wpos = (6.283185307179586f * (float)t) / (float)L;
    float z = 0.f;
    if (lane == 0) z = tl;
    else if (lane <= 32) { const int k = (lane - 1) & 15; const float f = 1e-4f + (float)k * ((15.0f - 1e-4f) / 15.0f); const float a = f * wpos; z = (lane <= 16) ? cosf(a) : -sinf(a); }
    const float frl = fr[lane];
    float pre = b1[lane];
    for (int e = 0; e < 33; ++e) pre += __shfl(z, e) * w1[e * 64 + lane];
    float h = sinf(frl * pre);
    pre = b2[lane];
    for (int i = 0; i < 64; ++i) pre += __shfl(h, i) * w2[i * 64 + lane];
    h = sinf(frl * pre);
    pre = b3[lane];
    for (int i = 0; i < 64; ++i) pre += __shfl(h, i) * w3[i * 64 + lane];
    return sinf(frl * pre);
}
__device__ __forceinline__ void hy_filter_core(const Ctx& C, KArgs& A, int layer, int L, int t, float (&acc)[32]) {
    const int lane = C.lane; const float* w4 = A.in[19] + (size_t)layer * 64 * 2048;
    const float tl = (float)t / (float)(L - 1);
    const float h = hy_filter_hidden(C, A, layer, L, t);
#pragma unroll
    for (int cc = 0; cc < 32; ++cc) acc[cc] = 0.f;
    for (int i = 0; i < 64; ++i) { const float hi = __shfl(h, i); const float* wr = w4 + (size_t)i * 2048 + lane;
#pragma unroll
        for (int cc = 0; cc < 32; ++cc) acc[cc] += hi * wr[cc * 64]; }
    const float dmin = 3.0701134573253945f, dmax = 15.350567286626973f;
#pragma unroll
    for (int cc = 0; cc < 32; ++cc) { const int c = (cc * 64 + lane) & 511; const float delta = dmin + (float)c * ((dmax - dmin) / 511.0f); acc[cc] *= expf(-tl * delta); }
}
__device__ __forceinline__ void hy_filter_item(const Ctx& C, KArgs& A, int layer, int L, int t, float* G) {
    float acc[32]; hy_filter_core(C, A, layer, L, t, acc);
    const float* skip = A.in[21] + layer * 1024; const int W = 2 * L - 1, lane = C.lane;
#pragma unroll
    for (int cc = 0; cc < 32; ++cc) { const int col = cc * 64 + lane, o = col >> 10, r = (col >> 9) & 1, c = col & 511;
        float val = acc[cc];
        if (r == 0) { if (t == 0) val += skip[o * 512 + c]; G[((size_t)o * W + (L - 1 + t)) * 512 + c] = val; }
        else if (t > 0) G[((size_t)o * W + (L - 1 - t)) * 512 + c] = val; }
}
template <int L>
__device__ __forceinline__ void hy_filter_unit16(const Ctx& C, KArgs& A, int layer, int t0, void* Gout) {
    LAS bf16* H3 = (LAS bf16*)C.lds;
    __syncthreads();
#pragma unroll 1
    for (int q = 0; q < 2; ++q) { const int pi = 2 * C.wave + q; const float h = hy_filter_hidden(C, A, layer, L, t0 + pi); H3[pi * 64 + C.lane] = (bf16)f2bf(h); }
    __syncthreads();
    int lane = C.lane; asm volatile("" : "+v"(lane));
    const int li = lane & 15, g = lane >> 4, tq = t0 + 4 * g;
    const bf16x8 ha0 = *(const LAS bf16x8*)(H3 + li * 64 + 8 * g), ha1 = *(const LAS bf16x8*)(H3 + li * 64 + 32 + 8 * g);
    const bf16* w4t = (const bf16*)(A.ws + WS_W4T) + (size_t)layer * 2048 * 64; const float* skip = A.in[21] + layer * 1024;
    const float dmin = 3.0701134573253945f, dmax = 15.350567286626973f, inv = 1.0f / (float)(L - 1);
#pragma unroll 2
    for (int i = 0; i < 16; ++i) { const int n = 16 * (C.wave * 16 + i) + li;
        const bf16* wr = w4t + (size_t)n * 64 + 8 * g;
        f32x4 acc = __builtin_amdgcn_mfma_f32_16x16x32_bf16(ha0, *(const bf16x8*)wr, (f32x4){0.f, 0.f, 0.f, 0.f}, 0, 0, 0);
        acc = __builtin_amdgcn_mfma_f32_16x16x32_bf16(ha1, *(const bf16x8*)(wr + 32), acc, 0, 0, 0);
        const int o = n >> 10, dir = (n >> 9) & 1, c = n & 511; const float delta = dmin + (float)c * ((dmax - dmin) / 511.0f);
        float v[4];
#pragma unroll
        for (int r = 0; r < 4; ++r) v[r] = acc[r] * expf(-((float)(tq + r) * inv) * delta);
        if (dir == 0 && tq == 0) v[0] += skip[o * 512 + c];
        if (L == SEQ) { bf16* gp = (bf16*)Gout + ((size_t)(o * 512 + c)) * 8192 + (dir ? 0 : 4096) + tq;
            *(unsigned long long*)gp = (unsigned long long)pk2(v[0], v[1]) | ((unsigned long long)pk2(v[2], v[3]) << 32); }
        else { float* gq = (float*)Gout + (size_t)o * (2 * L - 1) * 512 + c;
#pragma unroll
            for (int r = 0; r < 4; ++r) { const int t = tq + r; if (dir == 0) gq[(size_t)(L - 1 + t) * 512] = v[r]; else if (t > 0) gq[(size_t)(L - 1 - t) * 512] = v[r]; } } }
}

constexpr int HY_CP_STRIDE = 16384 + 64;
constexpr int HY_U_OFF = 4 * HY_CP_STRIDE;
constexpr int HY_U_PITCH = 8992;
struct HyF { v4u w0, w1; };
__device__ __forceinline__ void hy_load_filter(HyF& f, const bf16* grow, int tid) { const v4u* gp = (const v4u*)(grow + 16 * tid); f.w0 = gp[0]; f.w1 = gp[1]; }
__device__ __forceinline__ void hy_store_filter(LAS unsigned char* lds, const HyF& f, int tid) {
    const v4u w0 = f.w0, w1 = f.w1;
    unsigned e[16];
    e[0] = w0.x & 0xffffu; e[1] = w0.x >> 16; e[2] = w0.y & 0xffffu; e[3] = w0.y >> 16; e[4] = w0.z & 0xffffu; e[5] = w0.z >> 16; e[6] = w0.w & 0xffffu; e[7] = w0.w >> 16;
    e[8] = w1.x & 0xffffu; e[9] = w1.x >> 16; e[10] = w1.y & 0xffffu; e[11] = w1.y >> 16; e[12] = w1.z & 0xffffu; e[13] = w1.z >> 16; e[14] = w1.w & 0xffffu; e[15] = w1.w >> 16;
#pragma unroll
    for (int j = 0; j < 16; ++j) { const int i = 16 * tid + j, x = (i >= 4096) ? 8191 - i : (i == 0 ? 8191 : 4095 + i); const bf16 val = (i == 0) ? (bf16)0 : (bf16)e[j];
#pragma unroll
        for (int k = 0; k < 4; ++k) { const int y = x - k; if (y >= 0) *(LAS bf16*)(lds + k * HY_CP_STRIDE + 2 * y) = val; } }
}
__device__ __forceinline__ void hy_load_u(v4u (&u)[4], const bf16* src, int tid) {
#pragma unroll
    for (int q = 0; q < 4; ++q) u[q] = ((const v4u*)src)[tid + 512 * q];
}
__device__ __forceinline__ void hy_store_u(LAS unsigned char* lds, const v4u (&u)[4], int tid) {
#pragma unroll
    for (int q = 0; q < 4; ++q) { const int idx = tid + 512 * q, el = 8 * idx, b = el >> 12, s = el & 4095; *(LAS v4u*)(lds + HY_U_OFF + b * HY_U_PITCH + 384 + 2 * s) = u[q]; }
    if (tid < 192) { const int b = tid / 48, r = tid % 48, side = r / 24, off = (r % 24) * 16; unsigned z0 = 0u; asm volatile("" : "+v"(z0)); v4u zz; zz.x = z0; zz.y = z0; zz.z = z0; zz.w = z0;
        *(LAS v4u*)(lds + HY_U_OFF + b * HY_U_PITCH + (side ? 384 + 8192 : 0) + off) = zz; }
}
__device__ __forceinline__ void hy_conv_mfma(LAS unsigned char* lds, f32x4 (&acc)[2][4], int wave, int lane) {
    typedef unsigned long long u64;
    const int wm = wave & 1, wn = wave >> 1, r = lane & 15, g = lane >> 4;
    const int kcp = (4095 - r) & 3;
    const int abase = kcp * HY_CP_STRIDE + 2 * (4095 - r - kcp + 8 * g) - 64 * wm;
    const int bbase = HY_U_OFF + (lane & 3) * HY_U_PITCH + 384 + 2 * (64 * (16 * wn + ((lane & 15) >> 2)) + 8 * g);
#pragma unroll 1
    for (int rho = 0; rho < 4; ++rho) {
        bf16x8 ring[4][2];
#pragma unroll 1
        for (int jq = 0; jq < 5; ++jq) {
#pragma unroll
            for (int k = 0; k < 4; ++k) {
                const int Dp = -63 + rho + 4 * (4 * jq + k);
                if (Dp <= 15) {
                    const int D = 16 * wn + Dp;
                    if (Dp <= 3) {
#pragma unroll
                        for (int kk = 0; kk < 2; ++kk) ring[k][kk] = *(const LAS bf16x8*)(lds + bbase - 128 * D + 64 * kk); }
                    bf16x8 af[2][2];
#pragma unroll
                    for (int m = 0; m < 2; ++m)
#pragma unroll
                        for (int kk = 0; kk < 2; ++kk) { const LAS u64* ap = (const LAS u64*)(lds + abase - 128 * D - 32 * m + 64 * kk); union { u64 q[2]; bf16x8 v; } cv; cv.q[0] = ap[0]; cv.q[1] = ap[1]; af[m][kk] = cv.v; }
#pragma unroll
                    for (int kk = 0; kk < 2; ++kk)
#pragma unroll
                        for (int nt = 0; nt < 4; ++nt) { const int e = Dp - 4 * nt;
                            if (e >= -63 && e <= 3) {
#pragma unroll
                                for (int m = 0; m < 2; ++m) acc[m][nt] = __builtin_amdgcn_mfma_f32_16x16x32_bf16(af[m][kk], ring[(k - nt) & 3][kk], acc[m][nt], 0, 0, 0); } }
                }
            }
        }
    }
}
__device__ __forceinline__ void hy_fast_units(const Ctx& C, KArgs& A) {
    LAS unsigned char* lds = C.lds;
    const bf16* GT = (const bf16*)(A.ws + WS_GT); const bf16* HUT = (const bf16*)(A.ws + WS_HUT); bf16* YT = (bf16*)(A.ws + WS_YT);
    int tid = C.tid; asm volatile("" : "+v"(tid));
    const int wave = C.wave, lane = tid & 63, wm = wave & 1, wn = wave >> 1, g = lane >> 4, bb = lane & 3, il = (lane & 15) >> 2;
    int c = C.bid; if (c >= 512) return;
    HyF fa; v4u ua[4];
    hy_load_filter(fa, GT + (size_t)c * 8192, tid); hy_load_u(ua, HUT + ((size_t)(2 * 512 + c)) * M_LAT, tid);
    while (c < 512) {
        const int cn = c + C.G;
        __syncthreads();
        hy_store_filter(lds, fa, tid); hy_store_u(lds, ua, tid);
        HyF fb; hy_load_filter(fb, GT + (size_t)(512 + c) * 8192, tid);
        unsigned long long xg[2][4];
        { const bf16* x1 = HUT + (size_t)c * M_LAT + bb * SEQ;
#pragma unroll
          for (int m = 0; m < 2; ++m)
#pragma unroll
              for (int nt = 0; nt < 4; ++nt) xg[m][nt] = *(const unsigned long long*)(x1 + 64 * (16 * wn + 4 * nt + il) + 16 * (2 * wm + m) + 4 * g); }
        __syncthreads();
        f32x4 acc[2][4];
#pragma unroll
        for (int m = 0; m < 2; ++m)
#pragma unroll
            for (int nt = 0; nt < 4; ++nt) acc[m][nt] = (f32x4){0.f, 0.f, 0.f, 0.f};
        hy_conv_mfma(lds, acc, wave, lane);
        __syncthreads();
#pragma unroll
        for (int m = 0; m < 2; ++m)
#pragma unroll
            for (int nt = 0; nt < 4; ++nt) { const int t = 64 * (16 * wn + 4 * nt + il) + 16 * (2 * wm + m) + 4 * g;
                const unsigned lo = (unsigned)xg[m][nt], hi = (unsigned)(xg[m][nt] >> 32);
                const float z0 = __uint_as_float(lo << 16) * acc[m][nt][0], z1 = __uint_as_float(lo & 0xffff0000u) * acc[m][nt][1], z2 = __uint_as_float(hi << 16) * acc[m][nt][2], z3 = __uint_as_float(hi & 0xffff0000u) * acc[m][nt][3];
                *(LAS unsigned long long*)(lds + HY_U_OFF + bb * HY_U_PITCH + 384 + 2 * t) = (unsigned long long)pk2(z0, z1) | ((unsigned long long)pk2(z2, z3) << 32); }
        hy_store_filter(lds, fb, tid);
        { const bf16* x2 = HUT + ((size_t)(512 + c)) * M_LAT + bb * SEQ;
#pragma unroll
          for (int m = 0; m < 2; ++m)
#pragma unroll
              for (int nt = 0; nt < 4; ++nt) xg[m][nt] = *(const unsigned long long*)(x2 + 64 * (16 * wn + 4 * nt + il) + 16 * (2 * wm + m) + 4 * g); }
        if (cn < 512) { hy_load_filter(fa, GT + (size_t)cn * 8192, tid); hy_load_u(ua, HUT + ((size_t)(2 * 512 + cn)) * M_LAT, tid); }
        __syncthreads();
#pragma unroll
        for (int m = 0; m < 2; ++m)
#pragma unroll
            for (int nt = 0; nt < 4; ++nt) acc[m][nt] = (f32x4){0.f, 0.f, 0.f, 0.f};
        hy_conv_mfma(lds, acc, wave, lane);
        { bf16* yo = YT + (size_t)c * M_LAT + bb * SEQ;
#pragma unroll
          for (int m = 0; m < 2; ++m)
#pragma unroll
              for (int nt = 0; nt < 4; ++nt) { const int t = 64 * (16 * wn + 4 * nt + il) + 16 * (2 * wm + m) + 4 * g;
                  const unsigned lo = (unsigned)xg[m][nt], hi = (unsigned)(xg[m][nt] >> 32);
                  const float z0 = __uint_as_float(lo << 16) * acc[m][nt][0], z1 = __uint_as_float(lo & 0xffff0000u) * acc[m][nt][1], z2 = __uint_as_float(hi << 16) * acc[m][nt][2], z3 = __uint_as_float(hi & 0xffff0000u) * acc[m][nt][3];
                  *(unsigned long long*)(yo + t) = (unsigned long long)pk2(z0, z1) | ((unsigned long long)pk2(z2, z3) << 32); } }
        c = cn;
    }
}
__device__ __forceinline__ void hy_prep_tile(const Ctx& C, KArgs& A, int layer, int tile) {
    const int lane = C.lane; LAS unsigned* T = (LAS unsigned*)(C.lds + C.wave * 8448);
    const int ct = tile % 24, tt = tile / 24, cb = ct * 64, row0 = tt * 64, t0 = row0 & 4095;
    const float* sw = A.in[11] + layer * 3 * 1536; const float* sb = A.in[12] + layer * 1536; const int ch = cb + lane;
    const float w0 = sw[ch], w1 = sw[1536 + ch], w2 = sw[3072 + ch], bias = sb[ch];
    const bf16* p = (const bf16*)(A.ws + WS_P) + (size_t)row0 * N_INP + OFF_HY + ch;
    float pm = (t0 > 0) ? bf2f(p[-(ptrdiff_t)N_INP]) : 0.f, pc = bf2f(p[0]), ae = 0.f;
#pragma unroll 8
    for (int i = 0; i < 64; ++i) { const float pn = (t0 + i + 1 < SEQ) ? bf2f(p[(size_t)(i + 1) * N_INP]) : 0.f; const float a = bias + w0 * pm + w1 * pc + w2 * pn; pm = pc; pc = pn;
        if (i & 1) T[lane * 33 + (i >> 1)] = pk2(ae, a); else ae = a; }
    LDS_WAIT(); asm volatile("" ::: "memory");
    unsigned* dst = (unsigned*)((bf16*)(A.ws + WS_HUT) + (size_t)cb * M_LAT + row0);
#pragma unroll 8
    for (int ii = 0; ii < 32; ++ii) { const int rr = 2 * ii + (lane >> 5), j = lane & 31; dst[(size_t)rr * (M_LAT / 2) + j] = T[rr * 33 + j]; }
    LDS_WAIT(); asm volatile("" ::: "memory");
}
__device__ __forceinline__ void hy_post_tile(const Ctx& C, KArgs& A, int tile) {
    const int lane = C.lane; LAS unsigned char* T = C.lds + C.wave * 8448;
    const int ct = tile & 7, tt = tile >> 3, cb = ct * 64, row0 = tt * 64;
    const unsigned* src = (const unsigned*)((const bf16*)(A.ws + WS_YT) + (size_t)cb * M_LAT + row0);
#pragma unroll
    for (int ii = 0; ii < 32; ++ii) { const int rr = 2 * ii + (lane >> 5), j = lane & 31; const unsigned w = src[(size_t)rr * (M_LAT / 2) + j];
        *(LAS bf16*)(T + (2 * j) * 132 + 2 * rr) = (bf16)(w & 0xffffu); *(LAS bf16*)(T + (2 * j + 1) * 132 + 2 * rr) = (bf16)(w >> 16); }
    LDS_WAIT(); asm volatile("" ::: "memory");
    unsigned* dst = (unsigned*)((bf16*)(A.ws + WS_Y) + (size_t)row0 * DM + 512 + cb);
#pragma unroll
    for (int ii = 0; ii < 32; ++ii) { const int rr = 2 * ii + (lane >> 5), j = lane & 31; dst[(size_t)rr * (DM / 2) + j] = *(const LAS unsigned*)(T + rr * 132 + 4 * j); }
    LDS_WAIT(); asm volatile("" ::: "memory");
}

struct PrepDesc { int col0, nch; const float* w; int wstride; const float* bias; bool silu; int cm_count; bf16* dst_cm; size_t cm_stride; int cm_col; bf16* dst_tm; int tm_stride; };
__device__ __forceinline__ void prep_load(KArgs& A, const PrepDesc& D, int r0, int t0, int L, int tid, v4u (&v)[5]) {
    const bf16* P = (const bf16*)(A.ws + WS_P); const int cpr = D.nch >> 3; const bool conv = D.w != nullptr, hp = conv && t0 > 0, hn = conv && (t0 + 32 < L);
#pragma unroll
    for (int i = 0; i < 5; ++i) { const int idx = tid + NTHR * i, rr = idx / cpr, part = idx - rr * cpr; const bool ok = idx < 34 * cpr && ((rr == 0) ? hp : ((rr == 33) ? hn : true));
        v[i].x = 0u; v[i].y = 0u; v[i].z = 0u; v[i].w = 0u; if (ok) v[i] = *(const v4u*)(P + (size_t)(r0 - 1 + rr) * N_INP + D.col0 + 8 * part); }
}
__device__ __forceinline__ void prep_desc(KArgs& A, int layer, int u, PrepDesc& D, int& r0, int& t0, int& L) {
    const int NT_L = M_LAT / 32, NT_A = M_ALL / 32; const int nH = 3 * NT_L, nS = 2 * NT_A; int tt;
    if (u < nH) { const int k = u / NT_L; tt = u - k * NT_L; D.col0 = OFF_HY + 512 * k; D.nch = 512; D.w = A.in[11] + layer * 3 * 1536 + 512 * k; D.wstride = 1536; D.bias = A.in[12] + layer * 1536 + 512 * k; D.silu = false;
        D.cm_count = 512; D.dst_cm = (bf16*)(A.ws + WS_HUT) + (size_t)(512 * k) * M_LAT; D.cm_stride = M_LAT; D.cm_col = 32 * tt; D.dst_tm = nullptr; D.tm_stride = 0; }
    else if (u < nH + nS) { const int v = u - nH, k = v / NT_A; tt = v - k * NT_A; D.col0 = OFF_SSM + 512 + 512 * k; D.nch = 512; D.w = A.in[23] + layer * 3 * 1024 + 512 * k; D.wstride = 1024; D.bias = A.in[24] + layer * 1024 + 512 * k; D.silu = true;
        D.cm_count = k ? 256 : 512; D.dst_cm = (bf16*)(A.ws + WS_XBCT) + (size_t)(512 * k) * M_ALL; D.cm_stride = M_ALL; D.cm_col = 32 * tt; D.dst_tm = (bf16*)(A.ws + WS_XBC) + 512 * k; D.tm_stride = 1024; }
    else { const int v = u - nH - nS, k = v / NT_A; tt = v - k * NT_A; D.col0 = k ? OFF_NA + 1024 : 640; D.nch = k ? 512 : 128; D.w = nullptr; D.wstride = 0; D.bias = nullptr; D.silu = false;
        D.cm_count = D.nch; D.dst_cm = (bf16*)(A.ws + WS_VT) + (size_t)(k ? 128 : 0) * M_ALL; D.cm_stride = M_ALL; D.cm_col = 32 * tt; D.dst_tm = nullptr; D.tm_stride = 0; }
    r0 = 32 * tt; if (r0 < M_LAT) { t0 = r0 & 4095; L = SEQ; } else { t0 = (r0 - M_LAT) & 255; L = LC; }
}
__device__ __forceinline__ void phase_prep_units(const Ctx& C, KArgs& A, int layer) {
    LAS unsigned char* lds = C.lds; constexpr int OFF_T = 36864, OFF_O = 81920;
    const int N = 3 * (M_LAT / 32) + 4 * (M_ALL / 32);
    int tid = C.tid; asm volatile("" : "+v"(tid));
    int u = C.bid; v4u v[5];
    if (u < N) { PrepDesc D0; int a0, b0, c0; prep_desc(A, layer, u, D0, a0, b0, c0); prep_load(A, D0, a0, b0, c0, tid, v); }
    while (u < N) {
        PrepDesc D; int r0, t0, L; prep_desc(A, layer, u, D, r0, t0, L);
        const int cpr = D.nch >> 3;
        __syncthreads();
#pragma unroll
        for (int i = 0; i < 5; ++i) { const int idx = tid + NTHR * i, rr = idx / cpr, part = idx - rr * cpr; if (idx < 34 * cpr) *(LAS v4u*)(lds + (rr * D.nch + 8 * part) * 2) = v[i]; }
        const int un = u + C.G;
        if (un < N) { PrepDesc Dn; int r0n, t0n, Ln; prep_desc(A, layer, un, Dn, r0n, t0n, Ln); prep_load(A, Dn, r0n, t0n, Ln, tid, v); }
        __syncthreads();
        if (tid < D.nch) { const int c = tid; float w0 = 0.f, w1 = 1.f, w2 = 0.f, bs = 0.f;
            if (D.w != nullptr) { w0 = D.w[c]; w1 = D.w[D.wstride + c]; w2 = D.w[2 * D.wstride + c]; bs = D.bias[c]; }
            const LAS bf16* in = (const LAS bf16*)lds + c; float pm = bf2f(in[0]), pc = bf2f(in[D.nch]), ae = 0.f;
            const bool cm = c < D.cm_count, tm = D.dst_tm != nullptr;
#pragma unroll 8
            for (int t = 0; t < 32; ++t) { const float pn = bf2f(in[(t + 2) * D.nch]); float a = bs + w0 * pm + w1 * pc + w2 * pn; if (D.silu) a = silu_f(a); pm = pc; pc = pn;
                if (tm) *(LAS bf16*)(lds + OFF_O + (t * D.nch + c) * 2) = (bf16)f2bf(a);
                if (t & 1) { if (cm) *(LAS unsigned*)(lds + OFF_T + c * 80 + (t >> 1) * 4) = pk2(ae, a); } else ae = a; } }
        __syncthreads();
        for (int idx = tid; idx < D.cm_count * 4; idx += NTHR) { const int c = idx >> 2, part = idx & 3; *(v4u*)(D.dst_cm + (size_t)c * D.cm_stride + D.cm_col + 8 * part) = *(const LAS v4u*)(lds + OFF_T + c * 80 + part * 16); }
        if (D.dst_tm) for (int idx = tid; idx < 32 * cpr; idx += NTHR) { const int t = idx / cpr, part = idx - t * cpr; *(v4u*)(D.dst_tm + (size_t)(r0 + t) * D.tm_stride + 8 * part) = *(const LAS v4u*)(lds + OFF_O + (t * D.nch + 8 * part) * 2); }
        u = un;
    }
    __syncthreads();
}

__device__ __forceinline__ void prep_dt(const Ctx& C, KArgs& A, int layer) {
    const bf16* P = (const bf16*)(A.ws + WS_P); float* DT = (float*)(A.ws + WS_DT);
    for (int i = C.bid * NTHR + C.tid; i < M_ALL * 16; i += C.G * NTHR) { const int row = i >> 4, j = i & 15;
        const float raw = bf2f(P[(size_t)row * N_INP + OFF_SSM + 1536 + j]) + A.in[25][layer * 16 + j]; const float dt = raw > 20.f ? raw : log1pf(expf(raw));
        DT[i] = dt; DT[(size_t)M_ALL * 16 + i] = -expf(A.in[26][layer * 16 + j]) * dt; }
}
__device__ __forceinline__ void prep_row(const Ctx& C, KArgs& A, int layer, int row) {
    const int lane = C.lane;
    const bf16* prow = (const bf16*)(A.ws + WS_P) + (size_t)row * N_INP;
    const int t = (row - M_LAT) & 255; const bool hp = t > 0, hn = t < LC - 1;
    const bf16* pm = prow - N_INP; const bf16* pp = prow + N_INP;
    const float* sw = A.in[11] + layer * 3 * 1536; const float* sb = A.in[12] + layer * 1536; float* HU = (float*)(A.ws + WS_HU) + (size_t)row * 1536;
#pragma unroll
    for (int i = 0; i < 24; ++i) { const int ch = lane + 64 * i, col = OFF_HY + ch;
        float a = sb[ch] + sw[1536 + ch] * bf2f(prow[col]); if (hp) a += sw[ch] * bf2f(pm[col]); if (hn) a += sw[3072 + ch] * bf2f(pp[col]);
        HU[ch] = a; }
}

constexpr float ATT_SC = 0.125f * 1.4426950408889634f, LOG2E = 1.4426950408889634f;
struct SD_A { int b, base, ilo, nloc;
    __device__ __forceinline__ void init(int b_, int n, int hh) { b = b_; base = n * 128 + 64 * hh - 128; ilo = base < 0 ? (-base) >> 5 : 0; int ihi = (SEQ - base) >> 5; ihi = ihi > 10 ? 10 : ihi; nloc = ihi - ilo; }
    __device__ __forceinline__ int nsteps() const { return nloc + 8; }
    __device__ __forceinline__ int seg(int j, int& code) const { if (j < nloc) { code = ilo + j; return b * SEQ + base + 32 * code; } code = -1; return M_LAT + b * LC + 32 * (j - nloc); }
    __device__ __forceinline__ void mask(int code, int qt, int li, int g, float (&sv)[8]) const { if (code < 0 || (code >= 2 && code <= 7)) return; const int d0 = 32 * code + 4 * g - li - 16 * qt;
#pragma unroll
        for (int j = 0; j < 8; ++j) sv[j] = ((unsigned)(d0 + (j & 3) + 16 * (j >> 2)) <= 256u) ? sv[j] : -INFINITY; } };
struct SD_NA { int b, r, rstart; const LAS float* rpb;
    __device__ __forceinline__ int nsteps() const { return 24; }
    __device__ __forceinline__ int seg(int j, int& code) const { if (j < 16) { code = j; return b * SEQ + (rstart + (j >> 1)) * 64 + 32 * (j & 1); } code = -1; return M_LAT + b * LC + 32 * (j - 16); }
    __device__ __forceinline__ void mask(int code, int qt, int li, int g, float (&sv)[8]) const { if (code < 0) return; const int c = 16 * qt + li; int c0 = c - 8; c0 = c0 < 0 ? 0 : (c0 > 48 ? 48 : c0);
        const int lo = c0 - c, d0 = 32 * (code & 1) + 4 * g - c, rowb = (rstart + (code >> 1) - r + 7) * 31 + 15;
        float bias[8]; const volatile LAS float* rp = (const volatile LAS float*)rpb;
#pragma unroll
        for (int j = 0; j < 8; ++j) { const int d = d0 + (j & 3) + 16 * (j >> 2); const bool ok = (unsigned)(d - lo) < 16u; bias[j] = rp[ok ? rowb + d : 0]; }
#pragma unroll
        for (int j = 0; j < 8; ++j) { const int d = d0 + (j & 3) + 16 * (j >> 2); const bool ok = (unsigned)(d - lo) < 16u; sv[j] = ok ? sv[j] + bias[j] : -INFINITY; } } };
struct SD_CTX { int b;
    __device__ __forceinline__ int nsteps() const { return 8; }
    __device__ __forceinline__ int seg(int j, int& code) const { code = -1; return M_LAT + b * LC + 32 * j; }
    __device__ __forceinline__ void mask(int, int, int, int, float (&)[8]) const {} };

struct AttnKV { bf16x8 kf[2][2], vf[4]; };
__device__ __forceinline__ void attn_load(AttnKV& kv, __amdgpu_buffer_rsrc_t rp, __amdgpu_buffer_rsrc_t rv, int rowstart, int kcol, unsigned koff, unsigned voff) {
    const int ks = (rowstart * N_INP + kcol) * 2, vs = rowstart * 2;
#pragma unroll
    for (int half = 0; half < 2; ++half)
#pragma unroll
        for (int kk = 0; kk < 2; ++kk) { union { v4u u; bf16x8 x; } cv; cv.u = __builtin_amdgcn_raw_buffer_load_b128(rp, koff, ks + 16 * half * N_INP * 2 + 64 * kk, 0); kv.kf[half][kk] = cv.x; }
#pragma unroll
    for (int dt = 0; dt < 4; ++dt) { typedef unsigned v2u_ __attribute__((ext_vector_type(2))); union { v2u_ q[2]; bf16x8 x; } cv;
        cv.q[0] = __builtin_amdgcn_raw_buffer_load_b64(rv, voff, vs + 16 * dt * M_ALL * 2, 0); cv.q[1] = __builtin_amdgcn_raw_buffer_load_b64(rv, voff, vs + 16 * dt * M_ALL * 2 + 32, 0); kv.vf[dt] = cv.x; }
}
template <class SD>
__device__ __forceinline__ void attn_step(const AttnKV& kv, const SD& sd, int code, const LAS bf16x8* ql, f32x4 (&O)[4][4], float (&mrun)[4], float (&lrun)[4], int li, int g) {
    asm volatile("" : "+v"(li), "+v"(g));
#pragma unroll
    for (int qt = 0; qt < 4; ++qt) {
        const bf16x8 q0 = ql[(qt * 2 + 0) * 64], q1 = ql[(qt * 2 + 1) * 64];
        f32x4 s0 = __builtin_amdgcn_mfma_f32_16x16x32_bf16(kv.kf[0][0], q0, (f32x4){0.f, 0.f, 0.f, 0.f}, 0, 0, 0); f32x4 s1 = __builtin_amdgcn_mfma_f32_16x16x32_bf16(kv.kf[1][0], q0, (f32x4){0.f, 0.f, 0.f, 0.f}, 0, 0, 0);
        s0 = __builtin_amdgcn_mfma_f32_16x16x32_bf16(kv.kf[0][1], q1, s0, 0, 0, 0); s1 = __builtin_amdgcn_mfma_f32_16x16x32_bf16(kv.kf[1][1], q1, s1, 0, 0, 0);
        float sv[8];
#pragma unroll
        for (int r = 0; r < 4; ++r) { sv[r] = s0[r]; sv[4 + r] = s1[r]; }
        sd.mask(code, qt, li, g, sv);
        float tmax = fmaxf(fmaxf(fmaxf(sv[0], sv[1]), fmaxf(sv[2], sv[3])), fmaxf(fmaxf(sv[4], sv[5]), fmaxf(sv[6], sv[7])));
        tmax = fmaxf(tmax, __shfl_xor(tmax, 16)); tmax = fmaxf(tmax, __shfl_xor(tmax, 32));
        if (__builtin_amdgcn_ballot_w64(tmax > mrun[qt]) != 0ull) {
            const float mnew = fmaxf(mrun[qt], tmax), alpha = __builtin_amdgcn_exp2f(mrun[qt] - mnew); mrun[qt] = mnew; lrun[qt] *= alpha;
#pragma unroll
            for (int dt = 0; dt < 4; ++dt) O[qt][dt] = O[qt][dt] * alpha; }
        float p[8], ps = 0.f; const float mq = mrun[qt];
#pragma unroll
        for (int j = 0; j < 8; ++j) { p[j] = __builtin_amdgcn_exp2f(sv[j] - mq); ps += p[j]; }
        lrun[qt] += ps;
        union { unsigned u[4]; bf16x8 x; } pf; pf.u[0] = pk2(p[0], p[1]); pf.u[1] = pk2(p[2], p[3]); pf.u[2] = pk2(p[4], p[5]); pf.u[3] = pk2(p[6], p[7]);
#pragma unroll
        for (int dt = 0; dt < 4; ++dt) O[qt][dt] = __builtin_amdgcn_mfma_f32_16x16x32_bf16(kv.vf[dt], pf.x, O[qt][dt], 0, 0, 0);
    }
}
template <class SD, int DIAG = 0>
__device__ __forceinline__ void attn_core(const bf16* P, const bf16* VT, int qrow0, int qcol, int kcol, const SD& sd, bool has_sink, float sink, bf16* Ybase, int ocol, int lane, LAS bf16x8* ql) {
    const int li = lane & 15, g = lane >> 4;
    ql += lane;
    const unsigned koff = (unsigned)(li * N_INP + 8 * g) * 2u, voff = (unsigned)(li * M_ALL + 4 * g) * 2u;
    const int ns = sd.nsteps();
    const __amdgpu_buffer_rsrc_t rp = __builtin_amdgcn_make_buffer_rsrc((void*)P, 0, (int)((size_t)M_ALL * N_INP * 2), 0x00020000);
    const __amdgpu_buffer_rsrc_t rv = __builtin_amdgcn_make_buffer_rsrc((void*)VT, 0, 64 * M_ALL * 2, 0x00020000);
    const __amdgpu_buffer_rsrc_t ry = __builtin_amdgcn_make_buffer_rsrc((void*)Ybase, 0, (int)((size_t)M_ALL * DM * 2), 0x00020000);
    const unsigned yoff = (unsigned)(li * DM + 4 * g) * 2u;
    v4u qraw[4][2];
#pragma unroll
    for (int qt = 0; qt < 4; ++qt)
#pragma unroll
        for (int kk = 0; kk < 2; ++kk) qraw[qt][kk] = *(const v4u*)(P + (size_t)(qrow0 + 16 * qt + li) * N_INP + qcol + 32 * kk + 8 * g);
    AttnKV kva, kvb; int ca, cb;
    { const int rs = sd.seg(0, ca); attn_load(kva, rp, rv, rs, kcol, koff, voff); }
#pragma unroll
    for (int qt = 0; qt < 4; ++qt)
#pragma unroll
        for (int kk = 0; kk < 2; ++kk) { union { v4u u; bf16x8 x; } qv; qv.u = qraw[qt][kk];
#pragma unroll
            for (int e = 0; e < 4; ++e) { const unsigned w = qv.u[e]; qv.u[e] = pk2(__uint_as_float(w << 16) * ATT_SC, __uint_as_float(w & 0xffff0000u) * ATT_SC); }
            ql[(qt * 2 + kk) * 64] = qv.x; }
    LDS_WAIT(); asm volatile("" ::: "memory");
    f32x4 O[4][4]; float mrun[4], lrun[4];
#pragma unroll
    for (int qt = 0; qt < 4; ++qt) { mrun[qt] = has_sink ? sink * LOG2E : -1e30f; lrun[qt] = (has_sink && g == 0) ? 1.f : 0.f;
#pragma unroll
        for (int dt = 0; dt < 4; ++dt) O[qt][dt] = (f32x4){0.f, 0.f, 0.f, 0.f}; }
    if (DIAG == 0) {
#pragma unroll 1
    for (int step = 0; step < ns; step += 2) {
        if (step + 1 < ns) { const int rs = sd.seg(step + 1, cb); attn_load(kvb, rp, rv, rs, kcol, koff, voff); }
        attn_step(kva, sd, ca, ql, O, mrun, lrun, li, g);
        if (step + 1 < ns) {
            if (step + 2 < ns) { const int rs = sd.seg(step + 2, ca); attn_load(kva, rp, rv, rs, kcol, koff, voff); }
            attn_step(kvb, sd, cb, ql, O, mrun, lrun, li, g);
        }
    }
    }
#pragma unroll
    for (int qt = 0; qt < 4; ++qt) { float lt = lrun[qt]; lt += __shfl_xor(lt, 16); lt += __shfl_xor(lt, 32); const float inv = 1.0f / lt;
        const int so = ((qrow0 + 16 * qt) * DM + ocol) * 2;
#pragma unroll
        for (int dt = 0; dt < 4; ++dt) { const f32x4 o = O[qt][dt] * inv; typedef unsigned v2u_ __attribute__((ext_vector_type(2))); v2u_ w; w.x = pk2(o[0], o[1]); w.y = pk2(o[2], o[3]);
            __builtin_amdgcn_raw_buffer_store_b64(w, ry, yoff, so + 32 * dt, 0); } }
}

template <int DIAG = 0>
__device__ __forceinline__ void phase_attn(const Ctx& C, KArgs& A, int layer, bool need_ctx) {
    const bf16* P = (const bf16*)(A.ws + WS_P); bf16* Y = (bf16*)(A.ws + WS_Y); const bf16* VT = (const bf16*)(A.ws + WS_VT);
    const float* sinkp = A.in[10] + layer * 8; const float* rpb = A.in[22] + (size_t)layer * 8 * 15 * 31;
    LAS bf16x8* ql = (LAS bf16x8*)(C.lds + C.wave * 8192);
    const int nA = NB * 32 * 8 * 2, nN = NB * 8 * 64, nC = need_ctx ? NB * 8 * 4 : 0;
    const int ctx_r = (C.bid >= 80 && C.wave < 2) ? (C.bid - 80) + (C.G - 80) * C.wave : 1 << 20;
#pragma unroll 1
    for (int k = 0; k < 3; ++k) { const int it = (k < 2) ? C.gw + k * C.NGW : nA + nN + ctx_r;
        if (it >= nA + nN + 2 * nC) break;
        int r = it;
        if (r < nA) { const int hh = r & 1, hq = (r >> 1) & 7, n = (r >> 4) & 31, b = r >> 9, hk = hq >> 2; SD_A sd; sd.init(b, n, hh);
            attn_core<decltype(sd), DIAG>(P, VT + (size_t)hk * 64 * M_ALL, b * SEQ + n * 128 + 64 * hh, 64 * hq, 512 + 64 * hk, sd, true, sinkp[hq], Y, 64 * hq, C.lane, ql); continue; } r -= nA;
        if (r < nN) { const int h = r & 7, rr = (r >> 3) & 63, b = r >> 9; int rstart = rr - 4; rstart = rstart < 0 ? 0 : (rstart > 56 ? 56 : rstart); LAS float* rl = (LAS float*)(C.lds + 65536 + C.wave * 2048);
            for (int i = C.lane; i < 465; i += 64) rl[i] = rpb[h * 465 + i] * LOG2E;
            LDS_WAIT(); asm volatile("" ::: "memory");
            SD_NA sd{b, rr, rstart, rl};
            attn_core<decltype(sd), DIAG>(P, VT + (size_t)(2 + h) * 64 * M_ALL, b * SEQ + rr * 64, OFF_NA + 64 * h, OFF_NA + 512 + 64 * h, sd, false, 0.f, Y, 1024 + 64 * h, C.lane, ql); continue; } r -= nN;
        if (r < nC) { const int blk = r & 3, hq = (r >> 2) & 7, b = r >> 5, hk = hq >> 2; SD_CTX sd{b};
            attn_core<decltype(sd), DIAG>(P, VT + (size_t)hk * 64 * M_ALL, M_LAT + b * LC + 64 * blk, 64 * hq, 512 + 64 * hk, sd, true, sinkp[hq], Y, 64 * hq, C.lane, ql); continue; } r -= nC;
        { const int blk = r & 3, h = (r >> 2) & 7, b = r >> 5; SD_CTX sd{b};
            attn_core<decltype(sd), DIAG>(P, VT + (size_t)(2 + h) * 64 * M_ALL, M_LAT + b * LC + 64 * blk, OFF_NA + 64 * h, OFF_NA + 512 + 64 * h, sd, false, 0.f, Y, 1024 + 64 * h, C.lane, ql); }
    }
}
__device__ __forceinline__ void vt_prep_tile(const Ctx& C, KArgs& A, int tile) {
    const int lane = C.lane; LAS unsigned* T = (LAS unsigned*)(C.lds + C.wave * 8448);
    const int slot = tile % 10, tt = tile / 10, row0 = tt * 64, col0 = (slot < 2) ? 640 + 64 * slot : OFF_NA + 1024 + 64 * (slot - 2);
    const bf16* p = (const bf16*)(A.ws + WS_P) + (size_t)row0 * N_INP + col0 + lane;
#pragma unroll 8
    for (int i = 0; i < 32; ++i) { const unsigned lo = p[(size_t)(2 * i) * N_INP], hi = p[(size_t)(2 * i + 1) * N_INP]; T[lane * 33 + i] = lo | (hi << 16); }
    LDS_WAIT(); asm volatile("" ::: "memory");
    unsigned* dst = (unsigned*)((bf16*)(A.ws + WS_VT) + (size_t)slot * 64 * M_ALL + row0);
#pragma unroll 8
    for (int ii = 0; ii < 32; ++ii) { const int rr = 2 * ii + (lane >> 5), j = lane & 31; dst[(size_t)rr * (M_ALL / 2) + j] = T[rr * 33 + j]; }
    LDS_WAIT(); asm volatile("" ::: "memory");
}

template <bool OUT_BF16>
__device__ __forceinline__ void hy_conv_unit(const float* U, int ustride, const float* G, int L, int rowbase, int t0, const float* gate, int gstride, void* outp, int ostride, int c) {
    float acc[16], old[16], nw[16], u[16];
#pragma unroll
    for (int i = 0; i < 16; ++i) { acc[i] = 0.f; old[i] = 0.f; }
#pragma unroll
    for (int m = 0; m < 15; ++m) old[m] = G[(size_t)(t0 + 1 + m + L - 1) * 512 + c];
    float un[16], nn[16];
#pragma unroll
    for (int k = 0; k < 16; ++k) un[k] = U[(size_t)(rowbase + k) * ustride + c];
#pragma unroll
    for (int m = 0; m < 16; ++m) nn[m] = G[(size_t)(t0 - 15 + m + L - 1) * 512 + c];
    for (int sb = 0; sb < L; sb += 16) {
#pragma unroll
        for (int k = 0; k < 16; ++k) { u[k] = un[k]; nw[k] = nn[k]; }
        if (sb + 16 < L) {
#pragma unroll
            for (int k = 0; k < 16; ++k) un[k] = U[(size_t)(rowbase + sb + 16 + k) * ustride + c];
#pragma unroll
            for (int m = 0; m < 16; ++m) nn[m] = G[(size_t)(t0 - sb - 16 - 15 + m + L - 1) * 512 + c]; }
#pragma unroll
        for (int i = 0; i < 16; ++i)
#pragma unroll
            for (int k = 0; k < 16; ++k) { const int j = i - k; acc[i] += u[k] * ((j <= 0) ? nw[j + 15] : old[j - 1]); }
#pragma unroll
        for (int m = 0; m < 16; ++m) old[m] = nw[m];
    }
#pragma unroll
    for (int i = 0; i < 16; ++i) { const size_t row = (size_t)(rowbase + t0 + i); const float v = gate[row * gstride + c] * acc[i];
        if (OUT_BF16) ((bf16*)outp)[row * ostride + c] = (bf16)f2bf(v); else ((float*)outp)[row * ostride + c] = v; }
}
__device__ __forceinline__ void phase_hyconv(const Ctx& C, KArgs& A, int layer, int order, bool need_ctx, int first_wg = 0) {
    const float* HU = (const float*)(A.ws + WS_HU); float* Z = (float*)(A.ws + WS_Z); bf16* Y = (bf16*)(A.ws + WS_Y);
    const float* GL = (const float*)(A.ws + WS_GLAT) + (size_t)order * (2 * SEQ - 1) * 512; const float* GC = (const float*)(A.ws + ((layer & 1) ? WS_GCTX1 : WS_GCTX)) + (size_t)order * (2 * LC - 1) * 512;
    const int nl = 0, nc = need_ctx ? NB * (LC / 16) : 0;
    for (int u = (C.bid >= first_wg) ? C.bid - first_wg : C.bid - first_wg + C.G; u < nl + nc; u += C.G) {
        int L, rowbase, t0; const float* G;
        if (u < nl) { const int b = u / (SEQ / 16); t0 = (u % (SEQ / 16)) * 16; L = SEQ; rowbase = b * SEQ; G = GL; }
        else { const int v = u - nl, b = v / (LC / 16); t0 = (v % (LC / 16)) * 16; L = LC; rowbase = M_LAT + b * LC; G = GC; }
        if (order == 0) hy_conv_unit<false>(HU + 1024, 1536, G, L, rowbase, t0, HU, 1536, Z, 512, C.tid);
        else hy_conv_unit<true>(Z, 512, G, L, rowbase, t0, HU + 512, 1536, Y + 512, DM, C.tid);
    }
}

__device__ __forceinline__ int ssd_rowbase(int b, int ci) { return ci < 2 ? M_LAT + b * LC + 128 * ci : b * SEQ + 128 * (ci - 2); }
__device__ __forceinline__ void ssd_tables(const Ctx& C, KArgs& A, int rowbase, int grp, LAS float* cs, LAS float* dtl, LAS float* wtab, float* cd_out) {
    const int w = C.wave, lane = C.lane, h = w & 3, d = w >> 2, head = grp * 4 + h;
    const float* DT = (const float*)(A.ws + WS_DT); const float* DTA = DT + (size_t)M_ALL * 16;
    const size_t i0 = (size_t)(rowbase + 2 * lane) * 16 + d * 8 + head;
    const float a0 = DTA[i0], a1 = DTA[i0 + 16], dt0 = DT[i0], dt1 = DT[i0 + 16];
    float incl = a0 + a1;
#pragma unroll
    for (int o = 1; o < 64; o <<= 1) { const float t = __shfl_up(incl, o); if (lane >= o) incl += t; }
    const float excl = incl - (a0 + a1), tot = __shfl(incl, 63);
    float c0, c1;
    if (d == 0) { c0 = excl + a0; c1 = incl; } else { c0 = tot - excl; c1 = tot - excl - a0; }
    cs[w * 128 + 2 * lane] = c0; cs[w * 128 + 2 * lane + 1] = c1; dtl[w * 128 + 2 * lane] = dt0; dtl[w * 128 + 2 * lane + 1] = dt1;
    wtab[w * 128 + 2 * lane] = dt0 * __expf(tot - c0); wtab[w * 128 + 2 * lane + 1] = dt1 * __expf(tot - c1);
    if (cd_out && lane == 0) cd_out[head * 2 + d] = __expf(tot);
}
constexpr int D1_XS = 12288;
__device__ __forceinline__ void ssd_d1_unit(const Ctx& C, KArgs& A, int b, int ci, int grp) {
    const int w = C.wave, rowbase = ssd_rowbase(b, ci);
    LAS float* cs = (LAS float*)C.lds; LAS float* dtl = cs + 1024; LAS float* wtab = dtl + 1024; LAS unsigned char* lds = C.lds;
    const bf16* XT = (const bf16*)(A.ws + WS_XBCT);
    __syncthreads();
    int tid = C.tid; asm volatile("" : "+v"(tid));
    ssd_tables(C, A, rowbase, grp, cs, dtl, wtab, (float*)(A.ws + WS_CD) + (size_t)(b * 34 + ci) * 16);
    { const bf16* xsrc = XT + (size_t)(grp * 256) * M_ALL + rowbase;
#pragma unroll
      for (int i = 0; i < 8; ++i) { const int q = tid + 512 * i, row = q >> 4, part = q & 15; *(LAS v4u*)(lds + D1_XS + row * 272 + part * 16) = *(const v4u*)(xsrc + (size_t)row * M_ALL + 8 * part); } }
    const int lane = tid & 63, g = lane >> 4, li = lane & 15;
    v4u braw[4];
#pragma unroll
    for (int kq = 0; kq < 4; ++kq) braw[kq] = *(const v4u*)(XT + (size_t)(512 + grp * 128 + 16 * w + li) * M_ALL + rowbase + 32 * kq + 8 * g);
    __syncthreads();
    float* SST = (float*)(A.ws + WS_SST);
#pragma unroll 1
    for (int hd = 0; hd < 8; ++hd) {
        const int h = hd & 3, d = hd >> 2, head = grp * 4 + h;
        bf16x8 bw[4];
#pragma unroll
        for (int kq = 0; kq < 4; ++kq) { const LAS f32x4* wp = (const LAS f32x4*)(wtab + hd * 128 + 32 * kq + 8 * g); const f32x4 w0 = wp[0], w1 = wp[1]; const v4u x = braw[kq];
            union { unsigned u[4]; bf16x8 v; } cv; cv.u[0] = pk2(__uint_as_float(x.x << 16) * w0.x, __uint_as_float(x.x & 0xffff0000u) * w0.y); cv.u[1] = pk2(__uint_as_float(x.y << 16) * w0.z, __uint_as_float(x.y & 0xffff0000u) * w0.w);
            cv.u[2] = pk2(__uint_as_float(x.z << 16) * w1.x, __uint_as_float(x.z & 0xffff0000u) * w1.y); cv.u[3] = pk2(__uint_as_float(x.w << 16) * w1.z, __uint_as_float(x.w & 0xffff0000u) * w1.w); bw[kq] = cv.v; }
        f32x4 acc[4];
        int xo = (h * 64 + li) * 272 + 16 * g; asm volatile("" : "+v"(xo));
#pragma unroll
        for (int pt = 0; pt < 4; ++pt) { acc[pt] = (f32x4){0.f, 0.f, 0.f, 0.f};
#pragma unroll
            for (int kq = 0; kq < 4; ++kq) { const bf16x8 xf = *(const LAS bf16x8*)(lds + D1_XS + xo + 16 * pt * 272 + 64 * kq);
                acc[pt] = __builtin_amdgcn_mfma_f32_16x16x32_bf16(xf, bw[kq], acc[pt], 0, 0, 0); } }
        float* so = SST + ((size_t)((b * 34 + ci) * 8 + head) * 2 + d) * 8192 + 16 * w + li;
#pragma unroll
        for (int pt = 0; pt < 4; ++pt)
#pragma unroll
            for (int r = 0; r < 4; ++r) so[(size_t)(16 * pt + 4 * g + r) * 128] = acc[pt][r];
    }
}
__device__ __forceinline__ void ssd_d2(const Ctx& C, KArgs& A) {
    const float* SST = (const float*)(A.ws + WS_SST); const float* CD = (const float*)(A.ws + WS_CD); bf16* HIN = (bf16*)(A.ws + WS_HIN);
    for (int e = C.bid * NTHR + C.tid; e < NB * 8 * 2 * 8192; e += C.G * NTHR) {
        const int pn = e & 8191, d = (e >> 13) & 1, head = (e >> 14) & 7, b = e >> 17;
        float H = 0.f;
        float sv[34], cv[34];
#pragma unroll
        for (int i = 0; i < 34; ++i) { const int ci = d ? (i < 2 ? 1 - i : 35 - i) : i; const size_t o = ((size_t)((b * 34 + ci) * 8 + head) * 2 + d); sv[i] = SST[o * 8192 + pn]; cv[i] = CD[o]; }
#pragma unroll
        for (int i = 0; i < 34; ++i) { const int ci = d ? (i < 2 ? 1 - i : 35 - i) : i;
            const size_t o = ((size_t)((b * 34 + ci) * 8 + head) * 2 + d); HIN[o * 8192 + pn] = (bf16)f2bf(H); H = cv[i] * H + sv[i]; }
    }
}
constexpr int D3_XS = 8192, D3_HS = D3_XS + 256 * 272, D3_PITCH = 272, D3_BS = D3_HS + 8192;
template <bool CTX>
__device__ __forceinline__ void ssd_d3_unit(const Ctx& C, KArgs& A, int layer, int b, int ci, int grp) {
    const int lane = C.lane, w = C.wave, g = lane >> 4, li = lane & 15, rowbase = ssd_rowbase(b, ci);
    LAS float* cs = (LAS float*)C.lds; LAS float* dtl = cs + 1024; LAS unsigned char* lds = C.lds;
    const bf16* XBC = (const bf16*)(A.ws + WS_XBC); const bf16* XT = (const bf16*)(A.ws + WS_XBCT);
    __syncthreads();
    int tid = C.tid; asm volatile("" : "+v"(tid));
    {
      LAS float* wt = (LAS float*)(lds + D3_HS);
      ssd_tables(C, A, rowbase, grp, cs, dtl, wt, nullptr);
      const bf16* xsrc = XT + (size_t)(grp * 256) * M_ALL + rowbase;
#pragma unroll
      for (int i = 0; i < 8; ++i) { const int q = tid + 512 * i, row = q >> 4, part = q & 15; *(LAS v4u*)(lds + D3_XS + row * D3_PITCH + part * 16) = *(const v4u*)(xsrc + (size_t)row * M_ALL + 8 * part); }
      const bf16* bsrc = XBC + (size_t)rowbase * 1024 + 512 + grp * 128;
#pragma unroll
      for (int i = 0; i < 4; ++i) { const int q = tid + 512 * i, row = q >> 4, part = q & 15; *(LAS v4u*)(lds + D3_BS + row * D3_PITCH + part * 16) = *(const v4u*)(bsrc + (size_t)row * 1024 + 8 * part); } }
    __syncthreads();
    int lrow = 16 * w + li;
    bf16x8 cf[4];
#pragma unroll
    for (int kk = 0; kk < 4; ++kk) cf[kk] = *(const bf16x8*)(XBC + (size_t)(rowbase + lrow) * 1024 + 768 + grp * 128 + 32 * kk + 8 * g);
    f32x4 T[8];
#pragma unroll
    for (int st = 0; st < 8; ++st) { T[st] = (f32x4){0.f, 0.f, 0.f, 0.f};
#pragma unroll
        for (int kk = 0; kk < 4; ++kk) { const bf16x8 bf_ = *(const LAS bf16x8*)(lds + D3_BS + (16 * st + li) * D3_PITCH + 64 * kk + 16 * g);
            T[st] = __builtin_amdgcn_mfma_f32_16x16x32_bf16(bf_, cf[kk], T[st], 0, 0, 0); }
        if ((st & 1) == 1) __builtin_amdgcn_sched_barrier(0); }
    f32x4 acc[4][4];
#pragma unroll
    for (int h = 0; h < 4; ++h)
#pragma unroll
        for (int pt = 0; pt < 4; ++pt) acc[h][pt] = (f32x4){0.f, 0.f, 0.f, 0.f};
    const int xoff0 = li * D3_PITCH + 8 * g, hoff0 = li * D3_PITCH + 16 * g, kqm = w >> 1;
#pragma unroll 1
    for (int d = 0; d < 2; ++d) {
      asm volatile("" : "+v"(tid));
      __syncthreads();
      {
        if (CTX) { const bool zero = (d == 0) ? (ci == 0) : (ci == 1); const float* sst = (const float*)(A.ws + WS_SST) + ((size_t)((b * 34 + (1 - ci)) * 8 + grp * 4) * 2 + d) * 8192;
#pragma unroll
            for (int i = 0; i < 8; ++i) { const int q = tid + 512 * i, h = q >> 10, within = q & 1023, row = within >> 4, part = within & 15; v4u o; o.x = 0u; o.y = 0u; o.z = 0u; o.w = 0u;
                if (!zero) { const f32x4* sp = (const f32x4*)(sst + (size_t)h * 2 * 8192 + row * 128 + 8 * part); const f32x4 a = sp[0], c = sp[1]; o.x = pk2(a[0], a[1]); o.y = pk2(a[2], a[3]); o.z = pk2(c[0], c[1]); o.w = pk2(c[2], c[3]); }
                *(LAS v4u*)(lds + D3_HS + (h * 64 + row) * D3_PITCH + part * 16) = o; } }
        else { const bf16* hsrc = (const bf16*)(A.ws + WS_HIN) + ((size_t)((b * 34 + ci) * 8 + grp * 4) * 2 + d) * 8192;
#pragma unroll
            for (int i = 0; i < 8; ++i) { const int q = tid + 512 * i, h = q >> 10, within = q & 1023, row = within >> 4, part = within & 15;
                *(LAS v4u*)(lds + D3_HS + (h * 64 + row) * D3_PITCH + part * 16) = *(const v4u*)(hsrc + (size_t)h * 2 * 8192 + row * 128 + 8 * part); } } }
      __syncthreads();
#pragma unroll
      for (int h = 0; h < 4; ++h) {
        const int hd = d * 4 + h;
        int lr = lrow; asm volatile("" : "+v"(lr));
        const float csl = cs[hd * 128 + lr];
        bf16x8 mf[4];
#pragma unroll
        for (int kq = 0; kq < 4; ++kq) { if (d ? (kq >= kqm) : (kq <= kqm)) { float v[8];
#pragma unroll
            for (int half = 0; half < 2; ++half) { const int s0 = 32 * kq + 16 * half + 4 * g; const f32x4 cv4 = *(const LAS f32x4*)(cs + hd * 128 + s0), dt4 = *(const LAS f32x4*)(dtl + hd * 128 + s0);
#pragma unroll
                for (int r = 0; r < 4; ++r) { const int s = s0 + r; const bool ok = d ? (s >= lr) : (s <= lr); const float e = __expf(fminf(csl - cv4[r], 0.f)) * dt4[r]; v[half * 4 + r] = ok ? T[2 * kq + half][r] * e : 0.f; } }
            union { unsigned u[4]; bf16x8 x; } cv; cv.u[0] = pk2(v[0], v[1]); cv.u[1] = pk2(v[2], v[3]); cv.u[2] = pk2(v[4], v[5]); cv.u[3] = pk2(v[6], v[7]); mf[kq] = cv.x; } }
        const float el = __expf(csl); bf16x8 cfs[4];
#pragma unroll
        for (int kk = 0; kk < 4; ++kk) { union { bf16x8 x; unsigned u[4]; } ci_, co; ci_.x = cf[kk];
#pragma unroll
            for (int q = 0; q < 4; ++q) co.u[q] = pk2(__uint_as_float(ci_.u[q] << 16) * el, __uint_as_float(ci_.u[q] & 0xffff0000u) * el);
            cfs[kk] = co.x; }
        int xo = xoff0 + h * 64 * D3_PITCH, ho = hoff0 + h * 64 * D3_PITCH; asm volatile("" : "+v"(xo), "+v"(ho));
#pragma unroll
        for (int pt = 0; pt < 4; ++pt) {
            f32x4 a4 = acc[h][pt];
#pragma unroll
            for (int kq = 0; kq < 4; ++kq) { if (d ? (kq >= kqm) : (kq <= kqm)) { union { unsigned long long q[2]; bf16x8 x; } cv; const LAS unsigned char* xp = lds + D3_XS + xo + 16 * pt * D3_PITCH + 64 * kq;
                cv.q[0] = *(const LAS unsigned long long*)xp; cv.q[1] = *(const LAS unsigned long long*)(xp + 32);
                a4 = __builtin_amdgcn_mfma_f32_16x16x32_bf16(cv.x, mf[kq], a4, 0, 0, 0); } }
#pragma unroll
            for (int kk = 0; kk < 4; ++kk) { const bf16x8 hf = *(const LAS bf16x8*)(lds + D3_HS + ho + 16 * pt * D3_PITCH + 64 * kk);
                a4 = __builtin_amdgcn_mfma_f32_16x16x32_bf16(hf, cfs[kk], a4, 0, 0, 0); }
            acc[h][pt] = a4; asm volatile("" ::: "memory"); }
      }
    }
    const size_t row = (size_t)(rowbase + lrow);
    const bf16* xs = XBC + row * 1024 + grp * 256; const bf16* zp = (const bf16*)(A.ws + WS_P) + row * N_INP + OFF_SSM + grp * 256;
    const float* dsk = A.in[27] + layer * 8 + grp * 4; const float* nw = A.in[28] + layer * 512 + grp * 256;
    float ss = 0.f;
#pragma unroll
    for (int h = 0; h < 4; ++h) { const float dh = dsk[h];
#pragma unroll
        for (int pt = 0; pt < 4; ++pt) { const int cb = h * 64 + 16 * pt + 4 * g;
            const unsigned long long xw = *(const unsigned long long*)(xs + cb), zw = *(const unsigned long long*)(zp + cb);
            const unsigned xl = (unsigned)xw, xh = (unsigned)(xw >> 32), zl = (unsigned)zw, zh = (unsigned)(zw >> 32);
            f32x4 v = acc[h][pt];
            v[0] = (v[0] + dh * __uint_as_float(xl << 16)) * silu_f(__uint_as_float(zl << 16)); v[1] = (v[1] + dh * __uint_as_float(xl & 0xffff0000u)) * silu_f(__uint_as_float(zl & 0xffff0000u));
            v[2] = (v[2] + dh * __uint_as_float(xh << 16)) * silu_f(__uint_as_float(zh << 16)); v[3] = (v[3] + dh * __uint_as_float(xh & 0xffff0000u)) * silu_f(__uint_as_float(zh & 0xffff0000u));
            acc[h][pt] = v; ss += (v[0] * v[0] + v[1] * v[1]) + (v[2] * v[2] + v[3] * v[3]); } }
    ss += __shfl_xor(ss, 16); ss += __shfl_xor(ss, 32);
    const float rstd = 1.0f / sqrtf(ss * (1.f / 256.f) + EPS);
    bf16* yo = (bf16*)(A.ws + WS_Y) + row * DM + 1536 + grp * 256;
#pragma unroll
    for (int h = 0; h < 4; ++h)
#pragma unroll
        for (int pt = 0; pt < 4; ++pt) { const int cb = h * 64 + 16 * pt + 4 * g; const f32x4 nv = *(const f32x4*)(nw + cb); const f32x4 v = acc[h][pt];
            *(unsigned long long*)(yo + cb) = (unsigned long long)pk2(v[0] * rstd * nv[0], v[1] * rstd * nv[1]) | ((unsigned long long)pk2(v[2] * rstd * nv[2], v[3] * rstd * nv[3]) << 32); }
}
__device__ __forceinline__ void ssm_prep_tile(const Ctx& C, KArgs& A, int layer, int tile) {
    const int lane = C.lane; LAS unsigned* T = (LAS unsigned*)(C.lds + C.wave * 8448);
    const int ct = tile % 12, tt = tile / 12, cb = ct * 64, row0 = tt * 64;
    int t0, L; if (row0 < M_LAT) { t0 = row0 & 4095; L = SEQ; } else { t0 = (row0 - M_LAT) & 255; L = LC; }
    const float* cw = A.in[23] + layer * 3 * 1024; const float* cbias = A.in[24] + layer * 1024; const int ch = cb + lane;
    const float w0 = cw[ch], w1 = cw[1024 + ch], w2 = cw[2048 + ch], bias = cbias[ch];
    const bf16* p = (const bf16*)(A.ws + WS_P) + (size_t)row0 * N_INP + OFF_SSM + 512 + ch;
    float pm = (t0 > 0) ? bf2f(p[-(ptrdiff_t)N_INP]) : 0.f, pc = bf2f(p[0]), ae = 0.f;
#pragma unroll 8
    for (int i = 0; i < 64; ++i) { const float pn = (t0 + i + 1 < L) ? bf2f(p[(size_t)(i + 1) * N_INP]) : 0.f; const float a = silu_f(bias + w0 * pm + w1 * pc + w2 * pn); pm = pc; pc = pn;
        if (i & 1) T[lane * 33 + (i >> 1)] = pk2(ae, a); else ae = a; }
    LDS_WAIT(); asm volatile("" ::: "memory");
    unsigned* dst = (unsigned*)((bf16*)(A.ws + WS_XBCT) + (size_t)cb * M_ALL + row0);
#pragma unroll 8
    for (int ii = 0; ii < 32; ++ii) { const int rr = 2 * ii + (lane >> 5), j = lane & 31; dst[(size_t)rr * (M_ALL / 2) + j] = T[rr * 33 + j]; }
    LDS_WAIT(); asm volatile("" ::: "memory");
}

__device__ __forceinline__ void filter_unit(const Ctx& C, KArgs& A, int layer, int u) {
    if (u < SEQ / 16) hy_filter_unit16<SEQ>(C, A, layer, 16 * u, A.ws + WS_GT); else hy_filter_unit16<LC>(C, A, layer, 16 * (u - SEQ / 16), A.ws + ((layer & 1) ? WS_GCTX1 : WS_GCTX));
}
constexpr int CW_TAILQ = 8192;
__device__ __forceinline__ void tail_work(const Ctx& C, KArgs& A, int next_layer, volatile LAS unsigned* MISC) {
    const bool ctxf = next_layer < DEPTH - 1; const int nF = SEQ / 16 + (ctxf ? LC / 16 : 0);
    unsigned* head = (unsigned*)(A.ws + WS_CTL) + CW_TAILQ + 64 * next_layer;
    for (;;) {
        __syncthreads();
        if (C.tid == 0) MISC[16] = __hip_atomic_fetch_add(head, 1u, __ATOMIC_RELAXED, __HIP_MEMORY_SCOPE_AGENT);
        __syncthreads();
        const int q = (int)MISC[16];
        if (q >= nF) break;
        filter_unit(C, A, next_layer, q);
    }
    __syncthreads();
}

namespace pg8 {
struct CtxOrder {
    int c;
    __device__ bool next(int i, Unit& u) const { if (i > 0 || c >= 32) return false; u.pm = c >> 3; u.pn = c & 7; return true; }
    __device__ __forceinline__ void a_ready(const Unit&) const {}
    __device__ __forceinline__ void done(const Unit&) const {}
};
}
__global__ void __launch_bounds__(NTHR, 2) mk_fwd(const Args A_unused) {
    KArgs* Ap = (KArgs*)__builtin_amdgcn_kernarg_segment_ptr();
#define A (*Ap)
    extern __shared__ __attribute__((aligned(16))) unsigned char lds_raw[];
    Ctx C;
    C.lds = (LAS unsigned char*)lds_raw;
    C.tid = threadIdx.x; C.lane = C.tid & 63; C.wave = __builtin_amdgcn_readfirstlane(C.tid >> 6);
    C.bid = blockIdx.x; C.G = gridDim.x; C.gw = C.bid * NWAVES + C.wave; C.NGW = C.G * NWAVES;
    volatile LAS unsigned* MISC = (volatile LAS unsigned*)(C.lds + MISC_OFF);
    for (int u = C.tid; u < (LDS_BYTES - MISC_OFF) / 4; u += NTHR) MISC[u] = 0u;
    __syncthreads();
    XcdBarrier bar; bar.bar = (unsigned*)(A.ws + WS_CTL) + CW_BAR; bar.x = 0; bar.st = nullptr;
    if (!MK_SPLIT) bar = xcd_barrier_post((unsigned*)(A.ws + WS_CTL) + CW_BAR, MISC + 8);
    const int lo = A.ph_lo, hi = A.ph_hi;
#define IN(k) (lo <= (k) && (k) < hi && (launder(C), ({ asm volatile("" : "+s"(Ap)); true; })))
#define RELOAD_A_UNUSED() asm volatile("" : "+s"(Ap))
#define REPS(k) ((PROBE_REP == (k)) ? 2 : 1)
#define SEAM(k) do { if (!MK_SPLIT && IN(k) && IN((k) + 1)) xcd_barrier(bar); } while (0)

    if (IN(PH_PRO1)) { phase_pro1(C, A); if (PROBE_REP == 40) { if (!MK_SPLIT) xcd_barrier(bar); launder(C); phase_pro1(C, A); } } SEAM(PH_PRO1);
    if (IN(PH_PRO2)) { phase_pro2(C, A); for (int u = C.bid; u < SEQ / 16; u += C.G) filter_unit(C, A, 0, u); __syncthreads(); } SEAM(PH_PRO2);

    for (int layer = 0; layer < DEPTH; ++layer) {
        const int pb = PH_L0 + layer * PH_PER_LAYER; const bool last = (layer == DEPTH - 1), need_ctx = !last;
        const unsigned char* wl = A.ws + WS_W + (size_t)layer * W_LAYER;
        const float* mod = (const float*)(A.ws + WS_MOD) + (size_t)layer * 5 * 12288;
        if (IN(pb + 0)) for (int rep_ = 0; rep_ < REPS(0); ++rep_) { if (rep_) { if (!MK_SPLIT) xcd_barrier(bar); launder(C); }
            phase_norm(C, A, layer, 0, layer == 0 ? 0 : M_LAT, M_ALL, C.gw, C.NGW);
            const int nf = SEQ + (need_ctx ? LC : 0);
            (void)nf;
        } SEAM(pb + 0);
        if (IN(pb + 1)) for (int rep_ = 0; rep_ < REPS(1); ++rep_) { if (rep_) { if (!MK_SPLIT) xcd_barrier(bar); launder(C); }
            pg8::Gemm g{(const bf16*)(A.ws + WS_XN), (const bf16*)wl, M_ALL, N_INP, DM}; pg8::StaticOrder S; S.init(M_ALL, N_INP, C.G, C.bid);
            pg8::EpiStoreBf16<0> E{(bf16*)(A.ws + WS_P), N_INP, (const float*)(A.ws + WS_ROPE)};
            pg8::gemm_phase<pg8::EpiStoreBf16<0>, pg8::StaticOrder, true, true>(C.lds, g, S, E);
            if (layer == 0 && rep_ == 0 && C.bid >= C.G - LC / 16) { __syncthreads(); launder(C); filter_unit(C, A, 0, SEQ / 16 + C.bid - (C.G - LC / 16)); __syncthreads(); }
        } SEAM(pb + 1);
        if (IN(pb + 2)) for (int rep_ = 0; rep_ < REPS(2); ++rep_) { if (rep_) { if (!MK_SPLIT) xcd_barrier(bar); launder(C); } prep_dt(C, A, layer); if (need_ctx) { const int gws = C.gw - (C.NGW >> 1);
                for (int row = M_LAT + (gws < 0 ? gws + C.NGW : gws); row < M_ALL; row += C.NGW) prep_row(C, A, layer, row); }
            phase_prep_units(C, A, layer); } SEAM(pb + 2);
        if (IN(pb + 3)) for (int rep_ = 0; rep_ < REPS(3); ++rep_) { if (rep_) { if (!MK_SPLIT) xcd_barrier(bar); launder(C); }
            for (int sr = 0; sr < ((PROBE_REP == 32) ? 2 : 1); ++sr) { launder(C); for (int u = C.bid; u < NB * 34 * 2; u += C.G) ssd_d1_unit(C, A, u / 68, (u % 68) >> 1, u & 1); }
            __syncthreads();
            for (int sr = 0; sr < ((PROBE_REP == 30) ? 2 : 1); ++sr) { launder(C); hy_fast_units(C, A); }
            __syncthreads();
            phase_hyconv(C, A, layer, 0, need_ctx, 16);
            for (int sr = 0; sr < ((PROBE_REP == 31) ? 2 : 1); ++sr) { launder(C); phase_attn<0>(C, A, layer, need_ctx); }
        } SEAM(pb + 3);
        if (IN(pb + 4)) for (int rep_ = 0; rep_ < REPS(4); ++rep_) { if (rep_) { if (!MK_SPLIT) xcd_barrier(bar); launder(C); }
            const int nHP = 8 * (M_LAT / 64), nHPx = need_ctx ? 16 * NWAVES : 0;
            if (need_ctx && C.bid >= C.G - 16) { const int u = C.bid - (C.G - 16); ssd_d3_unit<true>(C, A, layer, u >> 2, (u >> 1) & 1, u & 1); __syncthreads();
                launder(C); hy_post_tile(C, A, nHP - nHPx + u * NWAVES + C.wave); }
            else { Ctx C2 = C; if (need_ctx) { C2.G = C.G - 16; C2.NGW = C2.G * NWAVES; }
                ssd_d2(C2, A);
                for (int tile = C2.gw; tile < nHP - nHPx; tile += C2.NGW) hy_post_tile(C2, A, tile);
                phase_hyconv(C2, A, layer, 1, need_ctx, 16); }
        } SEAM(pb + 4);
        if (IN(pb + 5)) for (int rep_ = 0; rep_ < REPS(5); ++rep_) { if (rep_) { if (!MK_SPLIT) xcd_barrier(bar); launder(C); }
            for (int u = C.bid; u < NB * 32 * 2; u += C.G) ssd_d3_unit<false>(C, A, layer, u >> 6, 2 + ((u & 63) >> 1), u & 1);
        } SEAM(pb + 5);
        if (IN(pb + 6)) for (int rep_ = 0; rep_ < REPS(6); ++rep_) { if (rep_) { if (!MK_SPLIT) xcd_barrier(bar); launder(C); }
            float* Xp = (float*)(A.ws + WS_X); const bool first = (layer == 0 && rep_ == 0); const float* bl = first ? A.in[0] : Xp; const float* bc = first ? A.in[2] : Xp + (size_t)M_LAT * DM;
            { pg8::Gemm g{(const bf16*)(A.ws + WS_Y), (const bf16*)(wl + W_OUT_OFF), M_LAT, DM, DM}; pg8::StaticOrder S; S.init(M_LAT, DM, C.G, C.bid);
              pg8::EpiResid E; E.X = Xp; E.gate = mod + 2 * DM; E.gs = rep_ ? 0.f : 1.f; E.base_lat = bl; E.base_ctx = bl;
              pg8::gemm_phase<pg8::EpiResid, pg8::StaticOrder, true, true>(C.lds, g, S, E); }
            if (need_ctx) { if (!MK_SPLIT) xcd_barrier(bar); launder(C);
                if (C.bid < 32) { pg8::Gemm g{(const bf16*)(A.ws + WS_Y) + (size_t)M_LAT * DM, (const bf16*)(wl + W_OUT_OFF), M_CTX, DM, DM}; pg8::CtxOrder S; S.c = C.bid;
                    pg8::EpiResid E; E.X = Xp + (size_t)M_LAT * DM; E.gate = mod + 4 * 12288 + 2 * DM; E.gs = rep_ ? 0.f : 1.f; E.base_lat = bc; E.base_ctx = bc;
                    pg8::gemm_phase<pg8::EpiResid, pg8::CtxOrder, true, true>(C.lds, g, S, E); }
                else phase_norm(C, A, layer, 1, 0, M_LAT, (C.bid - 32) * NWAVES + C.wave, (C.G - 32) * NWAVES); }
        } SEAM(pb + 6);
        if (IN(pb + 7)) for (int rep_ = 0; rep_ < REPS(7); ++rep_) { if (rep_) { if (!MK_SPLIT) xcd_barrier(bar); launder(C); } phase_norm(C, A, layer, 1, need_ctx ? M_LAT : 0, need_ctx ? M_ALL : M_LAT, C.gw, C.NGW); } SEAM(pb + 7);
        if (IN(pb + 8)) for (int rep_ = 0; rep_ < REPS(8); ++rep_) { if (rep_) { if (!MK_SPLIT) xcd_barrier(bar); launder(C); }
            const int Mo = need_ctx ? M_ALL : M_LAT;
            pg8::Gemm g{(const bf16*)(A.ws + WS_XN), (const bf16*)(wl + W_1_OFF), Mo, DFF, DM}; pg8::StaticOrder S; S.init(Mo, DFF, C.G, C.bid);
            pg8::EpiStoreBf16<1> E{(bf16*)(A.ws + WS_H), DFF, nullptr};
            pg8::gemm_phase<pg8::EpiStoreBf16<1>, pg8::StaticOrder, true, true>(C.lds, g, S, E);
        } SEAM(pb + 8);
        if (IN(pb + 9)) for (int rep_ = 0; rep_ < REPS(9); ++rep_) { if (rep_) { if (!MK_SPLIT) xcd_barrier(bar); launder(C); }
            float* Xp = (float*)(A.ws + WS_X);
            { pg8::Gemm g{(const bf16*)(A.ws + WS_H), (const bf16*)(wl + W_2_OFF), M_LAT, DM, DFF}; pg8::StaticOrder S; S.init(M_LAT, DM, C.G, C.bid);
              pg8::EpiResid E; E.X = Xp; E.gate = mod + 5 * DM; E.gs = rep_ ? 0.f : 1.f; E.base_lat = Xp; E.base_ctx = Xp;
              pg8::gemm_phase<pg8::EpiResid, pg8::StaticOrder, true, true>(C.lds, g, S, E); }
            if (need_ctx) { if (!MK_SPLIT) xcd_barrier(bar); launder(C);
                if (C.bid < 32) { pg8::Gemm g{(const bf16*)(A.ws + WS_H) + (size_t)M_LAT * DFF, (const bf16*)(wl + W_2_OFF), M_CTX, DM, DFF}; pg8::CtxOrder S; S.c = C.bid;
                    pg8::EpiResid E; E.X = Xp + (size_t)M_LAT * DM; E.gate = mod + 4 * 12288 + 5 * DM; E.gs = rep_ ? 0.f : 1.f; E.base_lat = Xp + (size_t)M_LAT * DM; E.base_ctx = E.base_lat;
                    pg8::gemm_phase<pg8::EpiResid, pg8::CtxOrder, true, true>(C.lds, g, S, E); }
                else { if (rep_ == 0) tail_work(C, A, layer + 1, MISC); launder(C); phase_norm(C, A, layer + 1, 0, 0, M_LAT, (C.bid - 32) * NWAVES + C.wave, (C.G - 32) * NWAVES); } }
            else if (layer + 1 < DEPTH && rep_ == 0) tail_work(C, A, layer + 1, MISC);
        } SEAM(pb + 9);
    }
    if (IN(PH_FINAL)) phase_final(C, A);
#undef IN
#undef SEAM
#undef A
}

extern "C" void kernel_launch(void* const* d_in, const int* in_sizes, int n_in, void* d_out, int out_size, void* d_ws, size_t ws_size, hipStream_t stream) {
    static int grid = 0;
    if (grid == 0) {
        if (n_in != 32 || out_size != M_LAT * DM || ws_size < WS_END) { fprintf(stderr, "kernel_launch: unexpected shapes (n_in %d, out %d, ws %zu); nothing launched\n", n_in, out_size, ws_size); grid = -1; return; }
        int dev = 0, cus = 0, per_cu = 0;
        if (hipGetDevice(&dev) != hipSuccess || hipDeviceGetAttribute(&cus, hipDeviceAttributeMultiprocessorCount, dev) != hipSuccess) { grid = -1; return; }
        if (hipFuncSetAttribute((const void*)mk_fwd, hipFuncAttributeMaxDynamicSharedMemorySize, LDS_BYTES) != hipSuccess) { fprintf(stderr, "kernel_launch: hipFuncSetAttribute failed\n"); grid = -1; return; }
        if (hipOccupancyMaxActiveBlocksPerMultiprocessor(&per_cu, (const void*)mk_fwd, NTHR, LDS_BYTES) != hipSuccess || per_cu < 1) { fprintf(stderr, "kernel_launch: occupancy query says %d blocks per CU\n", per_cu); }
        (void)hipGetLastError();
        grid = cus;
    }
    if (grid < 0) return;
    if (hipMemsetAsync((char*)d_ws + WS_CTL, 0, CTL_ZERO_BYTES, stream) != hipSuccess) { fprintf(stderr, "kernel_launch: memset failed\n"); return; }
    Args a{};
    for (int i = 0; i < 32; ++i) a.in[i] = (const float*)d_in[i];
    a.out = (float*)d_out; a.ws = (unsigned char*)d_ws;
#if MK_SPLIT
    for (int ph = 0; ph < N_PHASES; ++ph) { a.ph_lo = ph; a.ph_hi = ph + 1; hipLaunchKernelGGL(mk_fwd, dim3(grid), dim3(NTHR), LDS_BYTES, stream, a); }
#else
    a.ph_lo = 0; a.ph_hi = N_PHASES; hipLaunchKernelGGL(mk_fwd, dim3(grid), dim3(NTHR), LDS_BYTES, stream, a);
#endif
    const hipError_t le = hipPeekAtLastError();
    if (le != hipSuccess) fprintf(stderr, "kernel_launch: launch failed: %s\n", hipGetErrorName(le));
}
```

```cpp
#include <hip/hip_runtime.h>
#include <cstdio>
#include <cstdint>
namespace pg8 {
#define PG8_LAS __attribute__((address_space(3)))
typedef unsigned short bf16_t;
typedef short bf16x8 __attribute__((ext_vector_type(8)));
typedef float f32x4 __attribute__((ext_vector_type(4)));
typedef unsigned u32x4 __attribute__((ext_vector_type(4)));
constexpr int BM = 256, BK = 64, HALF = 128, HTB = HALF * BK * 2  , STAGE_BYTES = 8 * HTB, NXCD = 8, WGM = 8;

__host__ __device__ __forceinline__ int lds_byte(int r, int c) { const int st = (r >> 4) * 2 + (c >> 5), rr = r & 15, cc = c & 31, ob = rr * 64 + cc * 2; return st * 1024 + (ob ^ (((ob >> 9) & 1) << 5)); }
__host__ __device__ __forceinline__ void stage_rc(int b, int& R, int& C) { const int st = b / 1024, sb = b % 1024, swz = sb ^ (((sb >> 9) & 1) << 5); R = (st >> 1) * 16 + swz / 64; C = (st & 1) * 32 + (swz % 64) / 2; }
__host__ __device__ __forceinline__ int perm32(int rho) { const int n = rho >> 4, i = rho & 15; return 8 * (i >> 2) + 4 * n + (i & 3); }

struct Unit { int pm, pn; };
struct Gemm { const bf16_t* A; const bf16_t* Bt; int M, N, K; };

struct StaticOrder {
    int nM, nN, nwg, G, c, wgm;
    __host__ __device__ void init(int M, int N, int G_, int c_, int wgm_ = WGM) { nM = M / BM; nN = N / BM; nwg = nM * nN; G = G_; c = c_; wgm = wgm_; }
    __host__ __device__ bool next(int i, Unit& u) const {
        const long L = (long)i * G + c; if (L >= nwg) return false;
        int wgid = (int)L; { const int q = nwg / NXCD, r = nwg % NXCD, xcd = wgid % NXCD, off = wgid / NXCD; wgid = (xcd < r ? xcd * (q + 1) : r * (q + 1) + (xcd - r) * q) + off; }
        const int nig = wgm * nN, gid = wgid / nig, fm = gid * wgm, gsz = (nM - fm) < wgm ? (nM - fm) : wgm;
        u.pm = fm + ((wgid % nig) % gsz); u.pn = (wgid % nig) / gsz; return true;
    }
    __device__ __forceinline__ void a_ready(const Unit&) const {}
    __device__ __forceinline__ void done(const Unit&) const {}
};

__device__ __forceinline__ unsigned cvt_pk_bf16(float lo, float hi) { unsigned r; asm volatile("v_cvt_pk_bf16_f32 %0, %1, %2" : "=v"(r) : "v"(lo), "v"(hi)); return r; }
typedef float f32x2 __attribute__((ext_vector_type(2)));
template <int ACT  > struct EpiStoreBf16 {
    static constexpr bool PERM = true, AFTER_DRAIN = false;
    bf16_t* O; int ldc; const float* rope;
    __device__ __forceinline__ void operator()(const f32x4 (&acc)[2][2][4][2], const Unit& u, int wr, int wc, int fr, int fq) const {
        const int row0 = u.pm * BM + wr * 64 + fr; const int col0 = u.pn * BM + wc * 32 + 8 * fq;
        const bool roped = (ACT == 0) && rope != nullptr && u.pm < 64 && u.pn < 3;
#pragma unroll
        for (int ai = 0; ai < 2; ++ai)
#pragma unroll
            for (int m = 0; m < 4; ++m) { const int row = row0 + ai * HALF + m * 16; bf16_t* rowp = O + (size_t)row * ldc + col0;
                f32x4 c0 = {1.f, 1.f, 1.f, 1.f}, c1 = c0, s0 = {0.f, 0.f, 0.f, 0.f}, s1 = s0;
                if (roped) { const int t = row & 4095, pos = (wc & 1) ? (t & 63) : (t >> 6); const float* tp = rope + pos * 16 + 8 * (fq & 1);
                    c0 = *(const f32x4*)tp; c1 = *(const f32x4*)(tp + 4); s0 = *(const f32x4*)(tp + 1024); s1 = *(const f32x4*)(tp + 1028); if (fq < 2) { s0 = -s0; s1 = -s1; } }
#pragma unroll
                for (int bj = 0; bj < 2; ++bj) { f32x4 v0 = acc[ai][bj][m][0], v1 = acc[ai][bj][m][1];
                    if (ACT == 1) {
#pragma unroll
                        for (int j = 0; j < 4; ++j) { const float a = fmaxf(v0[j], 0.f), b = fmaxf(v1[j], 0.f); v0[j] = a * a; v1[j] = b * b; } }
                    if (roped && (u.pn < 2 || bj == 0)) { f32x4 p0, p1;
#pragma unroll
                        for (int j = 0; j < 4; ++j) { p0[j] = __shfl_xor(v0[j], 32); p1[j] = __shfl_xor(v1[j], 32); }
                        v0 = v0 * c0 + p0 * s0; v1 = v1 * c1 + p1 * s1; }
                    u32x4 w; w.x = cvt_pk_bf16(v0[0], v0[1]); w.y = cvt_pk_bf16(v0[2], v0[3]); w.z = cvt_pk_bf16(v1[0], v1[1]); w.w = cvt_pk_bf16(v1[2], v1[3]);
                    *(u32x4*)(rowp + bj * HALF) = w; } }
    }
};
typedef unsigned u32x2 __attribute__((ext_vector_type(2)));
__device__ __forceinline__ f32x4 bf4_to_f32(u32x2 w) { f32x4 r; r[0] = __builtin_bit_cast(float, w.x << 16); r[1] = __builtin_bit_cast(float, w.x & 0xffff0000u); r[2] = __builtin_bit_cast(float, w.y << 16); r[3] = __builtin_bit_cast(float, w.y & 0xffff0000u); return r; }
struct EpiResid {
    static constexpr bool PERM = false, AFTER_DRAIN = false;
    bf16_t* X; const float* gate; float gs; const void* base_lat; const void* base_ctx; int base_f32;
    template <bool F32> __device__ __forceinline__ void run(const f32x4 (&acc)[2][2][4][2], const Unit& u, int wr, int wc, int fr, int fq, const void* sbase) const {
        const int row0 = u.pm * BM + wr * 64 + fr, col0 = u.pn * BM + wc * 32 + 4 * fq;
        const int b = (u.pm < 64) ? (u.pm >> 4) : 4;
        const float* gp = gate + (size_t)b * 12288 + col0;
        f32x4 gv[2][2];
#pragma unroll
        for (int bj = 0; bj < 2; ++bj)
#pragma unroll
            for (int n = 0; n < 2; ++n) gv[bj][n] = *(const f32x4*)(gp + bj * HALF + n * 16) * gs;
#pragma unroll
        for (int ai = 0; ai < 2; ++ai)
#pragma unroll
            for (int m = 0; m < 4; ++m) { const int rr = row0 + ai * HALF + m * 16; const size_t ro = (size_t)rr * 2048 + col0;
#pragma unroll
                for (int bj = 0; bj < 2; ++bj)
#pragma unroll
                    for (int n = 0; n < 2; ++n) { const size_t o = ro + bj * HALF + n * 16; f32x4 x;
                        if (F32) x = *(const f32x4*)((const float*)sbase + o); else x = bf4_to_f32(*(const u32x2*)((const bf16_t*)sbase + o));
                        x = x + gv[bj][n] * acc[ai][bj][m][n];
                        u32x2 w; w.x = cvt_pk_bf16(x[0], x[1]); w.y = cvt_pk_bf16(x[2], x[3]); *(u32x2*)(X + o) = w; }
                if (m & 1) asm volatile("" ::: "memory"); }
    }
    __device__ __forceinline__ void operator()(const f32x4 (&acc)[2][2][4][2], const Unit& u, int wr, int wc, int fr, int fq) const {
        const void* bl_ = base_lat; const void* bc_ = base_ctx; const void* sbase = (u.pm < 64) ? bl_ : bc_;
        if (base_f32) run<true>(acc, u, wr, wc, fr, fq, sbase); else run<false>(acc, u, wr, wc, fr, fq, sbase);
    }
};

struct EpiResidSK {
    static constexpr bool PERM = false, AFTER_DRAIN = false;
    bf16_t* X; const float* gate; float gs; float* part; unsigned* flag;
    __device__ __forceinline__ void operator()(const f32x4 (&acc)[2][2][4][2], const Unit& u, int wr, int wc, int fr, int fq) const {
        const int ks = u.pn >> 8, pn = u.pn & 255, t = u.pm * 8 + pn;
        const int lrow0 = wr * 64 + fr, lcol0 = wc * 32 + 4 * fq;
        float* pt = part + (size_t)t * 65536 + (size_t)lrow0 * 256 + lcol0; unsigned* fl = flag + 64 * t;
        if (ks == 1) {
#pragma unroll
            for (int ai = 0; ai < 2; ++ai)
#pragma unroll
                for (int m = 0; m < 4; ++m)
#pragma unroll
                    for (int bj = 0; bj < 2; ++bj)
#pragma unroll
                        for (int n = 0; n < 2; ++n) *(f32x4*)(pt + (ai * HALF + m * 16) * 256 + bj * HALF + n * 16) = acc[ai][bj][m][n];
            asm volatile("s_waitcnt vmcnt(0)" ::: "memory"); __builtin_amdgcn_s_barrier();
            if (threadIdx.x == 0) { __builtin_amdgcn_fence(__ATOMIC_RELEASE, "agent"); asm volatile("s_waitcnt vmcnt(0)" ::: "memory"); __hip_atomic_fetch_add(fl, 1u, __ATOMIC_RELAXED, __HIP_MEMORY_SCOPE_AGENT); }
            return; }
        const int row0 = u.pm * BM + lrow0, col0 = pn * BM + lcol0;
        const float* gp = gate + col0;
        f32x4 gv[2][2];
#pragma unroll
        for (int bj = 0; bj < 2; ++bj)
#pragma unroll
            for (int n = 0; n < 2; ++n) gv[bj][n] = *(const f32x4*)(gp + bj * HALF + n * 16) * gs;
        { unsigned sp = 0; while (__hip_atomic_load(fl, __ATOMIC_RELAXED, __HIP_MEMORY_SCOPE_AGENT) == 0u) { __builtin_amdgcn_s_sleep(2); if (++sp > (1u << 22)) break; }
          __builtin_amdgcn_fence(__ATOMIC_ACQUIRE, "agent"); }
        __builtin_amdgcn_s_barrier();
#pragma unroll
        for (int ai = 0; ai < 2; ++ai)
#pragma unroll
            for (int m = 0; m < 4; ++m) { const int rr = row0 + ai * HALF + m * 16; bf16_t* rowp = X + (size_t)rr * 2048 + col0; const float* pp = pt + (ai * HALF + m * 16) * 256;
#pragma unroll
                for (int bj = 0; bj < 2; ++bj)
#pragma unroll
                    for (int n = 0; n < 2; ++n) { f32x4 x = bf4_to_f32(*(const u32x2*)(rowp + bj * HALF + n * 16)); const f32x4 pv = *(const f32x4*)(pp + bj * HALF + n * 16); x = x + gv[bj][n] * (acc[ai][bj][m][n] + pv); u32x2 w; w.x = cvt_pk_bf16(x[0], x[1]); w.y = cvt_pk_bf16(x[2], x[3]); *(u32x2*)(rowp + bj * HALF + n * 16) = w; }
                if (m & 1) asm volatile("" ::: "memory"); }
    }
};

template <class Epi, class Sched, bool ALIGN_EPI = false, bool SP2 = false, bool SPLITK = false>
__device__ __forceinline__ void gemm_phase(PG8_LAS unsigned char* lds, const Gemm g, const Sched& S, const Epi& E) {
    int tid_ = threadIdx.x; asm volatile("" : "+v"(tid_));
    const int tid = tid_, wid = __builtin_amdgcn_readfirstlane(tid >> 6), lane = tid & 63, wr = wid >> 2, wc = wid & 3, fr = lane & 15, fq = lane >> 4;
    const int K = g.K, nt = K / BK, ld = SPLITK ? 2 * K : K;
    unsigned voffA[2], voffB[2];
#pragma unroll
    for (int i = 0; i < 2; ++i) { int R, C; stage_rc(tid * 16 + i * 8192, R, C); const int Rb = Epi::PERM ? ((R & ~31) + perm32(R & 31)) : R;
        voffA[i] = (unsigned)(R * ld + C) * 2u; voffB[i] = (unsigned)(Rb * ld + C) * 2u; }
    const size_t kstep = (size_t)(BK * 2);
    const size_t hstep = (size_t)HALF * ld * 2;
    const size_t tstep = 2 * hstep;
    const unsigned ldsw = (unsigned)wid * 1024u;
    const int aoff = lds_byte(wr * 64 + fr, fq * 8), boff = lds_byte(wc * 32 + fr, fq * 8);
#define PG8_SA(b, h) (((b) * 2 + (h)) * HTB)
#define PG8_SB(b, h) ((4 + (b) * 2 + (h)) * HTB)
#define PG8_STAGE(bufoff, gbase, voff) do { _Pragma("unroll") for (int _i = 0; _i < 2; ++_i) \
        __builtin_amdgcn_global_load_lds((const unsigned*)((const char*)(gbase) + (voff)[_i]), (PG8_LAS unsigned*)(lds + (bufoff) + ldsw + _i * 8192), 16, 0, 0); } while (0)
#define PG8_LDA(dst, b, h) do { _Pragma("unroll") for (int m = 0; m < 4; ++m) _Pragma("unroll") for (int k = 0; k < 2; ++k) dst[m][k] = *(const PG8_LAS bf16x8*)(lds + PG8_SA(b, h) + aoff + m * 2048 + k * 1024); } while (0)
#define PG8_LDB(dst, b, h) do { _Pragma("unroll") for (int n = 0; n < 2; ++n) _Pragma("unroll") for (int k = 0; k < 2; ++k) dst[n][k] = *(const PG8_LAS bf16x8*)(lds + PG8_SB(b, h) + boff + n * 2048 + k * 1024); } while (0)
#define PG8_MMA(ai, bj, At, Bt) do { __builtin_amdgcn_s_setprio(1); _Pragma("unroll") for (int m = 0; m < 4; ++m) _Pragma("unroll") for (int n = 0; n < 2; ++n) _Pragma("unroll") for (int k = 0; k < 2; ++k) \
        acc[ai][bj][m][n] = __builtin_amdgcn_mfma_f32_16x16x32_bf16(Bt[n][k], At[m][k], acc[ai][bj][m][n], 0, 0, 0); __builtin_amdgcn_s_setprio(0); } while (0)
#define PG8_WAIT_V(n) asm volatile("s_waitcnt vmcnt(" #n ")" ::: "memory")
#define PG8_WAIT_L(n) asm volatile("s_waitcnt lgkmcnt(" #n ")" ::: "memory")
#define PG8_BAR __builtin_amdgcn_s_barrier()
#define PG8_SCHED __builtin_amdgcn_sched_barrier(0)
    Unit cur, nxt; int ui = 0;
    if (!S.next(0, cur)) return;
    f32x4 acc[2][2][4][2];
#pragma unroll
    for (int a = 0; a < 2; ++a)
#pragma unroll
        for (int b = 0; b < 2; ++b)
#pragma unroll
            for (int m = 0; m < 4; ++m)
#pragma unroll
                for (int n = 0; n < 2; ++n) acc[a][b][m][n] = (f32x4){0.f, 0.f, 0.f, 0.f};
    bf16x8 At[4][2], B0[2][2], B1[2][2];
#define PG8_UA(u) ((const char*)g.A + (size_t)(u).pm * tstep + (SPLITK ? (size_t)((u).pn >> 8) * (size_t)K * 2 : (size_t)0))
#define PG8_UB(u) ((const char*)g.Bt + (size_t)(SPLITK ? ((u).pn & 255) : (u).pn) * tstep + (SPLITK ? (size_t)((u).pn >> 8) * (size_t)K * 2 : (size_t)0))
    const char* cA = PG8_UA(cur); const char* cB = PG8_UB(cur);
    S.a_ready(cur);
    if constexpr (SP2) {
        PG8_STAGE(PG8_SB(0, 0), cB, voffB); PG8_STAGE(PG8_SB(0, 1), cB + hstep, voffB); PG8_STAGE(PG8_SA(0, 0), cA, voffA); PG8_STAGE(PG8_SA(0, 1), cA + hstep, voffA);
        if (wr == 1) PG8_BAR;
        PG8_WAIT_V(2); PG8_BAR;
        PG8_STAGE(PG8_SB(1, 0), cB + kstep, voffB); PG8_STAGE(PG8_SA(1, 0), cA + kstep, voffA); PG8_STAGE(PG8_SB(1, 1), cB + hstep + kstep, voffB);
        PG8_WAIT_V(6); PG8_BAR;
    } else {
        PG8_STAGE(PG8_SB(0, 0), cB, voffB); PG8_STAGE(PG8_SA(0, 0), cA, voffA); PG8_STAGE(PG8_SB(0, 1), cB + hstep, voffB); PG8_STAGE(PG8_SA(0, 1), cA + hstep, voffA);
        if (wr == 1) PG8_BAR;
        PG8_WAIT_V(4); PG8_BAR;
        PG8_STAGE(PG8_SB(1, 0), cB + kstep, voffB); PG8_STAGE(PG8_SA(1, 0), cA + kstep, voffA); PG8_STAGE(PG8_SB(1, 1), cB + hstep + kstep, voffB);
        PG8_WAIT_V(6); PG8_BAR;
    }
    for (;;) {
        const bool has_next = S.next(ui + 1, nxt);
        const char* nA = has_next ? PG8_UA(nxt) : cA; const char* nB = has_next ? PG8_UB(nxt) : cB;
        for (int t = 0; t < nt; t += 2) {
            const bool last = (t == nt - 2);
            const char* a1 = cA + (size_t)(t + 1) * kstep;
            const char* a2 = last ? nA : cA + (size_t)(t + 2) * kstep; const char* b2 = last ? nB : cB + (size_t)(t + 2) * kstep;
            const char* a3 = a2 + kstep; const char* b3 = b2 + kstep;
            if (last && has_next) S.a_ready(nxt);
            if constexpr (SP2) {
            PG8_LDB(B0, 0, 0); PG8_LDB(B1, 0, 1); PG8_SCHED; PG8_LDA(At, 0, 0); PG8_STAGE(PG8_SA(1, 1), a1 + hstep, voffA);
            PG8_WAIT_V(8); PG8_WAIT_L(0); PG8_BAR; PG8_MMA(0, 0, At, B0); PG8_MMA(0, 1, At, B1); PG8_BAR; PG8_SCHED;
            PG8_LDA(At, 0, 1); PG8_STAGE(PG8_SB(0, 0), b2, voffB); PG8_STAGE(PG8_SB(0, 1), b2 + hstep, voffB); PG8_STAGE(PG8_SA(0, 0), a2, voffA);
            PG8_WAIT_V(8); PG8_WAIT_L(0); PG8_BAR; PG8_MMA(1, 0, At, B0); PG8_MMA(1, 1, At, B1); PG8_BAR; PG8_SCHED;
            PG8_LDB(B0, 1, 0); PG8_LDB(B1, 1, 1); PG8_SCHED; PG8_LDA(At, 1, 0); PG8_STAGE(PG8_SA(0, 1), a2 + hstep, voffA);
            PG8_WAIT_V(8); PG8_WAIT_L(0); PG8_BAR; PG8_MMA(0, 0, At, B0); PG8_MMA(0, 1, At, B1); PG8_BAR; PG8_SCHED;
            PG8_LDA(At, 1, 1); PG8_STAGE(PG8_SB(1, 0), b3, voffB); PG8_STAGE(PG8_SB(1, 1), b3 + hstep, voffB); PG8_STAGE(PG8_SA(1, 0), a3, voffA);
            PG8_WAIT_V(8); PG8_WAIT_L(0); PG8_BAR; PG8_MMA(1, 0, At, B0); PG8_MMA(1, 1, At, B1); PG8_BAR; PG8_SCHED;
            } else {
            PG8_LDB(B0, 0, 0); PG8_SCHED; PG8_LDA(At, 0, 0); PG8_STAGE(PG8_SA(1, 1), a1 + hstep, voffA);
            PG8_WAIT_L(8); PG8_BAR; PG8_WAIT_L(0); PG8_MMA(0, 0, At, B0); PG8_BAR; PG8_SCHED;
            PG8_LDB(B1, 0, 1); PG8_STAGE(PG8_SB(0, 0), b2, voffB);
            PG8_BAR; PG8_WAIT_L(0); PG8_MMA(0, 1, At, B1); PG8_BAR;
            PG8_LDA(At, 0, 1); PG8_STAGE(PG8_SA(0, 0), a2, voffA);
            PG8_BAR; PG8_WAIT_L(0); PG8_MMA(1, 0, At, B0); PG8_BAR; PG8_SCHED;
            PG8_STAGE(PG8_SB(0, 1), b2 + hstep, voffB);
            PG8_WAIT_V(6); PG8_BAR; PG8_MMA(1, 1, At, B1); PG8_BAR;
            PG8_LDB(B0, 1, 0); PG8_SCHED; PG8_LDA(At, 1, 0); PG8_STAGE(PG8_SA(0, 1), a2 + hstep, voffA);
            PG8_WAIT_L(8); PG8_BAR; PG8_WAIT_L(0); PG8_MMA(0, 0, At, B0); PG8_BAR; PG8_SCHED;
            PG8_LDB(B1, 1, 1); PG8_STAGE(PG8_SB(1, 0), b3, voffB);
            PG8_BAR; PG8_WAIT_L(0); PG8_MMA(0, 1, At, B1); PG8_BAR;
            PG8_LDA(At, 1, 1); PG8_STAGE(PG8_SA(1, 0), a3, voffA);
            PG8_BAR; PG8_WAIT_L(0); PG8_MMA(1, 0, At, B0); PG8_BAR; PG8_SCHED;
            PG8_STAGE(PG8_SB(1, 1), b3 + hstep, voffB);
            PG8_WAIT_V(6); PG8_BAR; PG8_MMA(1, 1, At, B1); PG8_BAR;
            }
        }
        if constexpr (ALIGN_EPI) { if (wr == 0) PG8_BAR; }
        if constexpr (!Epi::AFTER_DRAIN) { E(acc, cur, wr, wc, fr, fq); S.done(cur); }
        if (!has_next) break;
#pragma unroll
        for (int a = 0; a < 2; ++a)
#pragma unroll
            for (int b = 0; b < 2; ++b)
#pragma unroll
                for (int m = 0; m < 4; ++m)
#pragma unroll
                    for (int n = 0; n < 2; ++n) acc[a][b][m][n] = (f32x4){0.f, 0.f, 0.f, 0.f};
        cur = nxt; cA = nA; cB = nB; ++ui;
        if constexpr (ALIGN_EPI) { if (wr == 1) PG8_BAR; }
    }
    PG8_WAIT_V(0);
    if constexpr (!ALIGN_EPI) { if (wr == 0) PG8_BAR; }
    PG8_BAR;
    if constexpr (Epi::AFTER_DRAIN) { E.fused(acc, cur, wr, wc, fr, fq, lds, wid, lane); S.done(cur); }
#undef PG8_UA
#undef PG8_UB
#undef PG8_SA
#undef PG8_SB
#undef PG8_STAGE
#undef PG8_LDA
#undef PG8_LDB
#undef PG8_MMA
#undef PG8_WAIT_V
#undef PG8_WAIT_L
#undef PG8_BAR
#undef PG8_SCHED
}
}
#define GAS __attribute__((address_space(1)))
#define LAS __attribute__((address_space(3)))
typedef unsigned short bf16;
typedef unsigned v4u __attribute__((ext_vector_type(4)));
typedef float f32x4 __attribute__((ext_vector_type(4)));
typedef short bf16x8 __attribute__((ext_vector_type(8)));
typedef GAS unsigned gu32;
typedef GAS unsigned long long gu64;
#define RLX_AGENT __ATOMIC_RELAXED, __HIP_MEMORY_SCOPE_AGENT
#define LDS_WAIT() asm volatile("s_waitcnt lgkmcnt(0)" ::: "memory")
#define VM_WAIT() asm volatile("s_waitcnt vmcnt(0)" ::: "memory")
__device__ __forceinline__ unsigned long long rt() { return __builtin_amdgcn_s_memrealtime(); }
__device__ __forceinline__ unsigned f2bf(float f) { unsigned u = __builtin_bit_cast(unsigned, f); return (u + 0x7fffu + ((u >> 16) & 1u)) >> 16; }
__device__ __forceinline__ unsigned pk2(float lo, float hi) { unsigned r; asm("v_cvt_pk_bf16_f32 %0, %1, %2" : "=v"(r) : "v"(lo), "v"(hi)); return r; }
#define XB_TMO      128
#define XB_XCNT(j)  (256  + 64 * (j))
#define XB_XSUB(j)  (1280 + 64 * (j))
#define XB_XGEN(j)  (2304 + 64 * (j))
#define XB_TOP      3328
#define XB_TOPGEN   3392
#define XCD_BAR_WORDS 3456
#define XB_SPIN_CAP (1u << 18)

__device__ __forceinline__ unsigned xb_ld(unsigned* p)              { return __hip_atomic_load(p, __ATOMIC_RELAXED, __HIP_MEMORY_SCOPE_AGENT); }
__device__ __forceinline__ unsigned xb_add(unsigned* p, unsigned v) { return __hip_atomic_fetch_add(p, v, __ATOMIC_RELAXED, __HIP_MEMORY_SCOPE_AGENT); }
__device__ __forceinline__ unsigned xb_xcc_id() { return (unsigned)__builtin_amdgcn_s_getreg((3 << 11) | 20) & 0xFu; }
#define XB_SPIN(cond, bar) do { unsigned _sp = 0; while (cond) { __builtin_amdgcn_s_sleep(1); \
    if ((++_sp & 255u) == 0u) { if (xb_ld(&(bar)[XB_TMO])) break; if (_sp > XB_SPIN_CAP) { atomicAdd(&(bar)[XB_TMO], 1u); break; } } } } while (0)

struct XcdBarrier {
    unsigned* bar; unsigned x;
    volatile LAS unsigned* st;
};

__device__ __forceinline__ XcdBarrier xcd_barrier_post(unsigned* bar, volatile LAS unsigned* st) {
    XcdBarrier b; b.bar = bar; b.x = xb_xcc_id(); b.st = st;
    if (threadIdx.x == 0) (void)xb_add(&bar[XB_XCNT(b.x)], 1u);
    return b;
}
__device__ __forceinline__ void xcd_barrier_complete(unsigned* bar, unsigned x, unsigned& nloc, unsigned& nx) {
    const unsigned G = gridDim.x * gridDim.y * gridDim.z;
    unsigned sum, cnt, mine, sp = 0u;
    for (;;) {
        sum = 0u; cnt = 0u; mine = 0u;
#pragma unroll
        for (unsigned j = 0; j < 16; ++j) { const unsigned c = xb_ld(&bar[XB_XCNT(j)]); sum += c; cnt += (c > 0u) ? 1u : 0u; mine = (j == x) ? c : mine; }
        if (sum == G) break;
        __builtin_amdgcn_s_sleep(1);
        if ((++sp & 255u) == 0u) { if (xb_ld(&bar[XB_TMO])) break; if (sp > XB_SPIN_CAP) { atomicAdd(&bar[XB_TMO], 1u); break; } }
    }
    nloc = mine > 0u ? mine : 1u; nx = cnt > 0u ? cnt : 1u;
}

__device__ __forceinline__ void xcd_barrier(const XcdBarrier& b) {
    asm volatile("s_waitcnt vmcnt(0)" ::: "memory");
    __syncthreads();
    if (threadIdx.x == 0) {
        unsigned* bar = b.bar; unsigned bx = b.x; asm volatile("" : "+s"(bar), "+s"(bx));
        __builtin_amdgcn_s_waitcnt(0);
        unsigned nloc = b.st[0], nx = b.st[1];
        if (nloc == 0u) { xcd_barrier_complete(bar, bx, nloc, nx); b.st[0] = nloc; b.st[1] = nx; }
        const unsigned old = xb_add(&bar[XB_XSUB(bx)], 1u);
        const unsigned gen = old / nloc;
        if (old + 1u == (gen + 1u) * nloc) {
            __builtin_amdgcn_fence(__ATOMIC_RELEASE, "agent");
            asm volatile("s_waitcnt vmcnt(0)" ::: "memory");
            const unsigned og = xb_add(&bar[XB_TOP], 1u);
            const unsigned tg = og / nx;
            if (og + 1u == (tg + 1u) * nx) xb_add(&bar[XB_TOPGEN], 1u);
            else XB_SPIN(xb_ld(&bar[XB_TOPGEN]) == tg, bar);
            __builtin_amdgcn_fence(__ATOMIC_ACQUIRE, "agent");
            xb_add(&bar[XB_XGEN(bx)], 1u);
            asm volatile("s_waitcnt vmcnt(0)" ::: "memory");
        } else {
            XB_SPIN(xb_ld(&bar[XB_XGEN(bx)]) == gen, bar);
            __builtin_amdgcn_fence(__ATOMIC_ACQUIRE, "agent");
            asm volatile("s_waitcnt vmcnt(0)" ::: "memory");
        }
    }
    __syncthreads();
}

constexpr int DM = 2048, NB = 4, SEQ = 4096, LC = 256, DEPTH = 4, DFF = 8192;
constexpr int M_LAT = NB * SEQ, M_CTX = NB * LC, M_ALL = M_LAT + M_CTX;
constexpr int N_IN = 5392, N_INP = 5632;
constexpr int OFF_HY = 768, OFF_NA = 2304, OFF_SSM = 3840;
constexpr int NWAVES = 8, NTHR = 512;
constexpr float EPS = 1e-6f;

constexpr size_t MiB = 1u << 20;
constexpr size_t WS_CTL = 0, CTL_ZERO_BYTES = 1 * MiB;
constexpr size_t WS_MOD = 1 * MiB;
constexpr size_t WS_MODP = 2 * MiB;
constexpr size_t WS_ROPE = 10 * MiB;
constexpr size_t WS_GLAT = 11 * MiB;
constexpr size_t WS_GCTX = 43 * MiB;
constexpr size_t WS_GCTX1 = 28 * MiB;
constexpr size_t WS_W4T = 46 * MiB;
constexpr size_t WS_W = 48 * MiB;
constexpr size_t W_LAYER = 94 * MiB, W_OUT_OFF = 22 * MiB, W_1_OFF = 30 * MiB, W_2_OFF = 62 * MiB;
constexpr size_t WS_X = 424 * MiB;
constexpr size_t WS_XN = 560 * MiB;
constexpr size_t WS_P = 628 * MiB;
constexpr size_t WS_Y = 815 * MiB;
constexpr size_t WS_H = 883 * MiB;
constexpr size_t WS_XBC = 1155 * MiB;
constexpr size_t WS_XBCT = WS_XBC + 34 * MiB;
constexpr size_t WS_DT = 1223 * MiB;
constexpr size_t WS_YF = 1226 * MiB;
constexpr size_t WS_HIN = WS_YF;
constexpr size_t WS_YB = 1260 * MiB;
constexpr size_t WS_CD = WS_YB;
constexpr size_t WS_HU = 1294 * MiB;
constexpr size_t WS_SST = WS_HU;
constexpr size_t WS_Z = 1396 * MiB;
constexpr size_t WS_HUT = 1430 * MiB;
constexpr size_t WS_YT = 1478 * MiB;
constexpr size_t WS_GT = WS_GLAT;
constexpr size_t WS_VT = 1494 * MiB;
constexpr size_t WS_END = 1516 * MiB;
constexpr int CW_BAR = 4096;

constexpr int RING_BYTES = 131072, MISC_OFF = 147456, LDS_BYTES = MISC_OFF + 1024;

constexpr int PH_PRO1 = 0, PH_PRO2 = 1, PH_L0 = 2, PH_PER_LAYER = 10, PH_FINAL = PH_L0 + DEPTH * PH_PER_LAYER, N_PHASES = PH_FINAL + 1;
#ifndef PROBE_REP
#define PROBE_REP -1
#endif
#ifndef MK_SPLIT
#define MK_SPLIT 0
#endif

__device__ __forceinline__ float bf2f(bf16 h) { return __uint_as_float(((unsigned)h) << 16); }
__device__ __forceinline__ float wave_sum(float v) {
#pragma unroll
    for (int o = 1; o < 64; o <<= 1) v += __shfl_xor(v, o);
    return v;
}
__device__ __forceinline__ float wave_max(float v) {
#pragma unroll
    for (int o = 1; o < 64; o <<= 1) v = fmaxf(v, __shfl_xor(v, o));
    return v;
}
__device__ __forceinline__ float silu_f(float v) { return v / (1.f + __expf(-v)); }

struct Ctx {
    LAS unsigned char* lds;
    int tid, lane, wave, G, gw, NGW, bid;
};
__device__ __forceinline__ void launder(Ctx& C) { int t = threadIdx.x, bx = blockIdx.x, gx = gridDim.x; asm volatile("" : "+v"(t), "+s"(bx), "+s"(gx));
    C.tid = t; C.lane = t & 63; C.wave = __builtin_amdgcn_readfirstlane(t >> 6); C.bid = bx; C.G = gx; C.gw = bx * NWAVES + C.wave; C.NGW = gx * NWAVES; }
struct Args { const float* in[32]; float* out; unsigned char* ws; int ph_lo, ph_hi; };
typedef const Args __attribute__((address_space(4))) KArgs;

#define LDS_BARRIER() do { asm volatile("s_waitcnt lgkmcnt(0)" ::: "memory"); __builtin_amdgcn_s_barrier(); asm volatile("" ::: "memory"); } while (0)
__device__ __forceinline__ void transpose_item(const float* W, int K, int N, bf16* WT, LAS float* scr, int kb, int nb, int lane) {
    const int k0 = 64 * kb, n0 = 64 * nb;
    const int nn = n0 + lane; const bool okn = nn < N;
    float tv[64];
#pragma unroll
    for (int i = 0; i < 64; ++i) tv[i] = okn ? W[(size_t)(k0 + i) * N + nn] : 0.f;
#pragma unroll
    for (int i = 0; i < 64; ++i) scr[i * 65 + lane] = tv[i];
    LDS_WAIT(); asm volatile("" ::: "memory");
    const int c = lane & 7;
#pragma unroll
    for (int j = 0; j < 8; ++j) { const int n = (lane >> 3) + 8 * j; const LAS float* s = scr + (8 * c) * 65 + n;
        v4u o; o.x = pk2(s[0 * 65], s[1 * 65]); o.y = pk2(s[2 * 65], s[3 * 65]); o.z = pk2(s[4 * 65], s[5 * 65]); o.w = pk2(s[6 * 65], s[7 * 65]);
        *(v4u*)(WT + (size_t)(n0 + n) * K + k0 + 8 * c) = o; }
    LDS_WAIT(); asm volatile("" ::: "memory");
}

__device__ __forceinline__ void cv_decode(KArgs& A, int layer, int it, const float*& W, bf16*& WT, int& K, int& N, int& kb, int& nb) {
    constexpr int I_IN = 32 * 88, I_OUT = 32 * 32, I_1 = 32 * 128;
    unsigned char* wl = A.ws + WS_W + (size_t)layer * W_LAYER; int r = it;
    if (r < I_IN) { W = A.in[8] + (size_t)layer * DM * N_IN; WT = (bf16*)wl; K = DM; N = N_IN; kb = r / 88; nb = r % 88; return; } r -= I_IN;
    if (r < I_OUT) { W = A.in[9] + (size_t)layer * DM * DM; WT = (bf16*)(wl + W_OUT_OFF); K = DM; N = DM; kb = r / 32; nb = r % 32; return; } r -= I_OUT;
    if (r < I_1) { W = A.in[29] + (size_t)layer * DM * DFF; WT = (bf16*)(wl + W_1_OFF); K = DM; N = DFF; kb = r / 128; nb = r % 128; return; } r -= I_1;
    W = A.in[30] + (size_t)layer * DFF * DM; WT = (bf16*)(wl + W_2_OFF); K = DFF; N = DM; kb = r / 32; nb = r % 32;
}
__device__ __forceinline__ void cv_load(float (&tv)[64], const float* W, int N, int kb, int nb, int lane) {
    const int nn = 64 * nb + lane; const bool okn = nn < N; const float* p = W + (size_t)(64 * kb) * N + nn;
#pragma unroll
    for (int i = 0; i < 64; ++i) tv[i] = okn ? p[(size_t)i * N] : 0.f;
}
__device__ __forceinline__ void cv_store(const float (&tv)[64], bf16* WT, int K, LAS float* scr, int kb, int nb, int lane) {
#pragma unroll
    for (int i = 0; i < 64; ++i) scr[i * 65 + lane] = tv[i];
    LDS_WAIT(); asm volatile("" ::: "memory");
    const int c = lane & 7, k0 = 64 * kb, n0 = 64 * nb;
#pragma unroll
    for (int j = 0; j < 8; ++j) { const int n = (lane >> 3) + 8 * j; const LAS float* s = scr + (8 * c) * 65 + n;
        v4u o; o.x = pk2(s[0 * 65], s[1 * 65]); o.y = pk2(s[2 * 65], s[3 * 65]); o.z = pk2(s[4 * 65], s[5 * 65]); o.w = pk2(s[6 * 65], s[7 * 65]);
        *(v4u*)(WT + (size_t)(n0 + n) * K + k0 + 8 * c) = o; }
    LDS_WAIT(); asm volatile("" ::: "memory");
}
constexpr int CV_ITEMS = 32 * 88 + 32 * 32 + 32 * 128 + 128 * 32;
constexpr int CV_SPLIT = 6600;
__device__ __forceinline__ void convert_items(const Ctx& C, KArgs& A, int layer, LAS float* scr, int widx, int nw, int it_lo = 0, int I_LAYER = CV_ITEMS) {
    int it = it_lo + widx; if (it >= I_LAYER) return;
    const float* W; bf16* WT; int K, N, kb, nb; float tv[64], tn[64];
    cv_decode(A, layer, it, W, WT, K, N, kb, nb); cv_load(tv, W, N, kb, nb, C.lane);
    for (;;) { const int nx = it + nw; const bool more = nx < I_LAYER;
        const float* W2 = W; bf16* WT2 = WT; int K2 = K, N2 = N, kb2 = kb, nb2 = nb;
        if (more) { cv_decode(A, layer, nx, W2, WT2, K2, N2, kb2, nb2); cv_load(tn, W2, N2, kb2, nb2, C.lane); }
        cv_store(tv, WT, K, scr, kb, nb, C.lane);
        if (!more) break;
#pragma unroll
        for (int i = 0; i < 64; ++i) tv[i] = tn[i];
        it = nx; W = W2; WT = WT2; K = K2; N = N2; kb = kb2; nb = nb2; }
}
__device__ __forceinline__ void phase_pro1(const Ctx& C, KArgs& A) {
    LAS float* sl = (LAS float*)C.lds;
    const float* cvec = A.in[1]; const float* cctx = A.in[3]; const float* ada_w = A.in[4];
    float* modp = (float*)(A.ws + WS_MODP);
    for (int sr = 0; sr < ((PROBE_REP == 43) ? 2 : 1); ++sr)
    for (int u = C.bid; u < 768; u += C.G) {
        const int layer = u / 192, r = u % 192, kc = r / 24, nb = r % 24;
        __syncthreads();
        for (int i = C.tid; i < 5 * 256; i += NTHR) { const int b = i >> 8, kk = i & 255, k = kc * 256 + kk; const float v = (b < 4) ? cvec[b * DM + k] : cctx[k]; sl[i] = v / (1.f + expf(-v)); }
        __syncthreads();
        const int n = nb * 512 + C.tid; const float* w = ada_w + ((size_t)layer * DM + kc * 256) * 12288 + n;
        float a0 = 0.f, a1 = 0.f, a2 = 0.f, a3 = 0.f, a4 = 0.f;
#pragma unroll 8
        for (int kk = 0; kk < 256; ++kk) { const float wv = w[(size_t)kk * 12288]; a0 += sl[kk] * wv; a1 += sl[256 + kk] * wv; a2 += sl[512 + kk] * wv; a3 += sl[768 + kk] * wv; a4 += sl[1024 + kk] * wv; }
        float* o = modp + ((size_t)(kc * 4 + layer) * 5) * 12288 + n;
        o[0] = a0; o[12288] = a1; o[2 * 12288] = a2; o[3 * 12288] = a3; o[4 * 12288] = a4;
    }
    __syncthreads();
    if (C.bid == 0) { float* rc = (float*)(A.ws + WS_ROPE); float* rs = rc + 1024;
        for (int i = C.tid; i < 1024; i += NTHR) { const int pos = i >> 4, j = i & 15; const float inv = powf(10000.f, -(float)j / 16.f); const float ang = (float)pos * inv; rc[i] = cosf(ang); rs[i] = sinf(ang); } }
    { const float* w4 = A.in[19]; bf16* w4t = (bf16*)(A.ws + WS_W4T);
      for (int i = C.bid * NTHR + C.tid; i < DEPTH * 2048; i += C.G * NTHR) { const int layer = i >> 11, n = i & 2047; const float* s = w4 + (size_t)layer * 64 * 2048 + n; v4u* d = (v4u*)(w4t + (size_t)i * 64);
#pragma unroll
          for (int q = 0; q < 8; ++q) { v4u o; o.x = pk2(s[(8 * q + 0) * 2048], s[(8 * q + 1) * 2048]); o.y = pk2(s[(8 * q + 2) * 2048], s[(8 * q + 3) * 2048]); o.z = pk2(s[(8 * q + 4) * 2048], s[(8 * q + 5) * 2048]); o.w = pk2(s[(8 * q + 6) * 2048], s[(8 * q + 7) * 2048]); d[q] = o; } } }
    convert_items(C, A, 0, (LAS float*)(C.lds + C.wave * 16896), C.gw, C.NGW);
}
__device__ __forceinline__ void phase_pro2(const Ctx& C, KArgs& A) {
    const float* modp = (const float*)(A.ws + WS_MODP); const float* ada_b = A.in[5]; float* mod = (float*)(A.ws + WS_MOD);
    for (int i = C.bid * NTHR + C.tid; i < DEPTH * 5 * 12288; i += C.G * NTHR) {
        const int layer = i / (5 * 12288), r = i % (5 * 12288), n = r % 12288;
        float s = ada_b[layer * 12288 + n];
#pragma unroll
        for (int kc = 0; kc < 8; ++kc) s += modp[(size_t)(kc * 4 + layer) * 5 * 12288 + r];
        mod[i] = s;
    }
}

__device__ __forceinline__ void norm_row_v(const f32x4 (&v)[8], const float* nw, const float* sh, const float* sc, bf16* orow, int lane) {
    float s = 0.f;
#pragma unroll
    for (int j = 0; j < 8; ++j) s += (v[j].x * v[j].x + v[j].y * v[j].y) + (v[j].z * v[j].z + v[j].w * v[j].w);
    const float rstd = 1.0f / sqrtf(wave_sum(s) * (1.f / DM) + EPS);
#pragma unroll
    for (int j = 0; j < 8; ++j) { const int c4 = lane + 64 * j; const f32x4 w = ((const f32x4*)nw)[c4], a = ((const f32x4*)sc)[c4], b = ((const f32x4*)sh)[c4];
        const f32x4 y = v[j] * rstd * w * (a + 1.0f) + b;
        *(unsigned long long*)(orow + 4 * c4) = (unsigned long long)pk2(y.x, y.y) | ((unsigned long long)pk2(y.z, y.w) << 32); }
}
__device__ __forceinline__ void norm_load(f32x4 (&v)[8], KArgs& A, int layer, int which, int m, int lane) {
    typedef unsigned v2u_ __attribute__((ext_vector_type(2)));
    if (layer == 0 && which == 0) { const f32x4* xr = (const f32x4*)((m < M_LAT) ? A.in[0] + (size_t)m * DM : A.in[2] + (size_t)(m - M_LAT) * DM);
#pragma unroll
        for (int j = 0; j < 8; ++j) v[j] = xr[lane + 64 * j]; }
    else { const v2u_* xr = (const v2u_*)((const bf16*)(A.ws + WS_X) + (size_t)m * DM);
#pragma unroll
        for (int j = 0; j < 8; ++j) { const v2u_ w = xr[lane + 64 * j]; v[j][0] = __uint_as_float(w.x << 16); v[j][1] = __uint_as_float(w.x & 0xffff0000u); v[j][2] = __uint_as_float(w.y << 16); v[j][3] = __uint_as_float(w.y & 0xffff0000u); } }
}
__device__ __forceinline__ void phase_norm(const Ctx& C, KArgs& A, int layer, int which  , int row_lo, int row_hi, int gw, int ngw) {
    bf16* XN = (bf16*)(A.ws + WS_XN);
    const float* nw = A.in[which ? 7 : 6] + layer * DM;
    const float* mod = (const float*)(A.ws + WS_MOD) + (size_t)layer * 5 * 12288 + (which ? 3 * DM : 0);
    int m = row_lo + gw; f32x4 cur[8];
    if (m < row_hi) norm_load(cur, A, layer, which, m, C.lane);
    while (m < row_hi) { const int mn = m + ngw; f32x4 nxt[8];
        if (mn < row_hi) norm_load(nxt, A, layer, which, mn, C.lane);
        const int b = (m < M_LAT) ? (m >> 12) : 4; const float* mb = mod + (size_t)b * 12288;
        norm_row_v(cur, nw, mb, mb + DM, XN + (size_t)m * DM, C.lane);
#pragma unroll
        for (int j = 0; j < 8; ++j) cur[j] = nxt[j];
        m = mn; }
}
__device__ __forceinline__ void phase_final(const Ctx& C, KArgs& A) {
    const float* nw = A.in[31];
    int m = C.gw; f32x4 cur[8];
    if (m < M_LAT) norm_load(cur, A, DEPTH, 1, m, C.lane);
    while (m < M_LAT) { const int mn = m + C.NGW; f32x4 nxt[8];
        if (mn < M_LAT) norm_load(nxt, A, DEPTH, 1, mn, C.lane);
        float s = 0.f;
#pragma unroll
        for (int j = 0; j < 8; ++j) s += (cur[j].x * cur[j].x + cur[j].y * cur[j].y) + (cur[j].z * cur[j].z + cur[j].w * cur[j].w);
        const float rstd = 1.0f / sqrtf(wave_sum(s) * (1.f / DM) + EPS);
        f32x4* o = (f32x4*)(A.out + (size_t)m * DM);
#pragma unroll
        for (int j = 0; j < 8; ++j) { const int c4 = C.lane + 64 * j; o[c4] = cur[j] * rstd * ((const f32x4*)nw)[c4]; }
#pragma unroll
        for (int j = 0; j < 8; ++j) cur[j] = nxt[j];
        m = mn; }
}

__device__ __forceinline__ float hy_filter_hidden(const Ctx& C, KArgs& A, int layer, int L, int t) {
    const int lane = C.lane;
    const float* w1 = A.in[13] + layer * 33 * 64; const float* b1 = A.in[14] + layer * 64; const float* w2 = A.in[15] + layer * 4096; const float* b2 = A.in[16] + layer * 64;
    const float* w3 = A.in[17] + layer * 4096; const float* b3 = A.in[18] + layer * 64; const float* fr = A.in[20] + layer * 64;
    const float tl = (float)t / (float)(L - 1);
    const float wpos = (6.283185307179586f * (float)t) / (float)L;
    float z = 0.f;
    if (lane == 0) z = tl;
    else if (lane <= 32) { const int k = (lane - 1) & 15; const float f = 1e-4f + (float)k * ((15.0f - 1e-4f) / 15.0f); const float a = f * wpos; z = (lane <= 16) ? cosf(a) : -sinf(a); }
    const float frl = fr[lane];
    float pre = b1[lane];
    for (int e = 0; e < 33; ++e) pre += __shfl(z, e) * w1[e * 64 + lane];
    float h = sinf(frl * pre);
    pre = b2[lane];
    for (int i = 0; i < 64; ++i) pre += __shfl(h, i) * w2[i * 64 + lane];
    h = sinf(frl * pre);
    pre = b3[lane];
    for (int i = 0; i < 64; ++i) pre += __shfl(h, i) * w3[i * 64 + lane];
    return sinf(frl * pre);
}
__device__ __forceinline__ void hy_filter_hidden2(const Ctx& C, KArgs& A, int layer, int L, int ta, int tb, float& ha, float& hb) {
    const int lane = C.lane;
    const float* w1 = A.in[13] + layer * 33 * 64; const float* b1 = A.in[14] + layer * 64; const float* w2 = A.in[15] + layer * 4096; const float* b2 = A.in[16] + layer * 64;
    const float* w3 = A.in[17] + layer * 4096; const float* b3 = A.in[18] + layer * 64; const float* fr = A.in[20] + layer * 64;
    float z[2];
#pragma unroll
    for (int p = 0; p < 2; ++p) { const int t = p ? tb : ta; const float tl = (float)t / (float)(L - 1); const float wpos = (6.283185307179586f * (float)t) / (float)L;
        float zz = 0.f;
        if (lane == 0) zz = tl;
        else if (lane <= 32) { const int k = (lane - 1) & 15; const float f = 1e-4f + (float)k * ((15.0f - 1e-4f) / 15.0f); const float a = f * wpos; zz = (lane <= 16) ? cosf(a) : -sinf(a); }
        z[p] = zz; }
    const float frl = fr[lane];
#define HYF_LAYER(W, N0, N1, XA, XB) _Pragma("unroll 1") for (int i0 = (N0); i0 < (N1); i0 += 16) { float w_[16]; \
        _Pragma("unroll") for (int k = 0; k < 16; ++k) w_[k] = (W)[(i0 + k) * 64 + lane]; \
        _Pragma("unroll") for (int k = 0; k < 16; ++k) { pa += __int_as_float(__builtin_amdgcn_readlane(__float_as_int(XA), i0 + k)) * w_[k]; pb += __int_as_float(__builtin_amdgcn_readlane(__float_as_int(XB), i0 + k)) * w_[k]; } }
    float pa = b1[lane], pb = pa;
    HYF_LAYER(w1, 0, 32, z[0], z[1])
    { const float w = w1[32 * 64 + lane]; pa += __int_as_float(__builtin_amdgcn_readlane(__float_as_int(z[0]), 32)) * w; pb += __int_as_float(__builtin_amdgcn_readlane(__float_as_int(z[1]), 32)) * w; }
    float xa = sinf(frl * pa), xb = sinf(frl * pb);
    pa = b2[lane]; pb = pa;
    HYF_LAYER(w2, 0, 64, xa, xb)
    xa = sinf(frl * pa); xb = sinf(frl * pb);
    pa = b3[lane]; pb = pa;
    HYF_LAYER(w3, 0, 64, xa, xb)
#undef HYF_LAYER
    ha = sinf(frl * pa); hb = sinf(frl * pb);
}
__device__ __forceinline__ void hy_filter_core(const Ctx& C, KArgs& A, int layer, int L, int t, float (&acc)[32]) {
    const int lane = C.lane; const float* w4 = A.in[19] + (size_t)layer * 64 * 2048;
    const float tl = (float)t / (float)(L - 1);
    const float h = hy_filter_hidden(C, A, layer, L, t);
#pragma unroll
    for (int cc = 0; cc < 32; ++cc) acc[cc] = 0.f;
    for (int i = 0; i < 64; ++i) { const float hi = __shfl(h, i); const float* wr = w4 + (size_t)i * 2048 + lane;
#pragma unroll
        for (int cc = 0; cc < 32; ++cc) acc[cc] += hi * wr[cc * 64]; }
    const float dmin = 3.0701134573253945f, dmax = 15.350567286626973f;
#pragma unroll
    for (int cc = 0; cc < 32; ++cc) { const int c = (cc * 64 + lane) & 511; const float delta = dmin + (float)c * ((dmax - dmin) / 511.0f); acc[cc] *= expf(-tl * delta); }
}
__device__ __forceinline__ void hy_filter_item(const Ctx& C, KArgs& A, int layer, int L, int t, float* G) {
    float acc[32]; hy_filter_core(C, A, layer, L, t, acc);
    const float* skip = A.in[21] + layer * 1024; const int W = 2 * L - 1, lane = C.lane;
#pragma unroll
    for (int cc = 0; cc < 32; ++cc) { const int col = cc * 64 + lane, o = col >> 10, r = (col >> 9) & 1, c = col & 511;
        float val = acc[cc];
        if (r == 0) { if (t == 0) val += skip[o * 512 + c]; G[((size_t)o * W + (L - 1 + t)) * 512 + c] = val; }
        else if (t > 0) G[((size_t)o * W + (L - 1 - t)) * 512 + c] = val; }
}
template <int L>
__device__ __forceinline__ void hy_filter_unit16(const Ctx& C, KArgs& A, int layer, int t0, void* Gout) {
    LAS bf16* H3 = (LAS bf16*)C.lds;
    __syncthreads();
    { const int pi = 2 * C.wave; float ha, hb; hy_filter_hidden2(C, A, layer, L, t0 + pi, t0 + pi + 1, ha, hb); H3[pi * 64 + C.lane] = (bf16)f2bf(ha); H3[(pi + 1) * 64 + C.lane] = (bf16)f2bf(hb); }
    __syncthreads();
    int lane = C.lane; asm volatile("" : "+v"(lane));
    const int li = lane & 15, g = lane >> 4, tq = t0 + 4 * g;
    const bf16x8 ha0 = *(const LAS bf16x8*)(H3 + li * 64 + 8 * g), ha1 = *(const LAS bf16x8*)(H3 + li * 64 + 32 + 8 * g);
    const bf16* w4t = (const bf16*)(A.ws + WS_W4T) + (size_t)layer * 2048 * 64; const float* skip = A.in[21] + layer * 1024;
    const float dmin = 3.0701134573253945f, dmax = 15.350567286626973f, inv = 1.0f / (float)(L - 1);
#pragma unroll 1
    for (int i8 = 0; i8 < 16; i8 += 8) { bf16x8 wv[8][2];
#pragma unroll
      for (int k = 0; k < 8; ++k) { const bf16* wr = w4t + (size_t)(16 * (C.wave * 16 + i8 + k) + li) * 64 + 8 * g; wv[k][0] = *(const bf16x8*)wr; wv[k][1] = *(const bf16x8*)(wr + 32); }
#pragma unroll
      for (int k = 0; k < 8; ++k) { const int i = i8 + k; const int n = 16 * (C.wave * 16 + i) + li;
        f32x4 acc = __builtin_amdgcn_mfma_f32_16x16x32_bf16(ha0, wv[k][0], (f32x4){0.f, 0.f, 0.f, 0.f}, 0, 0, 0);
        acc = __builtin_amdgcn_mfma_f32_16x16x32_bf16(ha1, wv[k][1], acc, 0, 0, 0);
        const int o = n >> 10, dir = (n >> 9) & 1, c = n & 511; const float delta = dmin + (float)c * ((dmax - dmin) / 511.0f);
        float v[4];
#pragma unroll
        for (int r = 0; r < 4; ++r) v[r] = acc[r] * expf(-((float)(tq + r) * inv) * delta);
        if (dir == 0 && tq == 0) v[0] += skip[o * 512 + c];
        if (L == SEQ) { bf16* gp = (bf16*)Gout + ((size_t)(o * 512 + c)) * 8192 + (dir ? 0 : 4096) + tq;
            *(unsigned long long*)gp = (unsigned long long)pk2(v[0], v[1]) | ((unsigned long long)pk2(v[2], v[3]) << 32); }
        else { float* gq = (float*)Gout + (size_t)o * (2 * L - 1) * 512 + c;
#pragma unroll
            for (int r = 0; r < 4; ++r) { const int t = tq + r; if (dir == 0) gq[(size_t)(L - 1 + t) * 512] = v[r]; else if (t > 0) gq[(size_t)(L - 1 - t) * 512] = v[r]; } } } }
}

constexpr int HY_CP_STRIDE = 16384 + 64;
constexpr int HY_U_OFF = 4 * HY_CP_STRIDE;
constexpr int HY_U_PITCH = 8992;
struct HyF { v4u w0, w1; };
__device__ __forceinline__ void hy_load_filter(HyF& f, const bf16* grow, int tid) { const v4u* gp = (const v4u*)(grow + 16 * tid); f.w0 = gp[0]; f.w1 = gp[1]; }
__device__ __forceinline__ void hy_store_filter(LAS unsigned char* lds, const HyF& f, int tid) {
    const v4u w0 = f.w0, w1 = f.w1;
    unsigned e[16];
    e[0] = w0.x & 0xffffu; e[1] = w0.x >> 16; e[2] = w0.y & 0xffffu; e[3] = w0.y >> 16; e[4] = w0.z & 0xffffu; e[5] = w0.z >> 16; e[6] = w0.w & 0xffffu; e[7] = w0.w >> 16;
    e[8] = w1.x & 0xffffu; e[9] = w1.x >> 16; e[10] = w1.y & 0xffffu; e[11] = w1.y >> 16; e[12] = w1.z & 0xffffu; e[13] = w1.z >> 16; e[14] = w1.w & 0xffffu; e[15] = w1.w >> 16;
#pragma unroll
    for (int j = 0; j < 16; ++j) { const int i = 16 * tid + j, x = (i >= 4096) ? 8191 - i : (i == 0 ? 8191 : 4095 + i); const bf16 val = (i == 0) ? (bf16)0 : (bf16)e[j];
#pragma unroll
        for (int k = 0; k < 4; ++k) { const int y = x - k; if (y >= 0) *(LAS bf16*)(lds + k * HY_CP_STRIDE + 2 * y) = val; } }
}
__device__ __forceinline__ void hy_load_u(v4u (&u)[4], const bf16* src, int tid) {
#pragma unroll
    for (int q = 0; q < 4; ++q) u[q] = ((const v4u*)src)[tid + 512 * q];
}
__device__ __forceinline__ void hy_store_u(LAS unsigned char* lds, const v4u (&u)[4], int tid) {
#pragma unroll
    for (int q = 0; q < 4; ++q) { const int idx = tid + 512 * q, el = 8 * idx, b = el >> 12, s = el & 4095; *(LAS v4u*)(lds + HY_U_OFF + b * HY_U_PITCH + 384 + 2 * s) = u[q]; }
    if (tid < 192) { const int b = tid / 48, r = tid % 48, side = r / 24, off = (r % 24) * 16; unsigned z0 = 0u; asm volatile("" : "+v"(z0)); v4u zz; zz.x = z0; zz.y = z0; zz.z = z0; zz.w = z0;
        *(LAS v4u*)(lds + HY_U_OFF + b * HY_U_PITCH + (side ? 384 + 8192 : 0) + off) = zz; }
}
__device__ __forceinline__ void hy_conv_mfma(LAS unsigned char* lds, f32x4 (&acc)[2][4], int wave, int lane) {
    typedef unsigned long long u64;
    const int wm = wave & 1, wn = wave >> 1, r = lane & 15, g = lane >> 4;
    const int kcp = (4095 - r) & 3;
    const int abase = kcp * HY_CP_STRIDE + 2 * (4095 - r - kcp + 8 * g) - 64 * wm;
    const int bbase = HY_U_OFF + (lane & 3) * HY_U_PITCH + 384 + 2 * (64 * (16 * wn + ((lane & 15) >> 2)) + 8 * g);
#pragma unroll 1
    for (int rho = 0; rho < 4; ++rho) {
        bf16x8 ring[4][2];
#pragma unroll 1
        for (int jq = 0; jq < 5; ++jq) {
#pragma unroll
            for (int k = 0; k < 4; ++k) {
                const int Dp = -63 + rho + 4 * (4 * jq + k);
                if (Dp <= 15) {
                    const int D = 16 * wn + Dp;
                    if (Dp <= 3) {
#pragma unroll
                        for (int kk = 0; kk < 2; ++kk) ring[k][kk] = *(const LAS bf16x8*)(lds + bbase - 128 * D + 64 * kk); }
                    bf16x8 af[2][2];
#pragma unroll
                    for (int m = 0; m < 2; ++m)
#pragma unroll
                        for (int kk = 0; kk < 2; ++kk) { const LAS u64* ap = (const LAS u64*)(lds + abase - 128 * D - 32 * m + 64 * kk); union { u64 q[2]; bf16x8 v; } cv; cv.q[0] = ap[0]; cv.q[1] = ap[1]; af[m][kk] = cv.v; }
#pragma unroll
                    for (int kk = 0; kk < 2; ++kk)
#pragma unroll
                        for (int nt = 0; nt < 4; ++nt) { const int e = Dp - 4 * nt;
                            if (e >= -63 && e <= 3) {
#pragma unroll
                                for (int m = 0; m < 2; ++m) acc[m][nt] = __builtin_amdgcn_mfma_f32_16x16x32_bf16(af[m][kk], ring[(k - nt) & 3][kk], acc[m][nt], 0, 0, 0); } }
                }
            }
        }
    }
}
__device__ __forceinline__ void hy_fast_units(const Ctx& C, KArgs& A) {
    LAS unsigned char* lds = C.lds;
    const bf16* GT = (const bf16*)(A.ws + WS_GT); const bf16* HUT = (const bf16*)(A.ws + WS_HUT); bf16* YT = (bf16*)(A.ws + WS_YT);
    int tid = C.tid; asm volatile("" : "+v"(tid));
    const int wave = C.wave, lane = tid & 63, wm = wave & 1, wn = wave >> 1, g = lane >> 4, bb = lane & 3, il = (lane & 15) >> 2;
    int c = C.bid; if (c >= 512) return;
    HyF fa; v4u ua[4];
    hy_load_filter(fa, GT + (size_t)c * 8192, tid); hy_load_u(ua, HUT + ((size_t)(2 * 512 + c)) * M_LAT, tid);
    while (c < 512) {
        const int cn = c + C.G;
        LDS_BARRIER();
        hy_store_filter(lds, fa, tid); hy_store_u(lds, ua, tid);
        HyF fb; hy_load_filter(fb, GT + (size_t)(512 + c) * 8192, tid);
        unsigned long long xg[2][4];
        { const bf16* x1 = HUT + (size_t)c * M_LAT + bb * SEQ;
#pragma unroll
          for (int m = 0; m < 2; ++m)
#pragma unroll
              for (int nt = 0; nt < 4; ++nt) xg[m][nt] = *(const unsigned long long*)(x1 + 64 * (16 * wn + 4 * nt + il) + 16 * (2 * wm + m) + 4 * g); }
        LDS_BARRIER();
        f32x4 acc[2][4];
#pragma unroll
        for (int m = 0; m < 2; ++m)
#pragma unroll
            for (int nt = 0; nt < 4; ++nt) acc[m][nt] = (f32x4){0.f, 0.f, 0.f, 0.f};
        hy_conv_mfma(lds, acc, wave, lane);
        LDS_BARRIER();
#pragma unroll
        for (int m = 0; m < 2; ++m)
#pragma unroll
            for (int nt = 0; nt < 4; ++nt) { const int t = 64 * (16 * wn + 4 * nt + il) + 16 * (2 * wm + m) + 4 * g;
                const unsigned lo = (unsigned)xg[m][nt], hi = (unsigned)(xg[m][nt] >> 32);
                const float z0 = __uint_as_float(lo << 16) * acc[m][nt][0], z1 = __uint_as_float(lo & 0xffff0000u) * acc[m][nt][1], z2 = __uint_as_float(hi << 16) * acc[m][nt][2], z3 = __uint_as_float(hi & 0xffff0000u) * acc[m][nt][3];
                *(LAS unsigned long long*)(lds + HY_U_OFF + bb * HY_U_PITCH + 384 + 2 * t) = (unsigned long long)pk2(z0, z1) | ((unsigned long long)pk2(z2, z3) << 32); }
        hy_store_filter(lds, fb, tid);
        { const bf16* x2 = HUT + ((size_t)(512 + c)) * M_LAT + bb * SEQ;
#pragma unroll
          for (int m = 0; m < 2; ++m)
#pragma unroll
              for (int nt = 0; nt < 4; ++nt) xg[m][nt] = *(const unsigned long long*)(x2 + 64 * (16 * wn + 4 * nt + il) + 16 * (2 * wm + m) + 4 * g); }
        if (cn < 512) { hy_load_filter(fa, GT + (size_t)cn * 8192, tid); hy_load_u(ua, HUT + ((size_t)(2 * 512 + cn)) * M_LAT, tid); }
        LDS_BARRIER();
#pragma unroll
        for (int m = 0; m < 2; ++m)
#pragma unroll
            for (int nt = 0; nt < 4; ++nt) acc[m][nt] = (f32x4){0.f, 0.f, 0.f, 0.f};
        hy_conv_mfma(lds, acc, wave, lane);
        { bf16* yo = YT + (size_t)c * M_LAT + bb * SEQ;
#pragma unroll
          for (int m = 0; m < 2; ++m)
#pragma unroll
              for (int nt = 0; nt < 4; ++nt) { const int t = 64 * (16 * wn + 4 * nt + il) + 16 * (2 * wm + m) + 4 * g;
                  const unsigned lo = (unsigned)xg[m][nt], hi = (unsigned)(xg[m][nt] >> 32);
                  const float z0 = __uint_as_float(lo << 16) * acc[m][nt][0], z1 = __uint_as_float(lo & 0xffff0000u) * acc[m][nt][1], z2 = __uint_as_float(hi << 16) * acc[m][nt][2], z3 = __uint_as_float(hi & 0xffff0000u) * acc[m][nt][3];
                  *(unsigned long long*)(yo + t) = (unsigned long long)pk2(z0, z1) | ((unsigned long long)pk2(z2, z3) << 32); } }
        c = cn;
    }
}
__device__ __forceinline__ void hy_prep_tile(const Ctx& C, KArgs& A, int layer, int tile) {
    const int lane = C.lane; LAS unsigned* T = (LAS unsigned*)(C.lds + C.wave * 8448);
    const int ct = tile % 24, tt = tile / 24, cb = ct * 64, row0 = tt * 64, t0 = row0 & 4095;
    const float* sw = A.in[11] + layer * 3 * 1536; const float* sb = A.in[12] + layer * 1536; const int ch = cb + lane;
    const float w0 = sw[ch], w1 = sw[1536 + ch], w2 = sw[3072 + ch], bias = sb[ch];
    const bf16* p = (const bf16*)(A.ws + WS_P) + (size_t)row0 * N_INP + OFF_HY + ch;
    float pm = (t0 > 0) ? bf2f(p[-(ptrdiff_t)N_INP]) : 0.f, pc = bf2f(p[0]), ae = 0.f;
#pragma unroll 8
    for (int i = 0; i < 64; ++i) { const float pn = (t0 + i + 1 < SEQ) ? bf2f(p[(size_t)(i + 1) * N_INP]) : 0.f; const float a = bias + w0 * pm + w1 * pc + w2 * pn; pm = pc; pc = pn;
        if (i & 1) T[lane * 33 + (i >> 1)] = pk2(ae, a); else ae = a; }
    LDS_WAIT(); asm volatile("" ::: "memory");
    unsigned* dst = (unsigned*)((bf16*)(A.ws + WS_HUT) + (size_t)cb * M_LAT + row0);
#pragma unroll 8
    for (int ii = 0; ii < 32; ++ii) { const int rr = 2 * ii + (lane >> 5), j = lane & 31; dst[(size_t)rr * (M_LAT / 2) + j] = T[rr * 33 + j]; }
    LDS_WAIT(); asm volatile("" ::: "memory");
}
__device__ __forceinline__ void hy_post_tile(const Ctx& C, KArgs& A, int tile) {
    const int lane = C.lane; LAS unsigned char* T = C.lds + C.wave * 8448;
    const int ct = tile & 7, tt = tile >> 3, cb = ct * 64, row0 = tt * 64;
    const unsigned* src = (const unsigned*)((const bf16*)(A.ws + WS_YT) + (size_t)cb * M_LAT + row0);
#pragma unroll
    for (int ii = 0; ii < 32; ++ii) { const int rr = 2 * ii + (lane >> 5), j = lane & 31; const unsigned w = src[(size_t)rr * (M_LAT / 2) + j];
        *(LAS bf16*)(T + (2 * j) * 132 + 2 * rr) = (bf16)(w & 0xffffu); *(LAS bf16*)(T + (2 * j + 1) * 132 + 2 * rr) = (bf16)(w >> 16); }
    LDS_WAIT(); asm volatile("" ::: "memory");
    unsigned* dst = (unsigned*)((bf16*)(A.ws + WS_Y) + (size_t)row0 * DM + 512 + cb);
#pragma unroll
    for (int ii = 0; ii < 32; ++ii) { const int rr = 2 * ii + (lane >> 5), j = lane & 31; dst[(size_t)rr * (DM / 2) + j] = *(const LAS unsigned*)(T + rr * 132 + 4 * j); }
    LDS_WAIT(); asm volatile("" ::: "memory");
}

struct PrepDesc { int col0, nch; const float* w; int wstride; const float* bias; bool silu; int cm_count; bf16* dst_cm; size_t cm_stride; int cm_col; bf16* dst_tm; int tm_stride; };
__device__ __forceinline__ void prep_load(KArgs& A, const PrepDesc& D, int r0, int t0, int L, int tid, v4u (&v)[5]) {
    const bf16* P = (const bf16*)(A.ws + WS_P); const int cpr = D.nch >> 3; const bool conv = D.w != nullptr, hp = conv && t0 > 0, hn = conv && (t0 + 32 < L);
#pragma unroll
    for (int i = 0; i < 5; ++i) { const int idx = tid + NTHR * i, rr = idx / cpr, part = idx - rr * cpr; const bool ok = idx < 34 * cpr && ((rr == 0) ? hp : ((rr == 33) ? hn : true));
        v[i].x = 0u; v[i].y = 0u; v[i].z = 0u; v[i].w = 0u; if (ok) v[i] = *(const v4u*)(P + (size_t)(r0 - 1 + rr) * N_INP + D.col0 + 8 * part); }
}
__device__ __forceinline__ void prep_desc(KArgs& A, int layer, int u, PrepDesc& D, int& r0, int& t0, int& L) {
    const int NT_L = M_LAT / 32, NT_A = M_ALL / 32; const int nH = 3 * NT_L, nS = 2 * NT_A; int tt;
    if (u < nH) { const int k = u / NT_L; tt = u - k * NT_L; D.col0 = OFF_HY + 512 * k; D.nch = 512; D.w = A.in[11] + layer * 3 * 1536 + 512 * k; D.wstride = 1536; D.bias = A.in[12] + layer * 1536 + 512 * k; D.silu = false;
        D.cm_count = 512; D.dst_cm = (bf16*)(A.ws + WS_HUT) + (size_t)(512 * k) * M_LAT; D.cm_stride = M_LAT; D.cm_col = 32 * tt; D.dst_tm = nullptr; D.tm_stride = 0; }
    else if (u < nH + nS) { const int v = u - nH, k = v / NT_A; tt = v - k * NT_A; D.col0 = OFF_SSM + 512 + 512 * k; D.nch = 512; D.w = A.in[23] + layer * 3 * 1024 + 512 * k; D.wstride = 1024; D.bias = A.in[24] + layer * 1024 + 512 * k; D.silu = true;
        D.cm_count = k ? 256 : 512; D.dst_cm = (bf16*)(A.ws + WS_XBCT) + (size_t)(512 * k) * M_ALL; D.cm_stride = M_ALL; D.cm_col = 32 * tt; D.dst_tm = (bf16*)(A.ws + WS_XBC) + 512 * k; D.tm_stride = 1024; }
    else { const int v = u - nH - nS, k = v / NT_A; tt = v - k * NT_A; D.col0 = k ? OFF_NA + 1024 : 640; D.nch = k ? 512 : 128; D.w = nullptr; D.wstride = 0; D.bias = nullptr; D.silu = false;
        D.cm_count = D.nch; D.dst_cm = (bf16*)(A.ws + WS_VT) + (size_t)(k ? 128 : 0) * M_ALL; D.cm_stride = M_ALL; D.cm_col = 32 * tt; D.dst_tm = nullptr; D.tm_stride = 0; }
    r0 = 32 * tt; if (r0 < M_LAT) { t0 = r0 & 4095; L = SEQ; } else { t0 = (r0 - M_LAT) & 255; L = LC; }
}
__device__ __forceinline__ void phase_prep_units(const Ctx& C, KArgs& A, int layer) {
    LAS unsigned char* lds = C.lds; constexpr int OFF_T = 36864, OFF_O = 81920;
    const int N = 3 * (M_LAT / 32) + 4 * (M_ALL / 32);
    int tid = C.tid; asm volatile("" : "+v"(tid));
    int u = (C.bid & 7) * (C.G >> 3) + (C.bid >> 3); v4u v[5];
    if (u < N) { PrepDesc D0; int a0, b0, c0; prep_desc(A, layer, u, D0, a0, b0, c0); prep_load(A, D0, a0, b0, c0, tid, v); }
    while (u < N) {
        PrepDesc D; int r0, t0, L; prep_desc(A, layer, u, D, r0, t0, L);
        const int cpr = D.nch >> 3;
        float w0 = 0.f, w1 = 1.f, w2 = 0.f, bs = 0.f;
        if (tid < D.nch && D.w != nullptr) { w0 = D.w[tid]; w1 = D.w[D.wstride + tid]; w2 = D.w[2 * D.wstride + tid]; bs = D.bias[tid]; }
        LDS_BARRIER();
#pragma unroll
        for (int i = 0; i < 5; ++i) { const int idx = tid + NTHR * i, rr = idx / cpr, part = idx - rr * cpr; if (idx < 34 * cpr) *(LAS v4u*)(lds + (rr * D.nch + 8 * part) * 2) = v[i]; }
        const int un = u + C.G;
        if (un < N) { PrepDesc Dn; int r0n, t0n, Ln; prep_desc(A, layer, un, Dn, r0n, t0n, Ln); prep_load(A, Dn, r0n, t0n, Ln, tid, v); }
        LDS_BARRIER();
        if (tid < D.nch) { const int c = tid;
            const LAS bf16* in = (const LAS bf16*)lds + c; float pm = bf2f(in[0]), pc = bf2f(in[D.nch]), ae = 0.f;
            const bool cm = c < D.cm_count, tm = D.dst_tm != nullptr;
#pragma unroll 8
            for (int t = 0; t < 32; ++t) { const float pn = bf2f(in[(t + 2) * D.nch]); float a = bs + w0 * pm + w1 * pc + w2 * pn; if (D.silu) a = silu_f(a); pm = pc; pc = pn;
                if (tm) *(LAS bf16*)(lds + OFF_O + (t * D.nch + c) * 2) = (bf16)f2bf(a);
                if (t & 1) { if (cm) *(LAS unsigned*)(lds + OFF_T + c * 80 + (t >> 1) * 4) = pk2(ae, a); } else ae = a; } }
        LDS_BARRIER();
        for (int idx = tid; idx < D.cm_count * 4; idx += NTHR) { const int c = idx >> 2, part = idx & 3; *(v4u*)(D.dst_cm + (size_t)c * D.cm_stride + D.cm_col + 8 * part) = *(const LAS v4u*)(lds + OFF_T + c * 80 + part * 16); }
        if (D.dst_tm) for (int idx = tid; idx < 32 * cpr; idx += NTHR) { const int t = idx / cpr, part = idx - t * cpr; *(v4u*)(D.dst_tm + (size_t)(r0 + t) * D.tm_stride + 8 * part) = *(const LAS v4u*)(lds + OFF_O + (t * D.nch + 8 * part) * 2); }
        u = un;
    }
    LDS_BARRIER();
}

__device__ __forceinline__ void prep_dt(const Ctx& C, KArgs& A, int layer) {
    const bf16* P = (const bf16*)(A.ws + WS_P); float* DT = (float*)(A.ws + WS_DT);
    for (int i = C.bid * NTHR + C.tid; i < M_ALL * 16; i += C.G * NTHR) { const int row = i >> 4, j = i & 15;
        const float raw = bf2f(P[(size_t)row * N_INP + OFF_SSM + 1536 + j]) + A.in[25][layer * 16 + j]; const float dt = raw > 20.f ? raw : log1pf(expf(raw));
        DT[i] = dt; DT[(size_t)M_ALL * 16 + i] = -expf(A.in[26][layer * 16 + j]) * dt; }
}
__device__ __forceinline__ void prep_row(const Ctx& C, KArgs& A, int layer, int row) {
    const int lane = C.lane;
    const bf16* prow = (const bf16*)(A.ws + WS_P) + (size_t)row * N_INP;
    const int t = (row - M_LAT) & 255; const bool hp = t > 0, hn = t < LC - 1;
    const bf16* pm = prow - N_INP; const bf16* pp = prow + N_INP;
    const float* sw = A.in[11] + layer * 3 * 1536; const float* sb = A.in[12] + layer * 1536; float* HU = (float*)(A.ws + WS_HU) + (size_t)row * 1536;
#pragma unroll
    for (int i = 0; i < 24; ++i) { const int ch = lane + 64 * i, col = OFF_HY + ch;
        float a = sb[ch] + sw[1536 + ch] * bf2f(prow[col]); if (hp) a += sw[ch] * bf2f(pm[col]); if (hn) a += sw[3072 + ch] * bf2f(pp[col]);
        HU[ch] = a; }
}

constexpr float ATT_SC = 0.125f * 1.4426950408889634f, LOG2E = 1.4426950408889634f;
struct SD_A { int b, base, ilo, nloc;
    __device__ __forceinline__ void init(int b_, int n, int hh) { b = b_; base = n * 128 + 64 * hh - 128; ilo = base < 0 ? (-base) >> 5 : 0; int ihi = (SEQ - base) >> 5; ihi = ihi > 10 ? 10 : ihi; nloc = ihi - ilo; }
    __device__ __forceinline__ int nsteps() const { return nloc + 8; }
    __device__ __forceinline__ int seg(int j, int& code) const { if (j < nloc) { code = ilo + j; return b * SEQ + base + 32 * code; } code = -1; return M_LAT + b * LC + 32 * (j - nloc); }
    __device__ __forceinline__ bool skip(int, int) const { return false; }
    __device__ __forceinline__ void mask(int code, int qt, int li, int g, float (&sv)[8]) const { if (code < 0 || (code >= 2 && code <= 7)) return; const int d0 = 32 * code + 4 * g - li - 16 * qt;
#pragma unroll
        for (int j = 0; j < 8; ++j) sv[j] = ((unsigned)(d0 + (j & 3) + 16 * (j >> 2)) <= 256u) ? sv[j] : -INFINITY; } };
struct SD_NA { int b, r, rstart; const LAS float* rpb;
    __device__ __forceinline__ int nsteps() const { return 24; }
    __device__ __forceinline__ int seg(int j, int& code) const { if (j < 16) { code = j; return b * SEQ + (rstart + (j >> 1)) * 64 + 32 * (j & 1); } code = -1; return M_LAT + b * LC + 32 * (j - 16); }
    __device__ __forceinline__ bool skip(int code, int qt) const { return code >= 0 && ((qt == 0 && (code & 1)) || (qt == 3 && !(code & 1))); }
    __device__ __forceinline__ void mask(int code, int qt, int li, int g, float (&sv)[8]) const { if (code < 0) return; const int c = 16 * qt + li; int c0 = c - 8; c0 = c0 < 0 ? 0 : (c0 > 48 ? 48 : c0);
        const int lo = c0 - c, d0 = 32 * (code & 1) + 4 * g - c, rowb = (rstart + (code >> 1) - r + 7) * 31 + 15;
        float bias[8]; const volatile LAS float* rp = (const volatile LAS float*)rpb;
#pragma unroll
        for (int j = 0; j < 8; ++j) { const int d = d0 + (j & 3) + 16 * (j >> 2); const bool ok = (unsigned)(d - lo) < 16u; bias[j] = rp[ok ? rowb + d : 0]; }
#pragma unroll
        for (int j = 0; j < 8; ++j) { const int d = d0 + (j & 3) + 16 * (j >> 2); const bool ok = (unsigned)(d - lo) < 16u; sv[j] = ok ? sv[j] + bias[j] : -INFINITY; } } };
struct SD_CTX { int b;
    __device__ __forceinline__ int nsteps() const { return 8; }
    __device__ __forceinline__ int seg(int j, int& code) const { code = -1; return M_LAT + b * LC + 32 * j; }
    __device__ __forceinline__ bool skip(int, int) const { return false; }
    __device__ __forceinline__ void mask(int, int, int, int, float (&)[8]) const {} };

struct AttnKV { bf16x8 kf[2][2], vf[4]; };
__device__ __forceinline__ void attn_load(AttnKV& kv, __amdgpu_buffer_rsrc_t rp, __amdgpu_buffer_rsrc_t rv, int rowstart, int kcol, unsigned koff, unsigned voff) {
    const int ks = (rowstart * N_INP + kcol) * 2, vs = rowstart * 2;
#pragma unroll
    for (int half = 0; half < 2; ++half)
#pragma unroll
        for (int kk = 0; kk < 2; ++kk) { union { v4u u; bf16x8 x; } cv; cv.u = __builtin_amdgcn_raw_buffer_load_b128(rp, koff, ks + 16 * half * N_INP * 2 + 64 * kk, 0); kv.kf[half][kk] = cv.x; }
#pragma unroll
    for (int dt = 0; dt < 4; ++dt) { typedef unsigned v2u_ __attribute__((ext_vector_type(2))); union { v2u_ q[2]; bf16x8 x; } cv;
        cv.q[0] = __builtin_amdgcn_raw_buffer_load_b64(rv, voff, vs + 16 * dt * M_ALL * 2, 0); cv.q[1] = __builtin_amdgcn_raw_buffer_load_b64(rv, voff, vs + 16 * dt * M_ALL * 2 + 32, 0); kv.vf[dt] = cv.x; }
}
template <class SD>
__device__ __forceinline__ void attn_step(const AttnKV& kv, const SD& sd, int code, const LAS bf16x8* ql, f32x4 (&O)[4][4], float (&mrun)[4], float (&lrun)[4], int li, int g) {
    asm volatile("" : "+v"(li), "+v"(g));
#pragma unroll
    for (int qt = 0; qt < 4; ++qt) {
        if (sd.skip(code, qt)) continue;
        const bf16x8 q0 = ql[(qt * 2 + 0) * 64], q1 = ql[(qt * 2 + 1) * 64];
        f32x4 s0 = __builtin_amdgcn_mfma_f32_16x16x32_bf16(kv.kf[0][0], q0, (f32x4){0.f, 0.f, 0.f, 0.f}, 0, 0, 0); f32x4 s1 = __builtin_amdgcn_mfma_f32_16x16x32_bf16(kv.kf[1][0], q0, (f32x4){0.f, 0.f, 0.f, 0.f}, 0, 0, 0);
        s0 = __builtin_amdgcn_mfma_f32_16x16x32_bf16(kv.kf[0][1], q1, s0, 0, 0, 0); s1 = __builtin_amdgcn_mfma_f32_16x16x32_bf16(kv.kf[1][1], q1, s1, 0, 0, 0);
        float sv[8];
#pragma unroll
        for (int r = 0; r < 4; ++r) { sv[r] = s0[r]; sv[4 + r] = s1[r]; }
        sd.mask(code, qt, li, g, sv);
        float tmax = fmaxf(fmaxf(fmaxf(sv[0], sv[1]), fmaxf(sv[2], sv[3])), fmaxf(fmaxf(sv[4], sv[5]), fmaxf(sv[6], sv[7])));
        tmax = fmaxf(tmax, __shfl_xor(tmax, 16)); tmax = fmaxf(tmax, __shfl_xor(tmax, 32));
        if (__builtin_amdgcn_ballot_w64(tmax > mrun[qt]) != 0ull) {
            const float mnew = fmaxf(mrun[qt], tmax), alpha = __builtin_amdgcn_exp2f(mrun[qt] - mnew); mrun[qt] = mnew; lrun[qt] *= alpha;
#pragma unroll
            for (int dt = 0; dt < 4; ++dt) O[qt][dt] = O[qt][dt] * alpha; }
        float p[8], ps = 0.f; const float mq = mrun[qt];
#pragma unroll
        for (int j = 0; j < 8; ++j) { p[j] = __builtin_amdgcn_exp2f(sv[j] - mq); ps += p[j]; }
        lrun[qt] += ps;
        union { unsigned u[4]; bf16x8 x; } pf; pf.u[0] = pk2(p[0], p[1]); pf.u[1] = pk2(p[2], p[3]); pf.u[2] = pk2(p[4], p[5]); pf.u[3] = pk2(p[6], p[7]);
#pragma unroll
        for (int dt = 0; dt < 4; ++dt) O[qt][dt] = __builtin_amdgcn_mfma_f32_16x16x32_bf16(kv.vf[dt], pf.x, O[qt][dt], 0, 0, 0);
    }
}
template <class SD, int DIAG = 0>
__device__ __forceinline__ void attn_core(const bf16* P, const bf16* VT, int qrow0, int qcol, int kcol, const SD& sd, bool has_sink, float sink, bf16* Ybase, int ocol, int lane, LAS bf16x8* ql) {
    const int li = lane & 15, g = lane >> 4;
    ql += lane;
    const unsigned koff = (unsigned)(li * N_INP + 8 * g) * 2u, voff = (unsigned)(li * M_ALL + 4 * g) * 2u;
    const int ns = sd.nsteps();
    const __amdgpu_buffer_rsrc_t rp = __builtin_amdgcn_make_buffer_rsrc((void*)P, 0, (int)((size_t)M_ALL * N_INP * 2), 0x00020000);
    const __amdgpu_buffer_rsrc_t rv = __builtin_amdgcn_make_buffer_rsrc((void*)VT, 0, 64 * M_ALL * 2, 0x00020000);
    const __amdgpu_buffer_rsrc_t ry = __builtin_amdgcn_make_buffer_rsrc((void*)Ybase, 0, (int)((size_t)M_ALL * DM * 2), 0x00020000);
    const unsigned yoff = (unsigned)(li * DM + 4 * g) * 2u;
    v4u qraw[4][2];
#pragma unroll
    for (int qt = 0; qt < 4; ++qt)
#pragma unroll
        for (int kk = 0; kk < 2; ++kk) qraw[qt][kk] = *(const v4u*)(P + (size_t)(qrow0 + 16 * qt + li) * N_INP + qcol + 32 * kk + 8 * g);
    AttnKV kva, kvb; int ca, cb;
    { const int rs = sd.seg(0, ca); attn_load(kva, rp, rv, rs, kcol, koff, voff); }
#pragma unroll
    for (int qt = 0; qt < 4; ++qt)
#pragma unroll
        for (int kk = 0; kk < 2; ++kk) { union { v4u u; bf16x8 x; } qv; qv.u = qraw[qt][kk];
#pragma unroll
            for (int e = 0; e < 4; ++e) { const unsigned w = qv.u[e]; qv.u[e] = pk2(__uint_as_float(w << 16) * ATT_SC, __uint_as_float(w & 0xffff0000u) * ATT_SC); }
            ql[(qt * 2 + kk) * 64] = qv.x; }
    LDS_WAIT(); asm volatile("" ::: "memory");
    f32x4 O[4][4]; float mrun[4], lrun[4];
#pragma unroll
    for (int qt = 0; qt < 4; ++qt) { mrun[qt] = has_sink ? sink * LOG2E : -1e30f; lrun[qt] = (has_sink && g == 0) ? 1.f : 0.f;
#pragma unroll
        for (int dt = 0; dt < 4; ++dt) O[qt][dt] = (f32x4){0.f, 0.f, 0.f, 0.f}; }
    if (DIAG == 0) {
#pragma unroll 1
    for (int step = 0; step < ns; step += 2) {
        if (step + 1 < ns) { const int rs = sd.seg(step + 1, cb); attn_load(kvb, rp, rv, rs, kcol, koff, voff); }
        attn_step(kva, sd, ca, ql, O, mrun, lrun, li, g);
        if (step + 1 < ns) {
            if (step + 2 < ns) { const int rs = sd.seg(step + 2, ca); attn_load(kva, rp, rv, rs, kcol, koff, voff); }
            attn_step(kvb, sd, cb, ql, O, mrun, lrun, li, g);
        }
    }
    }
#pragma unroll
    for (int qt = 0; qt < 4; ++qt) { float lt = lrun[qt]; lt += __shfl_xor(lt, 16); lt += __shfl_xor(lt, 32); const float inv = 1.0f / lt;
        const int so = ((qrow0 + 16 * qt) * DM + ocol) * 2;
#pragma unroll
        for (int dt = 0; dt < 4; ++dt) { const f32x4 o = O[qt][dt] * inv; typedef unsigned v2u_ __attribute__((ext_vector_type(2))); v2u_ w; w.x = pk2(o[0], o[1]); w.y = pk2(o[2], o[3]);
            __builtin_amdgcn_raw_buffer_store_b64(w, ry, yoff, so + 32 * dt, 0); } }
}

template <int DIAG = 0>
__device__ __forceinline__ void phase_attn(const Ctx& C, KArgs& A, int layer, bool need_ctx) {
    const bf16* P = (const bf16*)(A.ws + WS_P); bf16* Y = (bf16*)(A.ws + WS_Y); const bf16* VT = (const bf16*)(A.ws + WS_VT);
    const float* sinkp = A.in[10] + layer * 8; const float* rpb = A.in[22] + (size_t)layer * 8 * 15 * 31;
    LAS bf16x8* ql = (LAS bf16x8*)(C.lds + C.wave * 8192);
    const int nA = NB * 32 * 8 * 2, nN = NB * 8 * 64, nC = need_ctx ? NB * 8 * 4 : 0;

    const int ctx_r = (C.bid >= 80 && C.wave < 2) ? (C.bid - 80) + (C.G - 80) * C.wave : 1 << 20;
    const int bidv = (C.bid & 7) * (C.G >> 3) + (C.bid >> 3);
#pragma unroll 1
    for (int k = 0; k < 3; ++k) { const int it = (k < 2) ? bidv * NWAVES + C.wave + k * C.NGW : nA + nN + ctx_r;
        if (it >= nA + nN + 2 * nC) break;
        int r = it;
        if (r < nA) { const int hh = r & 1, hq = (r >> 1) & 7, n = (r >> 4) & 31, b = r >> 9, hk = hq >> 2; SD_A sd; sd.init(b, n, hh);
            attn_core<decltype(sd), DIAG>(P, VT + (size_t)hk * 64 * M_ALL, b * SEQ + n * 128 + 64 * hh, 64 * hq, 512 + 64 * hk, sd, true, sinkp[hq], Y, 64 * hq, C.lane, ql); continue; } r -= nA;
        if (r < nN) { const int h = r & 7, rr = (r >> 3) & 63, b = r >> 9; int rstart = rr - 4; rstart = rstart < 0 ? 0 : (rstart > 56 ? 56 : rstart); LAS float* rl = (LAS float*)(C.lds + 65536 + C.wave * 1864);
            for (int i = C.lane; i < 465; i += 64) rl[i] = rpb[h * 465 + i] * LOG2E;
            LDS_WAIT(); asm volatile("" ::: "memory");
            SD_NA sd{b, rr, rstart, rl};
            attn_core<decltype(sd), DIAG>(P, VT + (size_t)(2 + h) * 64 * M_ALL, b * SEQ + rr * 64, OFF_NA + 64 * h, OFF_NA + 512 + 64 * h, sd, false, 0.f, Y, 1024 + 64 * h, C.lane, ql); continue; } r -= nN;
        if (r < nC) { const int blk = r & 3, hq = (r >> 2) & 7, b = r >> 5, hk = hq >> 2; SD_CTX sd{b};
            attn_core<decltype(sd), DIAG>(P, VT + (size_t)hk * 64 * M_ALL, M_LAT + b * LC + 64 * blk, 64 * hq, 512 + 64 * hk, sd, true, sinkp[hq], Y, 64 * hq, C.lane, ql); continue; } r -= nC;
        { const int blk = r & 3, h = (r >> 2) & 7, b = r >> 5; SD_CTX sd{b};
            attn_core<decltype(sd), DIAG>(P, VT + (size_t)(2 + h) * 64 * M_ALL, M_LAT + b * LC + 64 * blk, OFF_NA + 64 * h, OFF_NA + 512 + 64 * h, sd, false, 0.f, Y, 1024 + 64 * h, C.lane, ql); }
    }
}
__device__ __forceinline__ void vt_prep_tile(const Ctx& C, KArgs& A, int tile) {
    const int lane = C.lane; LAS unsigned* T = (LAS unsigned*)(C.lds + C.wave * 8448);
    const int slot = tile % 10, tt = tile / 10, row0 = tt * 64, col0 = (slot < 2) ? 640 + 64 * slot : OFF_NA + 1024 + 64 * (slot - 2);
    const bf16* p = (const bf16*)(A.ws + WS_P) + (size_t)row0 * N_INP + col0 + lane;
#pragma unroll 8
    for (int i = 0; i < 32; ++i) { const unsigned lo = p[(size_t)(2 * i) * N_INP], hi = p[(size_t)(2 * i + 1) * N_INP]; T[lane * 33 + i] = lo | (hi << 16); }
    LDS_WAIT(); asm volatile("" ::: "memory");
    unsigned* dst = (unsigned*)((bf16*)(A.ws + WS_VT) + (size_t)slot * 64 * M_ALL + row0);
#pragma unroll 8
    for (int ii = 0; ii < 32; ++ii) { const int rr = 2 * ii + (lane >> 5), j = lane & 31; dst[(size_t)rr * (M_ALL / 2) + j] = T[rr * 33 + j]; }
    LDS_WAIT(); asm volatile("" ::: "memory");
}

template <bool OUT_BF16>
__device__ __forceinline__ void hy_conv_unit(const float* U, int ustride, const float* G, int L, int rowbase, int t0, const float* gate, int gstride, void* outp, int ostride, int c) {
    float acc[16], old[16], nw[16], u[16];
#pragma unroll
    for (int i = 0; i < 16; ++i) { acc[i] = 0.f; old[i] = 0.f; }
#pragma unroll
    for (int m = 0; m < 15; ++m) old[m] = G[(size_t)(t0 + 1 + m + L - 1) * 512 + c];
    float un[16], nn[16];
#pragma unroll
    for (int k = 0; k < 16; ++k) un[k] = U[(size_t)(rowbase + k) * ustride + c];
#pragma unroll
    for (int m = 0; m < 16; ++m) nn[m] = G[(size_t)(t0 - 15 + m + L - 1) * 512 + c];
    for (int sb = 0; sb < L; sb += 16) {
#pragma unroll
        for (int k = 0; k < 16; ++k) { u[k] = un[k]; nw[k] = nn[k]; }
        if (sb + 16 < L) {
#pragma unroll
            for (int k = 0; k < 16; ++k) un[k] = U[(size_t)(rowbase + sb + 16 + k) * ustride + c];
#pragma unroll
            for (int m = 0; m < 16; ++m) nn[m] = G[(size_t)(t0 - sb - 16 - 15 + m + L - 1) * 512 + c]; }
#pragma unroll
        for (int i = 0; i < 16; ++i)
#pragma unroll
            for (int k = 0; k < 16; ++k) { const int j = i - k; acc[i] += u[k] * ((j <= 0) ? nw[j + 15] : old[j - 1]); }
#pragma unroll
        for (int m = 0; m < 16; ++m) old[m] = nw[m];
    }
#pragma unroll
    for (int i = 0; i < 16; ++i) { const size_t row = (size_t)(rowbase + t0 + i); const float v = gate[row * gstride + c] * acc[i];
        if (OUT_BF16) ((bf16*)outp)[row * ostride + c] = (bf16)f2bf(v); else ((float*)outp)[row * ostride + c] = v; }
}
__device__ __forceinline__ void phase_hyconv(const Ctx& C, KArgs& A, int layer, int order, bool need_ctx, int first_wg = 0) {
    const float* HU = (const float*)(A.ws + WS_HU); float* Z = (float*)(A.ws + WS_Z); bf16* Y = (bf16*)(A.ws + WS_Y);
    const float* GL = (const float*)(A.ws + WS_GLAT) + (size_t)order * (2 * SEQ - 1) * 512; const float* GC = (const float*)(A.ws + ((layer & 1) ? WS_GCTX1 : WS_GCTX)) + (size_t)order * (2 * LC - 1) * 512;
    const int nl = 0, nc = need_ctx ? NB * (LC / 16) : 0;
    for (int u = (C.bid >= first_wg) ? C.bid - first_wg : C.bid - first_wg + C.G; u < nl + nc; u += C.G) {
        int L, rowbase, t0; const float* G;
        if (u < nl) { const int b = u / (SEQ / 16); t0 = (u % (SEQ / 16)) * 16; L = SEQ; rowbase = b * SEQ; G = GL; }
        else { const int v = u - nl, b = v / (LC / 16); t0 = (v % (LC / 16)) * 16; L = LC; rowbase = M_LAT + b * LC; G = GC; }
        if (order == 0) hy_conv_unit<false>(HU + 1024, 1536, G, L, rowbase, t0, HU, 1536, Z, 512, C.tid);
        else hy_conv_unit<true>(Z, 512, G, L, rowbase, t0, HU + 512, 1536, Y + 512, DM, C.tid);
    }
}

__device__ __forceinline__ int ssd_rowbase(int b, int ci) { return ci < 2 ? M_LAT + b * LC + 128 * ci : b * SEQ + 128 * (ci - 2); }
__device__ __forceinline__ void ssd_tables(const Ctx& C, KArgs& A, int rowbase, int grp, LAS float* cs, LAS float* dtl, LAS float* wtab, float* cd_out) {
    const int w = C.wave, lane = C.lane, h = w & 3, d = w >> 2, head = grp * 4 + h;
    const float* DT = (const float*)(A.ws + WS_DT); const float* DTA = DT + (size_t)M_ALL * 16;
    const size_t i0 = (size_t)(rowbase + 2 * lane) * 16 + d * 8 + head;
    const float a0 = DTA[i0], a1 = DTA[i0 + 16], dt0 = DT[i0], dt1 = DT[i0 + 16];
    float incl = a0 + a1;
#pragma unroll
    for (int o = 1; o < 64; o <<= 1) { const float t = __shfl_up(incl, o); if (lane >= o) incl += t; }
    const float excl = incl - (a0 + a1), tot = __shfl(incl, 63);
    float c0, c1;
    if (d == 0) { c0 = excl + a0; c1 = incl; } else { c0 = tot - excl; c1 = tot - excl - a0; }
    cs[w * 128 + 2 * lane] = c0; cs[w * 128 + 2 * lane + 1] = c1; dtl[w * 128 + 2 * lane] = dt0; dtl[w * 128 + 2 * lane + 1] = dt1;
    wtab[w * 128 + 2 * lane] = dt0 * __expf(tot - c0); wtab[w * 128 + 2 * lane + 1] = dt1 * __expf(tot - c1);
    if (cd_out && lane == 0) cd_out[head * 2 + d] = __expf(tot);
}
constexpr int D1_XS = 12288;
__device__ __forceinline__ void ssd_d1_unit(const Ctx& C, KArgs& A, int b, int ci, int grp) {
    const int w = C.wave, rowbase = ssd_rowbase(b, ci);
    LAS float* cs = (LAS float*)C.lds; LAS float* dtl = cs + 1024; LAS float* wtab = dtl + 1024; LAS unsigned char* lds = C.lds;
    const bf16* XT = (const bf16*)(A.ws + WS_XBCT);
    __syncthreads();
    int tid = C.tid; asm volatile("" : "+v"(tid));
    ssd_tables(C, A, rowbase, grp, cs, dtl, wtab, (float*)(A.ws + WS_CD) + (size_t)(b * 34 + ci) * 16);
    { const bf16* xsrc = XT + (size_t)(grp * 256) * M_ALL + rowbase;
#pragma unroll
      for (int i = 0; i < 8; ++i) { const int q = tid + 512 * i, row = q >> 4, part = q & 15; *(LAS v4u*)(lds + D1_XS + row * 272 + part * 16) = *(const v4u*)(xsrc + (size_t)row * M_ALL + 8 * part); } }
    const int lane = tid & 63, g = lane >> 4, li = lane & 15;
    v4u braw[4];
#pragma unroll
    for (int kq = 0; kq < 4; ++kq) braw[kq] = *(const v4u*)(XT + (size_t)(512 + grp * 128 + 16 * w + li) * M_ALL + rowbase + 32 * kq + 8 * g);
    __syncthreads();
    float* SST = (float*)(A.ws + WS_SST);
#pragma unroll 1
    for (int hd = 0; hd < 8; ++hd) {
        const int h = hd & 3, d = hd >> 2, head = grp * 4 + h;
        bf16x8 bw[4];
#pragma unroll
        for (int kq = 0; kq < 4; ++kq) { const LAS f32x4* wp = (const LAS f32x4*)(wtab + hd * 128 + 32 * kq + 8 * g); const f32x4 w0 = wp[0], w1 = wp[1]; const v4u x = braw[kq];
            union { unsigned u[4]; bf16x8 v; } cv; cv.u[0] = pk2(__uint_as_float(x.x << 16) * w0.x, __uint_as_float(x.x & 0xffff0000u) * w0.y); cv.u[1] = pk2(__uint_as_float(x.y << 16) * w0.z, __uint_as_float(x.y & 0xffff0000u) * w0.w);
            cv.u[2] = pk2(__uint_as_float(x.z << 16) * w1.x, __uint_as_float(x.z & 0xffff0000u) * w1.y); cv.u[3] = pk2(__uint_as_float(x.w << 16) * w1.z, __uint_as_float(x.w & 0xffff0000u) * w1.w); bw[kq] = cv.v; }
        f32x4 acc[4];
        int xo = (h * 64 + li) * 272 + 16 * g; asm volatile("" : "+v"(xo));
#pragma unroll
        for (int pt = 0; pt < 4; ++pt) { acc[pt] = (f32x4){0.f, 0.f, 0.f, 0.f};
#pragma unroll
            for (int kq = 0; kq < 4; ++kq) { const bf16x8 xf = *(const LAS bf16x8*)(lds + D1_XS + xo + 16 * pt * 272 + 64 * kq);
                acc[pt] = __builtin_amdgcn_mfma_f32_16x16x32_bf16(xf, bw[kq], acc[pt], 0, 0, 0); } }
        float* so = SST + ((size_t)((b * 34 + ci) * 8 + head) * 2 + d) * 8192 + 16 * w + li;
#pragma unroll
        for (int pt = 0; pt < 4; ++pt)
#pragma unroll
            for (int r = 0; r < 4; ++r) so[(size_t)(16 * pt + 4 * g + r) * 128] = acc[pt][r];
    }
}
__device__ __forceinline__ void ssd_d2(const Ctx& C, KArgs& A) {
    const float* SST = (const float*)(A.ws + WS_SST); const float* CD = (const float*)(A.ws + WS_CD); bf16* HIN = (bf16*)(A.ws + WS_HIN);
    const int S = C.G * NTHR, NE = NB * 8 * 2 * 8192;
    for (int e = C.bid * NTHR + C.tid; e < NE; e += 2 * S) {
        const int e2 = e + S; const bool two = e2 < NE;
        const int pn = e & 8191, d = (e >> 13) & 1, head = (e >> 14) & 7, b = e >> 17;
        const int pn2 = e2 & 8191, d2 = (e2 >> 13) & 1, head2 = (e2 >> 14) & 7, b2 = two ? (e2 >> 17) : b;
        float sv[34], cv[34], sw[34], cw[34];
#pragma unroll
        for (int i = 0; i < 34; ++i) { const int ci = d ? (i < 2 ? 1 - i : 35 - i) : i; const size_t o = ((size_t)((b * 34 + ci) * 8 + head) * 2 + d); sv[i] = SST[o * 8192 + pn]; cv[i] = CD[o]; }
        if (two) {
#pragma unroll
            for (int i = 0; i < 34; ++i) { const int ci = d2 ? (i < 2 ? 1 - i : 35 - i) : i; const size_t o = ((size_t)((b2 * 34 + ci) * 8 + head2) * 2 + d2); sw[i] = SST[o * 8192 + pn2]; cw[i] = CD[o]; } }
        float H = 0.f;
#pragma unroll
        for (int i = 0; i < 34; ++i) { const int ci = d ? (i < 2 ? 1 - i : 35 - i) : i;
            const size_t o = ((size_t)((b * 34 + ci) * 8 + head) * 2 + d); HIN[o * 8192 + pn] = (bf16)f2bf(H); H = cv[i] * H + sv[i]; }
        if (two) { float H2 = 0.f;
#pragma unroll
            for (int i = 0; i < 34; ++i) { const int ci = d2 ? (i < 2 ? 1 - i : 35 - i) : i;
                const size_t o = ((size_t)((b2 * 34 + ci) * 8 + head2) * 2 + d2); HIN[o * 8192 + pn2] = (bf16)f2bf(H2); H2 = cw[i] * H2 + sw[i]; } }
    }
}
constexpr int D3_XS = 8192, D3_HS = D3_XS + 256 * 272, D3_PITCH = 272, D3_BS = D3_HS + 8192;
template <bool CTX>
__device__ __forceinline__ void ssd_d3_unit(const Ctx& C, KArgs& A, int layer, int b, int ci, int grp) {
    const int lane = C.lane, w = C.wave, g = lane >> 4, li = lane & 15, rowbase = ssd_rowbase(b, ci);
    LAS float* cs = (LAS float*)C.lds; LAS float* dtl = cs + 1024; LAS unsigned char* lds = C.lds;
    const bf16* XBC = (const bf16*)(A.ws + WS_XBC); const bf16* XT = (const bf16*)(A.ws + WS_XBCT);
    __syncthreads();
    int tid = C.tid; asm volatile("" : "+v"(tid));
    {
      LAS float* wt = (LAS float*)(lds + D3_HS);
      ssd_tables(C, A, rowbase, grp, cs, dtl, wt, nullptr);
      const bf16* xsrc = XT + (size_t)(grp * 256) * M_ALL + rowbase;
#pragma unroll
      for (int i = 0; i < 8; ++i) { const int q = tid + 512 * i, row = q >> 4, part = q & 15; *(LAS v4u*)(lds + D3_XS + row * D3_PITCH + part * 16) = *(const v4u*)(xsrc + (size_t)row * M_ALL + 8 * part); }
      const bf16* bsrc = XBC + (size_t)rowbase * 1024 + 512 + grp * 128;
#pragma unroll
      for (int i = 0; i < 4; ++i) { const int q = tid + 512 * i, row = q >> 4, part = q & 15; *(LAS v4u*)(lds + D3_BS + row * D3_PITCH + part * 16) = *(const v4u*)(bsrc + (size_t)row * 1024 + 8 * part); } }
    int lrow = 16 * w + li;
    bf16x8 cf[4];
#pragma unroll
    for (int kk = 0; kk < 4; ++kk) cf[kk] = *(const bf16x8*)(XBC + (size_t)(rowbase + lrow) * 1024 + 768 + grp * 128 + 32 * kk + 8 * g);
    __syncthreads();
    f32x4 T[8];
#pragma unroll
    for (int st = 0; st < 8; ++st) { T[st] = (f32x4){0.f, 0.f, 0.f, 0.f};
#pragma unroll
        for (int kk = 0; kk < 4; ++kk) { const bf16x8 bf_ = *(const LAS bf16x8*)(lds + D3_BS + (16 * st + li) * D3_PITCH + 64 * kk + 16 * g);
            T[st] = __builtin_amdgcn_mfma_f32_16x16x32_bf16(bf_, cf[kk], T[st], 0, 0, 0); }
        if ((st & 1) == 1) __builtin_amdgcn_sched_barrier(0); }
    f32x4 acc[4][4];
#pragma unroll
    for (int h = 0; h < 4; ++h)
#pragma unroll
        for (int pt = 0; pt < 4; ++pt) acc[h][pt] = (f32x4){0.f, 0.f, 0.f, 0.f};
    const int xoff0 = li * D3_PITCH + 8 * g, hoff0 = li * D3_PITCH + 16 * g, kqm = w >> 1;
#pragma unroll 1
    for (int d = 0; d < 2; ++d) {
      asm volatile("" : "+v"(tid));
      __syncthreads();
      {
        if (CTX) { const bool zero = (d == 0) ? (ci == 0) : (ci == 1); const float* sst = (const float*)(A.ws + WS_SST) + ((size_t)((b * 34 + (1 - ci)) * 8 + grp * 4) * 2 + d) * 8192;
#pragma unroll
            for (int i = 0; i < 8; ++i) { const int q = tid + 512 * i, h = q >> 10, within = q & 1023, row = within >> 4, part = within & 15; v4u o; o.x = 0u; o.y = 0u; o.z = 0u; o.w = 0u;
                if (!zero) { const f32x4* sp = (const f32x4*)(sst + (size_t)h * 2 * 8192 + row * 128 + 8 * part); const f32x4 a = sp[0], c = sp[1]; o.x = pk2(a[0], a[1]); o.y = pk2(a[2], a[3]); o.z = pk2(c[0], c[1]); o.w = pk2(c[2], c[3]); }
                *(LAS v4u*)(lds + D3_HS + (h * 64 + row) * D3_PITCH + part * 16) = o; } }
        else { const bf16* hsrc = (const bf16*)(A.ws + WS_HIN) + ((size_t)((b * 34 + ci) * 8 + grp * 4) * 2 + d) * 8192;
#pragma unroll
            for (int i = 0; i < 8; ++i) { const int q = tid + 512 * i, h = q >> 10, within = q & 1023, row = within >> 4, part = within & 15;
                *(LAS v4u*)(lds + D3_HS + (h * 64 + row) * D3_PITCH + part * 16) = *(const v4u*)(hsrc + (size_t)h * 2 * 8192 + row * 128 + 8 * part); } } }
      __syncthreads();
#pragma unroll
      for (int h = 0; h < 4; ++h) {
        const int hd = d * 4 + h;
        int lr = lrow; asm volatile("" : "+v"(lr));
        const float csl = cs[hd * 128 + lr];
        bf16x8 mf[4];
#pragma unroll
        for (int kq = 0; kq < 4; ++kq) { if (d ? (kq >= kqm) : (kq <= kqm)) { float v[8];
#pragma unroll
            for (int half = 0; half < 2; ++half) { const int s0 = 32 * kq + 16 * half + 4 * g; const f32x4 cv4 = *(const LAS f32x4*)(cs + hd * 128 + s0), dt4 = *(const LAS f32x4*)(dtl + hd * 128 + s0);
#pragma unroll
                for (int r = 0; r < 4; ++r) { const int s = s0 + r; const bool ok = d ? (s >= lr) : (s <= lr); const float e = __expf(fminf(csl - cv4[r], 0.f)) * dt4[r]; v[half * 4 + r] = ok ? T[2 * kq + half][r] * e : 0.f; } }
            union { unsigned u[4]; bf16x8 x; } cv; cv.u[0] = pk2(v[0], v[1]); cv.u[1] = pk2(v[2], v[3]); cv.u[2] = pk2(v[4], v[5]); cv.u[3] = pk2(v[6], v[7]); mf[kq] = cv.x; } }
        const float el = __expf(csl); bf16x8 cfs[4];
#pragma unroll
        for (int kk = 0; kk < 4; ++kk) { union { bf16x8 x; unsigned u[4]; } ci_, co; ci_.x = cf[kk];
#pragma unroll
            for (int q = 0; q < 4; ++q) co.u[q] = pk2(__uint_as_float(ci_.u[q] << 16) * el, __uint_as_float(ci_.u[q] & 0xffff0000u) * el);
            cfs[kk] = co.x; }
        int xo = xoff0 + h * 64 * D3_PITCH, ho = hoff0 + h * 64 * D3_PITCH; asm volatile("" : "+v"(xo), "+v"(ho));
#pragma unroll
        for (int pt = 0; pt < 4; ++pt) {
            f32x4 a4 = acc[h][pt];
#pragma unroll
            for (int kq = 0; kq < 4; ++kq) { if (d ? (kq >= kqm) : (kq <= kqm)) { union { unsigned long long q[2]; bf16x8 x; } cv; const LAS unsigned char* xp = lds + D3_XS + xo + 16 * pt * D3_PITCH + 64 * kq;
                cv.q[0] = *(const LAS unsigned long long*)xp; cv.q[1] = *(const LAS unsigned long long*)(xp + 32);
                a4 = __builtin_amdgcn_mfma_f32_16x16x32_bf16(cv.x, mf[kq], a4, 0, 0, 0); } }
#pragma unroll
            for (int kk = 0; kk < 4; ++kk) { const bf16x8 hf = *(const LAS bf16x8*)(lds + D3_HS + ho + 16 * pt * D3_PITCH + 64 * kk);
                a4 = __builtin_amdgcn_mfma_f32_16x16x32_bf16(hf, cfs[kk], a4, 0, 0, 0); }
            acc[h][pt] = a4; asm volatile("" ::: "memory"); }
      }
    }
    const size_t row = (size_t)(rowbase + lrow);
    const bf16* xs = XBC + row * 1024 + grp * 256; const bf16* zp = (const bf16*)(A.ws + WS_P) + row * N_INP + OFF_SSM + grp * 256;
    const float* dsk = A.in[27] + layer * 8 + grp * 4; const float* nw = A.in[28] + layer * 512 + grp * 256;
    float ss = 0.f;
#pragma unroll
    for (int h = 0; h < 4; ++h) { const float dh = dsk[h];
#pragma unroll
        for (int pt = 0; pt < 4; ++pt) { const int cb = h * 64 + 16 * pt + 4 * g;
            const unsigned long long xw = *(const unsigned long long*)(xs + cb), zw = *(const unsigned long long*)(zp + cb);
            const unsigned xl = (unsigned)xw, xh = (unsigned)(xw >> 32), zl = (unsigned)zw, zh = (unsigned)(zw >> 32);
            f32x4 v = acc[h][pt];
            v[0] = (v[0] + dh * __uint_as_float(xl << 16)) * silu_f(__uint_as_float(zl << 16)); v[1] = (v[1] + dh * __uint_as_float(xl & 0xffff0000u)) * silu_f(__uint_as_float(zl & 0xffff0000u));
            v[2] = (v[2] + dh * __uint_as_float(xh << 16)) * silu_f(__uint_as_float(zh << 16)); v[3] = (v[3] + dh * __uint_as_float(xh & 0xffff0000u)) * silu_f(__uint_as_float(zh & 0xffff0000u));
            acc[h][pt] = v; ss += (v[0] * v[0] + v[1] * v[1]) + (v[2] * v[2] + v[3] * v[3]); } }
    ss += __shfl_xor(ss, 16); ss += __shfl_xor(ss, 32);
    const float rstd = 1.0f / sqrtf(ss * (1.f / 256.f) + EPS);
    bf16* yo = (bf16*)(A.ws + WS_Y) + row * DM + 1536 + grp * 256;
#pragma unroll
    for (int h = 0; h < 4; ++h)
#pragma unroll
        for (int pt = 0; pt < 4; ++pt) { const int cb = h * 64 + 16 * pt + 4 * g; const f32x4 nv = *(const f32x4*)(nw + cb); const f32x4 v = acc[h][pt];
            *(unsigned long long*)(yo + cb) = (unsigned long long)pk2(v[0] * rstd * nv[0], v[1] * rstd * nv[1]) | ((unsigned long long)pk2(v[2] * rstd * nv[2], v[3] * rstd * nv[3]) << 32); }
}
__device__ __forceinline__ void ssm_prep_tile(const Ctx& C, KArgs& A, int layer, int tile) {
    const int lane = C.lane; LAS unsigned* T = (LAS unsigned*)(C.lds + C.wave * 8448);
    const int ct = tile % 12, tt = tile / 12, cb = ct * 64, row0 = tt * 64;
    int t0, L; if (row0 < M_LAT) { t0 = row0 & 4095; L = SEQ; } else { t0 = (row0 - M_LAT) & 255; L = LC; }
    const float* cw = A.in[23] + layer * 3 * 1024; const float* cbias = A.in[24] + layer * 1024; const int ch = cb + lane;
    const float w0 = cw[ch], w1 = cw[1024 + ch], w2 = cw[2048 + ch], bias = cbias[ch];
    const bf16* p = (const bf16*)(A.ws + WS_P) + (size_t)row0 * N_INP + OFF_SSM + 512 + ch;
    float pm = (t0 > 0) ? bf2f(p[-(ptrdiff_t)N_INP]) : 0.f, pc = bf2f(p[0]), ae = 0.f;
#pragma unroll 8
    for (int i = 0; i < 64; ++i) { const float pn = (t0 + i + 1 < L) ? bf2f(p[(size_t)(i + 1) * N_INP]) : 0.f; const float a = silu_f(bias + w0 * pm + w1 * pc + w2 * pn); pm = pc; pc = pn;
        if (i & 1) T[lane * 33 + (i >> 1)] = pk2(ae, a); else ae = a; }
    LDS_WAIT(); asm volatile("" ::: "memory");
    unsigned* dst = (unsigned*)((bf16*)(A.ws + WS_XBCT) + (size_t)cb * M_ALL + row0);
#pragma unroll 8
    for (int ii = 0; ii < 32; ++ii) { const int rr = 2 * ii + (lane >> 5), j = lane & 31; dst[(size_t)rr * (M_ALL / 2) + j] = T[rr * 33 + j]; }
    LDS_WAIT(); asm volatile("" ::: "memory");
}

__device__ __forceinline__ void filter_unit(const Ctx& C, KArgs& A, int layer, int u) {
    if (u < SEQ / 16) hy_filter_unit16<SEQ>(C, A, layer, 16 * u, A.ws + WS_GT); else hy_filter_unit16<LC>(C, A, layer, 16 * (u - SEQ / 16), A.ws + ((layer & 1) ? WS_GCTX1 : WS_GCTX));
}
constexpr int CW_TAILQ = 8192;
__device__ __forceinline__ void tail_work(const Ctx& C, KArgs& A, int next_layer, volatile LAS unsigned* MISC) {
    const bool ctxf = next_layer < DEPTH - 1; const int nF = SEQ / 16 + (ctxf ? LC / 16 : 0);
    unsigned* head = (unsigned*)(A.ws + WS_CTL) + CW_TAILQ + 64 * next_layer;
    for (;;) {
        __syncthreads();
        if (C.tid == 0) MISC[16] = __hip_atomic_fetch_add(head, 1u, __ATOMIC_RELAXED, __HIP_MEMORY_SCOPE_AGENT);
        __syncthreads();
        const int q = (int)MISC[16];
        if (q >= nF) break;
        filter_unit(C, A, next_layer, q);
    }
    __syncthreads();
}

namespace pg8 {
struct CtxOrder {
    int c;
    __device__ bool next(int i, Unit& u) const { if (i > 0 || c >= 32) return false; u.pm = c >> 3; u.pn = c & 7; return true; }
    __device__ __forceinline__ void a_ready(const Unit&) const {}
    __device__ __forceinline__ void done(const Unit&) const {}
};
struct CtxOrderSK {
    int c;
    __device__ __forceinline__ bool next(int i, Unit& u) const { if (i > 0 || c >= 64) return false; const int t = c >> 1; u.pm = t >> 3; u.pn = (t & 7) | ((c & 1) << 8); return true; }
    __device__ __forceinline__ void a_ready(const Unit&) const {}
    __device__ __forceinline__ void done(const Unit&) const {}
};
}
constexpr int CW_FLAG = 16384;
__global__ void __launch_bounds__(NTHR, 2) mk_fwd(const Args A_unused) {
    KArgs* Ap = (KArgs*)__builtin_amdgcn_kernarg_segment_ptr();
#define A (*Ap)
    extern __shared__ __attribute__((aligned(16))) unsigned char lds_raw[];
    Ctx C;
    C.lds = (LAS unsigned char*)lds_raw;
    C.tid = threadIdx.x; C.lane = C.tid & 63; C.wave = __builtin_amdgcn_readfirstlane(C.tid >> 6);
    C.bid = blockIdx.x; C.G = gridDim.x; C.gw = C.bid * NWAVES + C.wave; C.NGW = C.G * NWAVES;
    volatile LAS unsigned* MISC = (volatile LAS unsigned*)(C.lds + MISC_OFF);
    for (int u = C.tid; u < (LDS_BYTES - MISC_OFF) / 4; u += NTHR) MISC[u] = 0u;
    __syncthreads();
    XcdBarrier bar; bar.bar = (unsigned*)(A.ws + WS_CTL) + CW_BAR; bar.x = 0; bar.st = nullptr;
    if (!MK_SPLIT) bar = xcd_barrier_post((unsigned*)(A.ws + WS_CTL) + CW_BAR, MISC + 8);
    const int lo = A.ph_lo, hi = A.ph_hi;
#define IN(k) (lo <= (k) && (k) < hi && (launder(C), ({ asm volatile("" : "+s"(Ap)); true; })))
#define RELOAD_A_UNUSED() asm volatile("" : "+s"(Ap))
#define REPS(k) ((PROBE_REP == (k)) ? 2 : 1)
#define SEAM(k) do { if (!MK_SPLIT && IN(k) && IN((k) + 1)) xcd_barrier(bar); } while (0)

    if (IN(PH_PRO1)) { phase_pro1(C, A); if (PROBE_REP == 40) { if (!MK_SPLIT) xcd_barrier(bar); launder(C); phase_pro1(C, A); } } SEAM(PH_PRO1);
    if (IN(PH_PRO2)) { phase_pro2(C, A); for (int u = (C.bid & 7) * (C.G >> 3) + (C.bid >> 3); u < SEQ / 16; u += C.G) filter_unit(C, A, 0, u);        __syncthreads(); } SEAM(PH_PRO2);

    for (int layer = 0; layer < DEPTH; ++layer) {
        const int pb = PH_L0 + layer * PH_PER_LAYER; const bool last = (layer == DEPTH - 1), need_ctx = !last;
        const unsigned char* wl = A.ws + WS_W + (size_t)layer * W_LAYER;
        const float* mod = (const float*)(A.ws + WS_MOD) + (size_t)layer * 5 * 12288;
        if (IN(pb + 0)) for (int rep_ = 0; rep_ < REPS(0); ++rep_) { if (rep_) { if (!MK_SPLIT) xcd_barrier(bar); launder(C); }
            phase_norm(C, A, layer, 0, layer == 0 ? 0 : M_LAT, M_ALL, C.gw, C.NGW);
            const int nf = SEQ + (need_ctx ? LC : 0);
            (void)nf;
        } SEAM(pb + 0);
        if (IN(pb + 1)) for (int rep_ = 0; rep_ < REPS(1); ++rep_) { if (rep_) { if (!MK_SPLIT) xcd_barrier(bar); launder(C); }
            pg8::Gemm g{(const bf16*)(A.ws + WS_XN), (const bf16*)wl, M_ALL, N_INP, DM}; pg8::StaticOrder S; S.init(M_ALL, N_INP, C.G, C.bid, 4);
            pg8::EpiStoreBf16<0> E{(bf16*)(A.ws + WS_P), N_INP, (const float*)(A.ws + WS_ROPE)};
            pg8::gemm_phase<pg8::EpiStoreBf16<0>, pg8::StaticOrder, true, true>(C.lds, g, S, E);
            if (layer == 0 && rep_ == 0 && C.bid >= C.G - LC / 16) { __syncthreads(); launder(C); filter_unit(C, A, 0, SEQ / 16 + C.bid - (C.G - LC / 16)); __syncthreads(); }
        } SEAM(pb + 1);
        if (IN(pb + 2)) for (int rep_ = 0; rep_ < REPS(2); ++rep_) { if (rep_) { if (!MK_SPLIT) xcd_barrier(bar); launder(C); } prep_dt(C, A, layer); if (need_ctx) { const int gws = ((C.bid & 7) * (C.G >> 3) + (C.bid >> 3)) * NWAVES + C.wave - (C.NGW >> 1);
                for (int row = M_LAT + (gws < 0 ? gws + C.NGW : gws); row < M_ALL; row += C.NGW) prep_row(C, A, layer, row); }
            phase_prep_units(C, A, layer); } SEAM(pb + 2);
        if (IN(pb + 3)) for (int rep_ = 0; rep_ < REPS(3); ++rep_) { if (rep_) { if (!MK_SPLIT) xcd_barrier(bar); launder(C); }
            for (int sr = 0; sr < ((PROBE_REP == 32) ? 2 : 1); ++sr) { launder(C); for (int u = C.bid; u < NB * 34 * 2; u += C.G) ssd_d1_unit(C, A, u / 68, (u % 68) >> 1, u & 1); }
            __syncthreads();
            for (int sr = 0; sr < ((PROBE_REP == 30) ? 2 : 1); ++sr) { launder(C); hy_fast_units(C, A); }
            __syncthreads();
            phase_hyconv(C, A, layer, 0, need_ctx, 16);
            for (int sr = 0; sr < ((PROBE_REP == 31) ? 2 : 1); ++sr) { launder(C); phase_attn<0>(C, A, layer, need_ctx); }
        } SEAM(pb + 3);
        if (IN(pb + 4)) for (int rep_ = 0; rep_ < REPS(4); ++rep_) { if (rep_) { if (!MK_SPLIT) xcd_barrier(bar); launder(C); }
            const int nHP = 8 * (M_LAT / 64), nHPx = need_ctx ? 16 * NWAVES : 0;
            if (need_ctx && C.bid >= C.G - 16) { const int u = C.bid - (C.G - 16); ssd_d3_unit<true>(C, A, layer, u >> 2, (u >> 1) & 1, u & 1); __syncthreads();
                launder(C); hy_post_tile(C, A, nHP - nHPx + u * NWAVES + C.wave); }
            else { Ctx C2 = C; if (need_ctx) { C2.G = C.G - 16; C2.NGW = C2.G * NWAVES; }
                ssd_d2(C2, A);
                for (int tile = C2.gw; tile < nHP - nHPx; tile += C2.NGW) hy_post_tile(C2, A, tile);
                phase_hyconv(C2, A, layer, 1, need_ctx, 16); }
        } SEAM(pb + 4);
        if (IN(pb + 5)) for (int rep_ = 0; rep_ < REPS(5); ++rep_) { if (rep_) { if (!MK_SPLIT) xcd_barrier(bar); launder(C); }
            for (int u = C.bid; u < NB * 32 * 2; u += C.G) ssd_d3_unit<false>(C, A, layer, u >> 6, 2 + ((u & 63) >> 1), u & 1);
        } SEAM(pb + 5);
        if (IN(pb + 6)) for (int rep_ = 0; rep_ < REPS(6); ++rep_) { if (rep_) { if (!MK_SPLIT) xcd_barrier(bar); launder(C); }
            bf16* Xp = (bf16*)(A.ws + WS_X); const bool first = (layer == 0 && rep_ == 0); const void* bl = first ? (const void*)A.in[0] : (const void*)Xp; const void* bc = first ? (const void*)A.in[2] : (const void*)(Xp + (size_t)M_LAT * DM);
            { pg8::Gemm g{(const bf16*)(A.ws + WS_Y), (const bf16*)(wl + W_OUT_OFF), M_LAT, DM, DM}; pg8::StaticOrder S; S.init(M_LAT, DM, C.G, C.bid);
              pg8::EpiResid E; E.X = Xp; E.gate = mod + 2 * DM; E.gs = rep_ ? 0.f : 1.f; E.base_lat = bl; E.base_ctx = bl; E.base_f32 = first;
              pg8::gemm_phase<pg8::EpiResid, pg8::StaticOrder, true, true>(C.lds, g, S, E); }
            if (need_ctx) { if (!MK_SPLIT) xcd_barrier(bar); launder(C);
                if (C.bid < 32) { pg8::Gemm g{(const bf16*)(A.ws + WS_Y) + (size_t)M_LAT * DM, (const bf16*)(wl + W_OUT_OFF), M_CTX, DM, DM}; pg8::CtxOrder S; S.c = C.bid;
                    pg8::EpiResid E; E.X = Xp + (size_t)M_LAT * DM; E.gate = mod + 4 * 12288 + 2 * DM; E.gs = rep_ ? 0.f : 1.f; E.base_lat = bc; E.base_ctx = bc; E.base_f32 = first;
                    pg8::gemm_phase<pg8::EpiResid, pg8::CtxOrder, true, true>(C.lds, g, S, E); }
                else phase_norm(C, A, layer, 1, 0, M_LAT, (C.bid - 32) * NWAVES + C.wave, (C.G - 32) * NWAVES); }
        } SEAM(pb + 6);
        if (IN(pb + 7)) for (int rep_ = 0; rep_ < REPS(7); ++rep_) { if (rep_) { if (!MK_SPLIT) xcd_barrier(bar); launder(C); } phase_norm(C, A, layer, 1, need_ctx ? M_LAT : 0, need_ctx ? M_ALL : M_LAT, C.gw, C.NGW); } SEAM(pb + 7);
        if (IN(pb + 8)) for (int rep_ = 0; rep_ < REPS(8); ++rep_) { if (rep_) { if (!MK_SPLIT) xcd_barrier(bar); launder(C); }
            const int Mo = need_ctx ? M_ALL : M_LAT;
            pg8::Gemm g{(const bf16*)(A.ws + WS_XN), (const bf16*)(wl + W_1_OFF), Mo, DFF, DM}; pg8::StaticOrder S; S.init(Mo, DFF, C.G, C.bid, 4);
            pg8::EpiStoreBf16<1> E{(bf16*)(A.ws + WS_H), DFF, nullptr};
            pg8::gemm_phase<pg8::EpiStoreBf16<1>, pg8::StaticOrder, true, true>(C.lds, g, S, E);
            if (need_ctx && rep_ == 0 && C.bid >= C.G / 2) { __syncthreads(); launder(C);
                convert_items(C, A, layer + 1, (LAS float*)(C.lds + C.wave * 16896), (C.bid - C.G / 2) * NWAVES + C.wave, (C.G / 2) * NWAVES, 0, CV_SPLIT); __syncthreads(); }
        } SEAM(pb + 8);
        if (IN(pb + 9)) for (int rep_ = 0; rep_ < REPS(9); ++rep_) { if (rep_) { if (!MK_SPLIT) xcd_barrier(bar); launder(C); }
            bf16* Xp = (bf16*)(A.ws + WS_X);
            { pg8::Gemm g{(const bf16*)(A.ws + WS_H), (const bf16*)(wl + W_2_OFF), M_LAT, DM, DFF}; pg8::StaticOrder S; S.init(M_LAT, DM, C.G, C.bid, 4);
              pg8::EpiResid E; E.X = Xp; E.gate = mod + 5 * DM; E.gs = rep_ ? 0.f : 1.f; E.base_lat = Xp; E.base_ctx = Xp; E.base_f32 = 0;
              pg8::gemm_phase<pg8::EpiResid, pg8::StaticOrder, true, true>(C.lds, g, S, E); }
            if (need_ctx) { if (!MK_SPLIT) xcd_barrier(bar); launder(C);
                if (C.bid < 64) { pg8::Gemm g{(const bf16*)(A.ws + WS_H) + (size_t)M_LAT * DFF, (const bf16*)(wl + W_2_OFF), M_CTX, DM, DFF / 2}; pg8::CtxOrderSK S; S.c = C.bid;
                    pg8::EpiResidSK E; E.X = Xp + (size_t)M_LAT * DM; E.gate = mod + 4 * 12288 + 5 * DM; E.gs = rep_ ? 0.f : 1.f; E.part = (float*)(A.ws + WS_MODP); E.flag = (unsigned*)(A.ws + WS_CTL) + CW_FLAG + 64 * 32 * layer;
                    pg8::gemm_phase<pg8::EpiResidSK, pg8::CtxOrderSK, true, true, true>(C.lds, g, S, E); }
                else { if (rep_ == 0) tail_work(C, A, layer + 1, MISC); launder(C); phase_norm(C, A, layer + 1, 0, 0, M_LAT, (C.bid - 64) * NWAVES + C.wave, (C.G - 64) * NWAVES);
                    if (rep_ == 0) { launder(C); convert_items(C, A, layer + 1, (LAS float*)(C.lds + C.wave * 16896), (C.bid - 64) * NWAVES + C.wave, (C.G - 64) * NWAVES, CV_SPLIT, CV_ITEMS); } } }
            else if (layer + 1 < DEPTH && rep_ == 0) tail_work(C, A, layer + 1, MISC);
        } SEAM(pb + 9);
    }
    if (IN(PH_FINAL)) phase_final(C, A);
#undef IN
#undef SEAM
#undef A
}

extern "C" void kernel_launch(void* const* d_in, const int* in_sizes, int n_in, void* d_out, int out_size, void* d_ws, size_t ws_size, hipStream_t stream) {
    static int grid = 0;
    if (grid == 0) {
        if (n_in != 32 || out_size != M_LAT * DM || ws_size < WS_END) { fprintf(stderr, "kernel_launch: unexpected shapes (n_in %d, out %d, ws %zu); nothing launched\n", n_in, out_size, ws_size); grid = -1; return; }
        int dev = 0, cus = 0, per_cu = 0;
        if (hipGetDevice(&dev) != hipSuccess || hipDeviceGetAttribute(&cus, hipDeviceAttributeMultiprocessorCount, dev) != hipSuccess) { grid = -1; return; }
        if (hipFuncSetAttribute((const void*)mk_fwd, hipFuncAttributeMaxDynamicSharedMemorySize, LDS_BYTES) != hipSuccess) { fprintf(stderr, "kernel_launch: hipFuncSetAttribute failed\n"); grid = -1; return; }
        if (hipOccupancyMaxActiveBlocksPerMultiprocessor(&per_cu, (const void*)mk_fwd, NTHR, LDS_BYTES) != hipSuccess || per_cu < 1) { fprintf(stderr, "kernel_launch: occupancy query says %d blocks per CU\n", per_cu); }
        (void)hipGetLastError();
        grid = cus;
    }
    if (grid < 0) return;
    if (hipMemsetAsync((char*)d_ws + WS_CTL, 0, CTL_ZERO_BYTES, stream) != hipSuccess) { fprintf(stderr, "kernel_launch: memset failed\n"); return; }
    Args a{};
    for (int i = 0; i < 32; ++i) a.in[i] = (const float*)d_in[i];
    a.out = (float*)d_out; a.ws = (unsigned char*)d_ws;
#if MK_SPLIT
    for (int ph = 0; ph < N_PHASES; ++ph) { a.ph_lo = ph; a.ph_hi = ph + 1; hipLaunchKernelGGL(mk_fwd, dim3(grid), dim3(NTHR), LDS_BYTES, stream, a); }
#else
    a.ph_lo = 0; a.ph_hi = N_PHASES; hipLaunchKernelGGL(mk_fwd, dim3(grid), dim3(NTHR), LDS_BYTES, stream, a);
#endif
    const hipError_t le = hipPeekAtLastError();
    if (le != hipSuccess) fprintf(stderr, "kernel_launch: launch failed: %s\n", hipGetErrorName(le));
}
```
